# Optimizing an MI355X kernel written in HIP

```python
import math
import jax, jax.numpy as jnp
from jax import lax
import numpy as np

D_MODEL = 1024
BATCH = 8
SEQ = 2048
DEPTH = 1
DEC_BATCH = 32
DEC_SEQ = 64
PAST_LEN = 1024

CHUNK = 64
D_MIX = D_MODEL
HEAD_DIM = 64
D_ATTN = D_MIX // 2
D_CMLP = D_MIX - D_ATTN
N_HEADS = D_ATTN // HEAD_DIM
N_KV_HEADS = 2
GQA_GROUP = N_HEADS // N_KV_HEADS
D_KV = N_KV_HEADS * HEAD_DIM
WINDOW = 128
N_PREV_CHUNKS = WINDOW // CHUNK
ROPE_DIM = HEAD_DIM // 4
ROPE_THETA = 500000.0
CMLP_BLOCK = 128
CMLP_GROUP_DIM = 64
CMLP_GROUPS = D_CMLP // CMLP_GROUP_DIM
D_IN = D_ATTN + 2 * D_KV + 2 * D_CMLP
D_FF = ((-(-8 * D_MODEL // 3) + 255) // 256) * 256
ALPHA = (2 * DEPTH) ** 0.25
BETA = (8 * DEPTH) ** -0.25
LN_EPS = 1e-5
NEG_INF = -1e30

kernel_name = "hybrid_swa_sink_chunk_gmlp_stream_step"


def _layernorm(x, g, b):
    xf = x.astype(jnp.float32)
    mu = jnp.mean(xf, -1, keepdims=True)
    var = jnp.mean(jnp.square(xf - mu), -1, keepdims=True)
    return ((xf - mu) * lax.rsqrt(var + LN_EPS) * g.astype(jnp.float32) + b.astype(jnp.float32)).astype(x.dtype)


def _rmsnorm(x, g):
    xf = x.astype(jnp.float32)
    ms = jnp.mean(jnp.square(xf), -1, keepdims=True)
    return (xf * lax.rsqrt(ms + LN_EPS) * g.astype(jnp.float32)).astype(x.dtype)


def _rope(x, pos):
    half = ROPE_DIM // 2
    inv = jnp.power(ROPE_THETA, -jnp.arange(half, dtype=jnp.float32) * (2.0 / ROPE_DIM))
    ang = pos.astype(jnp.float32)[:, None] * inv[None, :]
    cos = jnp.cos(ang)[:, None, :]
    sin = jnp.sin(ang)[:, None, :]
    xr = x[..., :ROPE_DIM].astype(jnp.float32)
    x1, x2 = xr[..., :half], xr[..., half:]
    rot = jnp.concatenate([x1 * cos - x2 * sin, x2 * cos + x1 * sin], -1)
    return jnp.concatenate([rot.astype(x.dtype), x[..., ROPE_DIM:]], -1)


def _sink_attention(q, k, v, valid, sinks):
    s = jnp.einsum('...qkgd,...jkd->...kgqj', q.astype(jnp.float32), k.astype(jnp.float32)) * (HEAD_DIM ** -0.5)
    if valid is not None:
        s = jnp.where(valid, s, NEG_INF)
    sink = sinks.astype(jnp.float32).reshape(N_KV_HEADS, GQA_GROUP)[..., None, None]
    m = jnp.maximum(jnp.max(s, -1, keepdims=True), sink)
    p = jnp.exp(s - m)
    denom = jnp.sum(p, -1, keepdims=True) + jnp.exp(sink - m)
    o = jnp.einsum('...kgqj,...jkd->...qkgd', p / denom, v.astype(jnp.float32))
    return o.astype(q.dtype)


def _project(x, w_in, ln_v_g, ln_v_b):
    B, L = x.shape[:2]
    h = x @ w_in
    q = h[..., :D_ATTN].reshape(B, L, N_HEADS, HEAD_DIM)
    k = h[..., D_ATTN:D_ATTN + D_KV].reshape(B, L, N_KV_HEADS, HEAD_DIM)
    v = h[..., D_ATTN + D_KV:D_ATTN + 2 * D_KV].reshape(B, L, N_KV_HEADS, HEAD_DIM)
    uv = jax.nn.gelu(h[..., D_ATTN + 2 * D_KV:])
    u = uv[..., :D_CMLP].reshape(B, L, CMLP_GROUPS, CMLP_GROUP_DIM)
    vm = _layernorm(uv[..., D_CMLP:], ln_v_g, ln_v_b).reshape(B, L, CMLP_GROUPS, CMLP_GROUP_DIM)
    return q, k, v, u, vm


def _window_attn_prompt(q, k, v, sinks):
    B, S = q.shape[:2]
    n_c = S // CHUNK
    pad = N_PREV_CHUNKS * CHUNK
    pos = jnp.arange(S)
    q = _rope(q, pos)
    k = _rope(k, pos)
    kp = jnp.pad(k, ((0, 0), (pad, 0), (0, 0), (0, 0))).reshape(B, n_c + N_PREV_CHUNKS, CHUNK, N_KV_HEADS, HEAD_DIM)
    vp = jnp.pad(v, ((0, 0), (pad, 0), (0, 0), (0, 0))).reshape(B, n_c + N_PREV_CHUNKS, CHUNK, N_KV_HEADS, HEAD_DIM)
    kb = jnp.concatenate([kp[:, i:i + n_c] for i in range(N_PREV_CHUNKS + 1)], axis=2)
    vb = jnp.concatenate([vp[:, i:i + n_c] for i in range(N_PREV_CHUNKS + 1)], axis=2)
    qb = q.reshape(B, n_c, CHUNK, N_KV_HEADS, GQA_GROUP, HEAD_DIM)
    key_pos = jnp.arange(n_c)[:, None] * CHUNK - pad + jnp.arange((N_PREV_CHUNKS + 1) * CHUNK)[None, :]
    valid = (key_pos >= 0)[:, None, None, None, :]
    o = _sink_attention(qb, kb, vb, valid, sinks)
    return o.reshape(B, S, D_ATTN), k, v


def _window_attn_sample(q, k, v, cache_k, cache_v, sinks):
    Bd, L = q.shape[:2]
    pos = PAST_LEN + jnp.arange(L)
    q = _rope(q, pos)
    k = _rope(k, pos)
    kk = jnp.concatenate([cache_k.astype(k.dtype), k], axis=1)
    vv = jnp.concatenate([cache_v.astype(v.dtype), v], axis=1)
    qg = q.reshape(Bd, L, N_KV_HEADS, GQA_GROUP, HEAD_DIM)
    o = _sink_attention(qg, kk, vv, None, sinks)
    return o.reshape(Bd, L, D_ATTN), k, v


def _spatial_gate(u, vm, w_s, b_s):
    lb = u.shape[2]
    i = jnp.arange(lb)
    mask = (i[None, :] // CHUNK) <= (i[:, None] // CHUNK)
    w = jnp.where(mask[None], w_s[:, :lb, :lb], jnp.zeros((), w_s.dtype))
    s = jnp.einsum('gij,bnjgd->bnigd', w, vm) + jnp.transpose(b_s[:, :lb])[:, :, None]
    return u * s


def _merge(attn_o, cmlp_o, norm_attn_g, norm_cmlp_g, w_out):
    cat = jnp.concatenate([_rmsnorm(attn_o, norm_attn_g), _rmsnorm(cmlp_o, norm_cmlp_g)], -1)
    return cat @ w_out


def _post(x, mix, ln1_g, ln1_b, w_gate_up, w_down, ln2_g, ln2_b):
    h = _layernorm(ALPHA * x + mix, ln1_g, ln1_b)
    gu = h @ w_gate_up
    f = (jax.nn.silu(gu[..., :D_FF]) * gu[..., D_FF:]) @ w_down
    return _layernorm(ALPHA * h + f, ln2_g, ln2_b)


def setup_inputs(seed: int = 0) -> dict:
    key = jax.random.key(seed)
    ks = jax.random.split(key, 20)
    cw = min(WINDOW, PAST_LEN)
    f32 = jnp.float32
    nrm = lambda k, shape, scale: (jax.random.normal(k, shape, f32) * scale)
    return {
        "x_prompt": nrm(ks[0], (BATCH, SEQ, D_MODEL), 1.0),
        "x_sample": nrm(ks[1], (DEC_BATCH, DEC_SEQ, D_MODEL), 1.0),
        "cache_win_k": nrm(ks[2], (DEPTH, DEC_BATCH, cw, N_KV_HEADS, HEAD_DIM), 1.0),
        "cache_win_v": nrm(ks[3], (DEPTH, DEC_BATCH, cw, N_KV_HEADS, HEAD_DIM), 1.0),
        "w_in": nrm(ks[4], (DEPTH, D_MODEL, D_IN), D_MODEL ** -0.5),
        "ln_v_g": 1.0 + nrm(ks[5], (DEPTH, D_CMLP), 0.02),
        "ln_v_b": nrm(ks[6], (DEPTH, D_CMLP), 0.02),
        "attn_sinks": nrm(ks[7], (DEPTH, N_HEADS), 1.0),
        "w_spatial": nrm(ks[8], (DEPTH, CMLP_GROUPS, CMLP_BLOCK, CMLP_BLOCK), CMLP_BLOCK ** -0.5),
        "b_spatial": 1.0 + nrm(ks[9], (DEPTH, CMLP_GROUPS, CMLP_BLOCK), 0.1),
        "norm_attn_g": 1.0 + nrm(ks[10], (DEPTH, D_ATTN), 0.02),
        "norm_cmlp_g": 1.0 + nrm(ks[11], (DEPTH, D_CMLP), 0.02),
        "w_out": nrm(ks[12], (DEPTH, D_MIX, D_MODEL), BETA * D_MIX ** -0.5),
        "ln1_g": 1.0 + nrm(ks[13], (DEPTH, D_MODEL), 0.02),
        "ln1_b": nrm(ks[14], (DEPTH, D_MODEL), 0.02),
        "w_gate_up": nrm(ks[15], (DEPTH, D_MODEL, 2 * D_FF), D_MODEL ** -0.5),
        "w_down": nrm(ks[16], (DEPTH, D_FF, D_MODEL), BETA * D_FF ** -0.5),
        "ln2_g": 1.0 + nrm(ks[17], (DEPTH, D_MODEL), 0.02),
        "ln2_b": nrm(ks[18], (DEPTH, D_MODEL), 0.02),
    }


def reference(x_prompt, x_sample, cache_win_k, cache_win_v, w_in, ln_v_g, ln_v_b, attn_sinks, w_spatial, b_spatial,
              norm_attn_g, norm_cmlp_g, w_out, ln1_g, ln1_b, w_gate_up, w_down, ln2_g, ln2_b):
    yp, ys = x_prompt, x_sample
    B, S = yp.shape[:2]
    Bd, L = ys.shape[:2]
    cw_p = min(WINDOW, S)
    kp_rows, vp_rows, ks_rows, vs_rows, ms_rows = [], [], [], [], []
    for l in range(DEPTH):
        q, k, v, u, vm = _project(yp, w_in[l], ln_v_g[l], ln_v_b[l])
        ao, kr, vr = _window_attn_prompt(q, k, v, attn_sinks[l])
        nb = S // CMLP_BLOCK
        co = _spatial_gate(u.reshape(B, nb, CMLP_BLOCK, CMLP_GROUPS, CMLP_GROUP_DIM),
                           vm.reshape(B, nb, CMLP_BLOCK, CMLP_GROUPS, CMLP_GROUP_DIM),
                           w_spatial[l], b_spatial[l]).reshape(B, S, D_CMLP)
        mix = _merge(ao, co, norm_attn_g[l], norm_cmlp_g[l], w_out[l])
        yp = _post(yp, mix, ln1_g[l], ln1_b[l], w_gate_up[l], w_down[l], ln2_g[l], ln2_b[l])
        kp_rows.append(kr[:, S - cw_p:])
        vp_rows.append(vr[:, S - cw_p:])
        q, k, v, u, vm = _project(ys, w_in[l], ln_v_g[l], ln_v_b[l])
        ao, kr, vr = _window_attn_sample(q, k, v, cache_win_k[l], cache_win_v[l], attn_sinks[l])
        co = _spatial_gate(u[:, None], vm[:, None], w_spatial[l], b_spatial[l]).reshape(Bd, L, D_CMLP)
        mix = _merge(ao, co, norm_attn_g[l], norm_cmlp_g[l], w_out[l])
        ys = _post(ys, mix, ln1_g[l], ln1_b[l], w_gate_up[l], w_down[l], ln2_g[l], ln2_b[l])
        ks_rows.append(kr)
        vs_rows.append(vr)
        ms_rows.append(vm)
    new_win_k_prompt = jnp.stack(kp_rows)
    new_win_v_prompt = jnp.stack(vp_rows)
    new_k_sample = jnp.stack(ks_rows)
    new_v_sample = jnp.stack(vs_rows)
    new_cmlp_v_sample = jnp.stack(ms_rows)
    return (yp, ys, new_win_k_prompt, new_win_v_prompt, new_k_sample, new_v_sample, new_cmlp_v_sample)
```

```cpp
#include <hip/hip_runtime.h>
#include <hip/hip_cooperative_groups.h>
#include <cstdio>
#include <cstdint>
namespace cg = cooperative_groups;

#define LAS __attribute__((address_space(3)))
typedef unsigned short bf16_t;
typedef short bf16x8 __attribute__((ext_vector_type(8)));
typedef short bf16x4 __attribute__((ext_vector_type(4)));
typedef float f32x4 __attribute__((ext_vector_type(4)));
typedef float f32x2 __attribute__((ext_vector_type(2)));
typedef unsigned u32x4 __attribute__((ext_vector_type(4)));
typedef unsigned u32x2 __attribute__((ext_vector_type(2)));

#ifndef GEMM_SP2
#define GEMM_SP2 1
#endif
#ifndef GEMM_ALIGN_EPI
#define GEMM_ALIGN_EPI 1
#endif
#ifndef P3_STREAMK
#define P3_STREAMK 1
#endif
#ifndef PROBE_PH
#define PROBE_PH -1
#endif
constexpr int D = 1024, SEQ = 2048, NB = 8, DEC_B = 32, DEC_L = 64, PAST = 1024;
constexpr int MP = NB * SEQ, MS = DEC_B * DEC_L, M = MP + MS;
constexpr int D_IN = 1792, D_FF = 2816;
constexpr int C_Q = 0, C_K = 512, C_V = 640, C_U = 768, C_VM = 1280;
constexpr float ALPHA = 1.189207115002721f;
constexpr float LN_EPS = 1e-5f;
constexpr size_t O_Y = 0, O_KP = (size_t)M * D, O_VP = O_KP + 131072, O_KS = O_VP + 131072, O_VS = O_KS + 262144, O_MS = O_VS + 262144;
constexpr size_t WS_XB = 0;
constexpr size_t WS_H = WS_XB + (size_t)M * D * 2;
constexpr size_t WS_ACT = 0;
constexpr size_t WS_W1 = (size_t)M * D_FF * 2;
constexpr size_t WS_W2 = WS_W1 + (size_t)D_IN * D * 2;
constexpr size_t WS_W3 = WS_W2 + (size_t)D * D * 2;
constexpr size_t WS_W4 = WS_W3 + (size_t)2 * D_FF * D * 2;
constexpr size_t WS_WS = WS_W4 + (size_t)D * D_FF * 2;
constexpr size_t WS_ROPE = WS_WS + (size_t)8 * 128 * 128 * 2;
constexpr size_t WS_CAT = WS_ROPE + (size_t)2048 * 16 * 4;
constexpr size_t WS_HB = WS_CAT + (size_t)M * D * 2;
constexpr size_t WS_BAR = WS_HB + (size_t)M * D * 2;
constexpr int NSETS = (PROBE_PH == 3 || PROBE_PH == 6 || PROBE_PH == 10) ? 6 : 2, NBAR = PROBE_PH == 10 ? 2 : 1;
constexpr size_t WS_CNT = WS_BAR + (size_t)NBAR * 16384;
constexpr size_t WS_FLG = WS_CNT + (size_t)NSETS * 72 * 256;
constexpr size_t WS_ZERO_BYTES = (size_t)NBAR * 16384 + (size_t)NSETS * 72 * 256 + (size_t)NSETS * 224 * 256;
constexpr size_t WS_XB1 = WS_FLG + (size_t)NSETS * 224 * 256;
constexpr size_t WS_XB2 = WS_XB1 + (size_t)M * 4 * 8;
constexpr size_t WS_SLAB = WS_XB2 + (size_t)M * 4 * 8;
constexpr size_t WS_END = WS_SLAB + (size_t)224 * 131072;
constexpr int LDS_BYTES = 147456;
constexpr int NTHREADS = 512;

struct Params {
    const float *x_prompt, *x_sample, *cache_k, *cache_v, *w_in, *ln_v_g, *ln_v_b, *sinks, *w_sp, *b_sp, *g_attn, *g_cmlp, *w_out, *ln1_g, *ln1_b, *w_gu, *w_down, *ln2_g, *ln2_b;
    float* out;
    unsigned char* ws;
    int ph_lo, ph_hi, coop, pad;
};

__device__ __forceinline__ unsigned cvt_pk_bf16(float lo, float hi) { unsigned r; asm volatile("v_cvt_pk_bf16_f32 %0, %1, %2" : "=v"(r) : "v"(lo), "v"(hi)); return r; }
__device__ __forceinline__ float bf2f(unsigned short b) { return __uint_as_float(((unsigned)b) << 16); }
__device__ __forceinline__ float bflo(unsigned w) { return __uint_as_float(w << 16); }
__device__ __forceinline__ float bfhi(unsigned w) { return __uint_as_float(w & 0xffff0000u); }
__device__ __forceinline__ float fast_sigmoid(float x) { return __builtin_amdgcn_rcpf(1.0f + __builtin_amdgcn_exp2f(-1.4426950408889634f * x)); }
__device__ __forceinline__ float gelu_tanh(float x) { const float u = 1.5957691216057308f * (x + 0.044715f * x * x * x); return x * fast_sigmoid(u); }
__device__ __forceinline__ float silu(float x) { return x * fast_sigmoid(x); }
__device__ __forceinline__ f32x2 silu_mul_pk(f32x2 g, f32x2 u) {
    const f32x2 m = g * (-1.4426950408889634f);
    f32x2 e; e.x = __builtin_amdgcn_exp2f(m.x); e.y = __builtin_amdgcn_exp2f(m.y);
    const f32x2 d = e + 1.0f;
    f32x2 r; r.x = __builtin_amdgcn_rcpf(d.x); r.y = __builtin_amdgcn_rcpf(d.y);
    return (g * r) * u;
}
__device__ __forceinline__ f32x2 gelu_tanh_pk(f32x2 x) {
    const f32x2 f = (x * x) * (-0.10294324f) + (-2.3022082f);
    const f32x2 w = x * f;
    f32x2 e; e.x = __builtin_amdgcn_exp2f(w.x); e.y = __builtin_amdgcn_exp2f(w.y);
    const f32x2 d = e + 1.0f;
    f32x2 r; r.x = __builtin_amdgcn_rcpf(d.x); r.y = __builtin_amdgcn_rcpf(d.y);
    return x * r;
}


#define XB_TMO      128
#define XB_XCNT(j)  (256  + 64 * (j))
#define XB_XSUB(j)  (1280 + 64 * (j))
#define XB_XGEN(j)  (2304 + 64 * (j))
#define XB_TOP      3328
#define XB_TOPGEN   3392
#define XCD_BAR_WORDS 3456
#define XB_SPIN_CAP (1u << 18)
__device__ __forceinline__ unsigned xb_ld(unsigned* p)              { return __hip_atomic_load(p, __ATOMIC_RELAXED, __HIP_MEMORY_SCOPE_AGENT); }
__device__ __forceinline__ unsigned xb_add(unsigned* p, unsigned v) { return __hip_atomic_fetch_add(p, v, __ATOMIC_RELAXED, __HIP_MEMORY_SCOPE_AGENT); }
__device__ __forceinline__ unsigned xb_xcc_id() { return (unsigned)__builtin_amdgcn_s_getreg((3 << 11) | 20) & 0xFu; }
#define XB_SPIN(cond, bar) do { unsigned _sp = 0; while (cond) { __builtin_amdgcn_s_sleep(1); \
    if ((++_sp & 255u) == 0u) { if (xb_ld(&(bar)[XB_TMO])) break; if (_sp > XB_SPIN_CAP) { atomicAdd(&(bar)[XB_TMO], 1u); break; } } } } while (0)
struct XcdBarrier { unsigned* bar; unsigned x; volatile LAS unsigned* st; };
__device__ __forceinline__ XcdBarrier xcd_barrier_post(unsigned* bar, volatile LAS unsigned* st) {
    XcdBarrier b; b.bar = bar; b.x = xb_xcc_id(); b.st = st;
    if (threadIdx.x == 0) (void)xb_add(&bar[XB_XCNT(b.x)], 1u);
    return b;
}
__device__ __forceinline__ void xcd_barrier_complete(unsigned* bar, unsigned x, unsigned& nloc, unsigned& nx) {
    const unsigned G = gridDim.x * gridDim.y * gridDim.z;
    unsigned sum, cnt, mine, sp = 0u;
    for (;;) {
        sum = 0u; cnt = 0u; mine = 0u;
#pragma unroll
        for (unsigned j = 0; j < 16; ++j) { const unsigned c = xb_ld(&bar[XB_XCNT(j)]); sum += c; cnt += (c > 0u) ? 1u : 0u; mine = (j == x) ? c : mine; }
        if (sum == G) break;
        __builtin_amdgcn_s_sleep(1);
        if ((++sp & 255u) == 0u) { if (xb_ld(&bar[XB_TMO])) break; if (sp > XB_SPIN_CAP) { atomicAdd(&bar[XB_TMO], 1u); break; } }
    }
    nloc = mine > 0u ? mine : 1u; nx = cnt > 0u ? cnt : 1u;
}
__device__ __forceinline__ void xcd_barrier(const XcdBarrier& b) {
    asm volatile("s_waitcnt vmcnt(0)" ::: "memory");
    __syncthreads();
    if (threadIdx.x == 0) {
        unsigned* bar = b.bar;
        __builtin_amdgcn_s_waitcnt(0);
        unsigned nloc = b.st[0], nx = b.st[1];
        if (nloc == 0u) { xcd_barrier_complete(bar, b.x, nloc, nx); b.st[0] = nloc; b.st[1] = nx; }
        const unsigned old = xb_add(&bar[XB_XSUB(b.x)], 1u);
        const unsigned gen = old / nloc;
        if (old + 1u == (gen + 1u) * nloc) {
            __builtin_amdgcn_fence(__ATOMIC_RELEASE, "agent");
            asm volatile("s_waitcnt vmcnt(0)" ::: "memory");
            const unsigned og = xb_add(&bar[XB_TOP], 1u);
            const unsigned tg = og / nx;
            if (og + 1u == (tg + 1u) * nx) xb_add(&bar[XB_TOPGEN], 1u);
            else XB_SPIN(xb_ld(&bar[XB_TOPGEN]) == tg, bar);
            __builtin_amdgcn_fence(__ATOMIC_ACQUIRE, "agent");
            xb_add(&bar[XB_XGEN(b.x)], 1u);
            asm volatile("s_waitcnt vmcnt(0)" ::: "memory");
        } else {
            XB_SPIN(xb_ld(&bar[XB_XGEN(b.x)]) == gen, bar);
            __builtin_amdgcn_fence(__ATOMIC_ACQUIRE, "agent");
            asm volatile("s_waitcnt vmcnt(0)" ::: "memory");
        }
    }
    __syncthreads();
}

namespace pg8 {
constexpr int BM = 256, BK = 64, HALF = 128, HTB = HALF * BK * 2, STAGE_BYTES = 8 * HTB, NXCD = 8, WGM = 8;
__host__ __device__ __forceinline__ int lds_byte(int r, int c) { const int st = (r >> 4) * 2 + (c >> 5), rr = r & 15, cc = c & 31, ob = rr * 64 + cc * 2; return st * 1024 + (ob ^ (((ob >> 9) & 1) << 5)); }
__host__ __device__ __forceinline__ void stage_rc(int b, int& R, int& C) { const int st = b / 1024, sb = b % 1024, swz = sb ^ (((sb >> 9) & 1) << 5); R = (st >> 1) * 16 + swz / 64; C = (st & 1) * 32 + (swz % 64) / 2; }
__host__ __device__ __forceinline__ int perm32(int rho) { const int n = rho >> 4, i = rho & 15; return 8 * (i >> 2) + 4 * n + (i & 3); }
struct Unit { int pm, pn, k0, nt, kind, slot; };
struct Gemm { const bf16_t* A; const bf16_t* Bt; int M, N, K; };
struct StaticOrder {
    int nM, nN, nwg, G, c, ntile;
    __host__ __device__ void init(int M_, int N_, int K_, int G_, int c_) { nM = M_ / BM; nN = N_ / BM; nwg = nM * nN; G = G_; c = c_; ntile = K_ / BK; }
    __host__ __device__ bool next(int i, Unit& u) const {
        const long L = (long)i * G + c; if (L >= nwg) return false;
        int wgid = (int)L; { const int q = nwg / NXCD, r = nwg % NXCD, xcd = wgid % NXCD, off = wgid / NXCD; wgid = (xcd < r ? xcd * (q + 1) : r * (q + 1) + (xcd - r) * q) + off; }
        const int nig = WGM * nN, gid = wgid / nig, fm = gid * WGM, gsz = (nM - fm) < WGM ? (nM - fm) : WGM;
        u.pm = fm + ((wgid % nig) % gsz); u.pn = (wgid % nig) / gsz; u.k0 = 0; u.nt = ntile; u.kind = 0; u.slot = 0; return true;
    }
};

struct TeamOrder {
    int x, j, pn, npair, streamk;
    __host__ __device__ void init(int K_, int c_, int streamk_) { x = c_ & 7; const int l = c_ >> 3; j = l >> 2; pn = l & 3; npair = K_ / (2 * BK); streamk = streamk_; }
    __host__ __device__ bool next(int i, Unit& u) const {
        if (!streamk) { const int q = i * 8 + j; if (q >= 9) return false; u.pm = 9 * x + q; u.pn = pn; u.k0 = 0; u.nt = 2 * npair; u.kind = 0; u.slot = 0; return true; }
        const int total = 9 * npair, R1 = ((j + 1) * total) / 8; int p = (j * total) / 8;
        for (int ii = 0; ; ++ii) {
            if (p >= R1) return false;
            const int panel = p / npair, off = p - panel * npair, tend = (panel + 1) * npair, end = R1 < tend ? R1 : tend;
            if (ii == i) { u.pm = 9 * x + panel; u.pn = pn; u.k0 = off * 2; u.nt = (end - p) * 2; u.kind = off > 0 ? 1 : (end < tend ? 2 : 0);
                u.slot = x * 28 + (u.kind == 1 ? j - 1 : j) * 4 + pn; return true; }
            p = end;
        }
    }
};
template <class Epi, class Sched>
__device__ __forceinline__ void gemm_phase(LAS unsigned char* lds, const Gemm g, const Sched& S, const Epi& E) {
    const int tid = threadIdx.x, wid = __builtin_amdgcn_readfirstlane(tid >> 6), lane = tid & 63, wr = wid >> 2, wc = wid & 3, fr = lane & 15, fq = lane >> 4;
    const int K = g.K;
    unsigned voffA[2], voffB[2];
#pragma unroll
    for (int i = 0; i < 2; ++i) { int R, C; stage_rc(tid * 16 + i * 8192, R, C); const int Rb = (R & ~31) + perm32(R & 31);
        voffA[i] = (unsigned)(R * K + C) * 2u; voffB[i] = (unsigned)(Rb * K + C) * 2u; }
    const size_t kstep = (size_t)(BK * 2);
    const size_t hstep = (size_t)HALF * K * 2;
    const size_t tstep = 2 * hstep;
    const unsigned ldsw = (unsigned)wid * 1024u;
    const int aoff = lds_byte(wr * 64 + fr, fq * 8), boff = lds_byte(wc * 32 + fr, fq * 8);
#define PG8_SA(b, h) (((b) * 2 + (h)) * HTB)
#define PG8_SB(b, h) ((4 + (b) * 2 + (h)) * HTB)
#define PG8_STAGE(bufoff, gbase, voff) do { _Pragma("unroll") for (int _i = 0; _i < 2; ++_i) \
        __builtin_amdgcn_global_load_lds((const unsigned*)((const char*)(gbase) + (voff)[_i]), (LAS unsigned*)(lds + (bufoff) + ldsw + _i * 8192), 16, 0, 0); } while (0)
#define PG8_LDA(dst, b, h) do { _Pragma("unroll") for (int m = 0; m < 4; ++m) _Pragma("unroll") for (int k = 0; k < 2; ++k) dst[m][k] = *(const LAS bf16x8*)(lds + PG8_SA(b, h) + aoff + m * 2048 + k * 1024); } while (0)
#define PG8_LDB(dst, b, h) do { _Pragma("unroll") for (int n = 0; n < 2; ++n) _Pragma("unroll") for (int k = 0; k < 2; ++k) dst[n][k] = *(const LAS bf16x8*)(lds + PG8_SB(b, h) + boff + n * 2048 + k * 1024); } while (0)
#define PG8_MMA(ai, bj, At, Bt) do { __builtin_amdgcn_s_setprio(1); _Pragma("unroll") for (int m = 0; m < 4; ++m) _Pragma("unroll") for (int n = 0; n < 2; ++n) _Pragma("unroll") for (int k = 0; k < 2; ++k) \
        acc[ai][bj][m][n] = __builtin_amdgcn_mfma_f32_16x16x32_bf16(Bt[n][k], At[m][k], acc[ai][bj][m][n], 0, 0, 0); __builtin_amdgcn_s_setprio(0); } while (0)
#define PG8_WAIT_V(n) asm volatile("s_waitcnt vmcnt(" #n ")" ::: "memory")
#define PG8_WAIT_L(n) asm volatile("s_waitcnt lgkmcnt(" #n ")" ::: "memory")
#define PG8_BAR __builtin_amdgcn_s_barrier()
#define PG8_SCHED __builtin_amdgcn_sched_barrier(0)
    Unit cur, nxt; int ui = 0;
    if (!S.next(0, cur)) return;
    f32x4 acc[2][2][4][2];
    if constexpr (Epi::FUSED) E.init(acc, cur, wid, lane);
    else {
#pragma unroll
    for (int a = 0; a < 2; ++a)
#pragma unroll
        for (int b = 0; b < 2; ++b)
#pragma unroll
            for (int m = 0; m < 4; ++m)
#pragma unroll
                for (int n = 0; n < 2; ++n) acc[a][b][m][n] = (f32x4){0.f, 0.f, 0.f, 0.f};
    }
    bf16x8 At[4][2], B0[2][2], B1[2][2];
    const char* cA = (const char*)g.A + (size_t)cur.pm * tstep + (size_t)cur.k0 * kstep; const char* cB = (const char*)g.Bt + (size_t)cur.pn * tstep + (size_t)cur.k0 * kstep;
#if GEMM_SP2
    PG8_STAGE(PG8_SB(0, 0), cB, voffB); PG8_STAGE(PG8_SB(0, 1), cB + hstep, voffB); PG8_STAGE(PG8_SA(0, 0), cA, voffA); PG8_STAGE(PG8_SA(0, 1), cA + hstep, voffA);
    if (wr == 1) PG8_BAR;
    PG8_WAIT_V(2); PG8_BAR;
    PG8_STAGE(PG8_SB(1, 0), cB + kstep, voffB); PG8_STAGE(PG8_SA(1, 0), cA + kstep, voffA); PG8_STAGE(PG8_SB(1, 1), cB + hstep + kstep, voffB);
    PG8_WAIT_V(6); PG8_BAR;
#else
    PG8_STAGE(PG8_SB(0, 0), cB, voffB); PG8_STAGE(PG8_SA(0, 0), cA, voffA); PG8_STAGE(PG8_SB(0, 1), cB + hstep, voffB); PG8_STAGE(PG8_SA(0, 1), cA + hstep, voffA);
    if (wr == 1) PG8_BAR;
    PG8_WAIT_V(4); PG8_BAR;
    PG8_STAGE(PG8_SB(1, 0), cB + kstep, voffB); PG8_STAGE(PG8_SA(1, 0), cA + kstep, voffA); PG8_STAGE(PG8_SB(1, 1), cB + hstep + kstep, voffB);
    PG8_WAIT_V(6); PG8_BAR;
#endif
    for (;;) {
        const bool has_next = S.next(ui + 1, nxt);
        const char* nA = has_next ? (const char*)g.A + (size_t)nxt.pm * tstep + (size_t)nxt.k0 * kstep : cA; const char* nB = has_next ? (const char*)g.Bt + (size_t)nxt.pn * tstep + (size_t)nxt.k0 * kstep : cB;
        const int nt = cur.nt;
        for (int t = 0; t < nt; t += 2) {
            const bool last = (t == nt - 2);
            const char* a1 = cA + (size_t)(t + 1) * kstep;
            const char* a2 = last ? nA : cA + (size_t)(t + 2) * kstep; const char* b2 = last ? nB : cB + (size_t)(t + 2) * kstep;
            const char* a3 = a2 + kstep; const char* b3 = b2 + kstep;
#if GEMM_SP2
            PG8_LDB(B0, 0, 0); PG8_LDB(B1, 0, 1); PG8_SCHED; PG8_LDA(At, 0, 0); PG8_STAGE(PG8_SA(1, 1), a1 + hstep, voffA);
            PG8_WAIT_V(8); PG8_WAIT_L(0); PG8_BAR; PG8_MMA(0, 0, At, B0); PG8_MMA(0, 1, At, B1); PG8_BAR; PG8_SCHED;
            PG8_LDA(At, 0, 1); PG8_STAGE(PG8_SB(0, 0), b2, voffB); PG8_STAGE(PG8_SB(0, 1), b2 + hstep, voffB); PG8_STAGE(PG8_SA(0, 0), a2, voffA);
            PG8_WAIT_V(8); PG8_WAIT_L(0); PG8_BAR; PG8_MMA(1, 0, At, B0); PG8_MMA(1, 1, At, B1); PG8_BAR; PG8_SCHED;
            PG8_LDB(B0, 1, 0); PG8_LDB(B1, 1, 1); PG8_SCHED; PG8_LDA(At, 1, 0); PG8_STAGE(PG8_SA(0, 1), a2 + hstep, voffA);
            PG8_WAIT_V(8); PG8_WAIT_L(0); PG8_BAR; PG8_MMA(0, 0, At, B0); PG8_MMA(0, 1, At, B1); PG8_BAR; PG8_SCHED;
            PG8_LDA(At, 1, 1); PG8_STAGE(PG8_SB(1, 0), b3, voffB); PG8_STAGE(PG8_SB(1, 1), b3 + hstep, voffB); PG8_STAGE(PG8_SA(1, 0), a3, voffA);
            PG8_WAIT_V(8); PG8_WAIT_L(0); PG8_BAR; PG8_MMA(1, 0, At, B0); PG8_MMA(1, 1, At, B1); PG8_BAR; PG8_SCHED;
#else
            PG8_LDB(B0, 0, 0); PG8_SCHED; PG8_LDA(At, 0, 0); PG8_STAGE(PG8_SA(1, 1), a1 + hstep, voffA);
            PG8_WAIT_L(8); PG8_BAR; PG8_WAIT_L(0); PG8_MMA(0, 0, At, B0); PG8_BAR; PG8_SCHED;
            PG8_LDB(B1, 0, 1); PG8_STAGE(PG8_SB(0, 0), b2, voffB);
            PG8_BAR; PG8_WAIT_L(0); PG8_MMA(0, 1, At, B1); PG8_BAR;
            PG8_LDA(At, 0, 1); PG8_STAGE(PG8_SA(0, 0), a2, voffA);
            PG8_BAR; PG8_WAIT_L(0); PG8_MMA(1, 0, At, B0); PG8_BAR; PG8_SCHED;
            PG8_STAGE(PG8_SB(0, 1), b2 + hstep, voffB);
            PG8_WAIT_V(6); PG8_BAR; PG8_MMA(1, 1, At, B1); PG8_BAR;
            PG8_LDB(B0, 1, 0); PG8_SCHED; PG8_LDA(At, 1, 0); PG8_STAGE(PG8_SA(0, 1), a2 + hstep, voffA);
            PG8_WAIT_L(8); PG8_BAR; PG8_WAIT_L(0); PG8_MMA(0, 0, At, B0); PG8_BAR; PG8_SCHED;
            PG8_LDB(B1, 1, 1); PG8_STAGE(PG8_SB(1, 0), b3, voffB);
            PG8_BAR; PG8_WAIT_L(0); PG8_MMA(0, 1, At, B1); PG8_BAR;
            PG8_LDA(At, 1, 1); PG8_STAGE(PG8_SA(1, 0), a3, voffA);
            PG8_BAR; PG8_WAIT_L(0); PG8_MMA(1, 0, At, B0); PG8_BAR; PG8_SCHED;
            PG8_STAGE(PG8_SB(1, 1), b3 + hstep, voffB);
            PG8_WAIT_V(6); PG8_BAR; PG8_MMA(1, 1, At, B1); PG8_BAR;
#endif
        }
        if constexpr (Epi::FUSED) {
            if (wr == 0) PG8_BAR;
            E.fused(acc, cur, wr, wc, fr, fq, lds + STAGE_BYTES, wid, lane);
            if (wr == 1) PG8_BAR;
        } else {
#if GEMM_ALIGN_EPI
            if (wr == 0) PG8_BAR;
            E(acc, cur, wr, wc, fr, fq);
            if (wr == 1) PG8_BAR;
#else
            E(acc, cur, wr, wc, fr, fq);
#endif
        }
        if (!has_next) break;
        if constexpr (Epi::FUSED) E.init(acc, nxt, wid, lane);
        else {
#pragma unroll
        for (int a = 0; a < 2; ++a)
#pragma unroll
            for (int b = 0; b < 2; ++b)
#pragma unroll
                for (int m = 0; m < 4; ++m)
#pragma unroll
                    for (int n = 0; n < 2; ++n) acc[a][b][m][n] = (f32x4){0.f, 0.f, 0.f, 0.f};
        }
        cur = nxt; cA = nA; cB = nB; ++ui;
    }
    PG8_WAIT_V(0);
    if (wr == 0) PG8_BAR;
    PG8_BAR;
#undef PG8_SA
#undef PG8_SB
#undef PG8_STAGE
#undef PG8_LDA
#undef PG8_LDB
#undef PG8_MMA
#undef PG8_WAIT_V
#undef PG8_WAIT_L
#undef PG8_BAR
#undef PG8_SCHED
}
}
using pg8::Unit;
typedef f32x4 Acc[2][2][4][2];


struct EpiProj {
    static constexpr bool FUSED = false;
    bf16_t* H; const float* rope; float* out;
    __device__ __forceinline__ void operator()(const Acc& acc, const Unit& u, int wr, int wc, int fr, int fq) const {
        const int pn = u.pn;
#pragma unroll
        for (int ai = 0; ai < 2; ++ai)
#pragma unroll
            for (int m = 0; m < 4; ++m) {
                const int row = u.pm * 256 + ai * 128 + wr * 64 + m * 16 + fr;
                const int pos = row < MP ? (row & (SEQ - 1)) : PAST + ((row - MP) & (DEC_L - 1));
                bf16_t* rowp = H + (size_t)row * D_IN + pn * 256 + wc * 32 + 8 * fq;
#pragma unroll
                for (int bj = 0; bj < 2; ++bj) {
                    f32x4 v0 = acc[ai][bj][m][0], v1 = acc[ai][bj][m][1];
                    if (pn >= 3) {
#pragma unroll
                        for (int j = 0; j < 4; j += 2) { const f32x2 a = gelu_tanh_pk((f32x2){v0[j], v0[j + 1]}), b = gelu_tanh_pk((f32x2){v1[j], v1[j + 1]}); v0[j] = a.x; v0[j + 1] = a.y; v1[j] = b.x; v1[j + 1] = b.y; }
                    } else {
                        const bool is_v = (pn == 2 && bj == 1);
                        if (!is_v && (wc & 1) == 0) {
                            f32x4 p0, p1;
#pragma unroll
                            for (int j = 0; j < 4; ++j) { p0[j] = __shfl_xor(v0[j], 16); p1[j] = __shfl_xor(v1[j], 16); }
                            if (fq < 2) {
                                const f32x4 c0 = *(const f32x4*)(rope + pos * 16), c1 = *(const f32x4*)(rope + pos * 16 + 4), s0 = *(const f32x4*)(rope + pos * 16 + 8), s1 = *(const f32x4*)(rope + pos * 16 + 12);
                                if (fq == 0) { v0 = v0 * c0 - p0 * s0; v1 = v1 * c1 - p1 * s1; }
                                else         { v0 = v0 * c0 + p0 * s0; v1 = v1 * c1 + p1 * s1; }
                            }
                        }
                        if (pn == 2) {
                            const int c = wc * 32 + 8 * fq;
                            float* o = nullptr;
                            if (row >= MP) o = out + (bj ? O_VS : O_KS) + (size_t)(row - MP) * 128 + c;
                            else if ((row & (SEQ - 1)) >= SEQ - 128) o = out + (bj ? O_VP : O_KP) + ((size_t)(row >> 11) * 128 + ((row & (SEQ - 1)) - (SEQ - 128))) * 128 + c;
                            if (o) { *(f32x4*)o = v0; *(f32x4*)(o + 4) = v1; }
                        } else { v0 = v0 * 0.18033688011112042f; v1 = v1 * 0.18033688011112042f; }
                    }
                    u32x4 w; w.x = cvt_pk_bf16(v0[0], v0[1]); w.y = cvt_pk_bf16(v0[2], v0[3]); w.z = cvt_pk_bf16(v1[0], v1[1]); w.w = cvt_pk_bf16(v1[2], v1[3]);
                    *(u32x4*)(rowp + bj * 128) = w;
                }
            }
    }
};
template <int WHICH> struct EpiLn {
    static constexpr bool FUSED = true;
    int set;
    __device__ __forceinline__ void init(Acc& acc, const Unit& u, int wid_, int lane_) const {
        int lane = lane_, wid = wid_; asm volatile("" : "+v"(lane)); asm volatile("" : "+s"(wid));
        const int fr = lane & 15, fq = lane >> 4, wr = wid >> 2, wc = wid & 3, tid = wid * 64 + lane;
        typedef const Params __attribute__((address_space(4)))* KP;
        KP pp = (KP)__builtin_amdgcn_kernarg_segment_ptr(); asm volatile("" : "+s"(pp));
        unsigned char* ws = pp->ws;
        if (u.kind == 2) {
            unsigned* flg = (unsigned*)(ws + WS_FLG) + set * 224 * 64;
            unsigned sp = 0;
            while ((unsigned)__builtin_amdgcn_readfirstlane(__hip_atomic_load(flg + 64 * u.slot, __ATOMIC_RELAXED, __HIP_MEMORY_SCOPE_AGENT)) < 8u) { __builtin_amdgcn_s_sleep(2); if (++sp > (1u << 22)) break; }
            asm volatile("" ::: "memory");
            const unsigned long long* sl = (const unsigned long long*)(ws + WS_SLAB) + (size_t)u.slot * 16384 + (size_t)tid;
#pragma unroll
            for (int ai = 0; ai < 2; ++ai)
#pragma unroll
                for (int bj = 0; bj < 2; ++bj)
#pragma unroll
                    for (int m = 0; m < 4; ++m)
#pragma unroll
                        for (int n = 0; n < 2; ++n) {
                            const unsigned long long a = __hip_atomic_load(sl, __ATOMIC_RELAXED, __HIP_MEMORY_SCOPE_AGENT);
                            sl += 512; asm volatile("" : "+v"(sl));
                            const unsigned lo = (unsigned)a, hi = (unsigned)(a >> 32);
                            acc[ai][bj][m][n] = (f32x4){bflo(lo), bfhi(lo), bflo(hi), bfhi(hi)}; }
            return;
        }
        const int rbase = u.pm * 256, col0 = u.pn * 256 + wc * 32 + 8 * fq;
#pragma unroll
        for (int ai = 0; ai < 2; ++ai)
#pragma unroll
            for (int m = 0; m < 4; ++m) { const int rl = ai * 128 + wr * 64 + m * 16 + fr;
#pragma unroll
                for (int bj = 0; bj < 2; ++bj) {
                    { const u32x4 h = *(const u32x4*)((const bf16_t*)(ws + (WHICH == 1 ? WS_XB : WS_HB)) + (size_t)(rbase + rl) * D + col0 + bj * 128);
                        acc[ai][bj][m][0] = (f32x4){bflo(h.x), bfhi(h.x), bflo(h.y), bfhi(h.y)} * ALPHA; acc[ai][bj][m][1] = (f32x4){bflo(h.z), bfhi(h.z), bflo(h.w), bfhi(h.w)} * ALPHA; } } }
    }
    __device__ __forceinline__ void fused(const Acc& acc, const Unit& u, int wr_, int wc_, int fr_, int fq_, LAS unsigned char* lx, int wid_, int lane_) const {
        int lane = lane_, wid = wid_; asm volatile("" : "+v"(lane)); asm volatile("" : "+s"(wid));
        const int fr = lane & 15, fq = lane >> 4, wr = wid >> 2, wc = wid & 3, tid = wid * 64 + lane;
        typedef const Params __attribute__((address_space(4)))* KP;
        KP pp = (KP)__builtin_amdgcn_kernarg_segment_ptr(); asm volatile("" : "+s"(pp));
        unsigned char* ws = pp->ws;
        if (u.kind == 1) {
            unsigned* flg = (unsigned*)(ws + WS_FLG) + set * 224 * 64;
            unsigned long long* sl = (unsigned long long*)(ws + WS_SLAB) + (size_t)u.slot * 16384 + (size_t)tid;
#pragma unroll
            for (int ai = 0; ai < 2; ++ai)
#pragma unroll
                for (int bj = 0; bj < 2; ++bj)
#pragma unroll
                    for (int m = 0; m < 4; ++m)
#pragma unroll
                        for (int n = 0; n < 2; ++n) { const f32x4 v = acc[ai][bj][m][n];
                            __hip_atomic_store(sl, ((unsigned long long)cvt_pk_bf16(v[2], v[3]) << 32) | cvt_pk_bf16(v[0], v[1]), __ATOMIC_RELAXED, __HIP_MEMORY_SCOPE_AGENT);
                            sl += 512; asm volatile("" : "+v"(sl)); }
            asm volatile("s_waitcnt vmcnt(0)" ::: "memory");
            if (lane == 0) __hip_atomic_fetch_add(flg + 64 * u.slot, 1u, __ATOMIC_RELAXED, __HIP_MEMORY_SCOPE_AGENT);
            return;
        }
        bf16_t* Hout = (bf16_t*)(ws + WS_HB); float* Y = pp->out + O_Y;
        const float* gam = WHICH == 1 ? pp->ln1_g : pp->ln2_g; const float* bet = WHICH == 1 ? pp->ln1_b : pp->ln2_b;
        unsigned long long* xbuf = (unsigned long long*)(ws + (WHICH == 1 ? WS_XB1 : WS_XB2)); unsigned* cnt = (unsigned*)(ws + WS_CNT) + set * 72 * 64;
        const int rbase = u.pm * 256, col0 = u.pn * 256 + wc * 32 + 8 * fq;
        LAS f32x2* P = (LAS f32x2*)lx;
        LAS f32x2* S = (LAS f32x2*)(lx + 8192);
#pragma unroll
        for (int ai = 0; ai < 2; ++ai)
#pragma unroll
            for (int m = 0; m < 4; ++m) {
                float s = 0.f;
#pragma unroll
                for (int bj = 0; bj < 2; ++bj)
#pragma unroll
                    for (int n = 0; n < 2; ++n) { const f32x4 x = acc[ai][bj][m][n]; s += (x[0] + x[1]) + (x[2] + x[3]); }
                s += __shfl_xor(s, 16); s += __shfl_xor(s, 32);
                const float mw = s * (1.0f / 64.0f); float q = 0.f;
#pragma unroll
                for (int bj = 0; bj < 2; ++bj)
#pragma unroll
                    for (int n = 0; n < 2; ++n) { const f32x4 d = acc[ai][bj][m][n] - mw; q += (d[0] * d[0] + d[1] * d[1]) + (d[2] * d[2] + d[3] * d[3]); }
                q += __shfl_xor(q, 16); q += __shfl_xor(q, 32);
                if (fq == 0) P[(ai * 128 + wr * 64 + m * 16 + fr) * 4 + wc] = (f32x2){mw, q};
            }
        asm volatile("s_waitcnt lgkmcnt(0)" ::: "memory"); __builtin_amdgcn_s_barrier(); asm volatile("" ::: "memory");
        const int row = wid * 32 + (lane & 31);
        if (lane < 32) {
            const f32x2 a = P[row * 4 + 0], b = P[row * 4 + 1], c = P[row * 4 + 2], d = P[row * 4 + 3];
            const float mt = (a.x + b.x + c.x + d.x) * 0.25f;
            const float da = a.x - mt, db = b.x - mt, dc = c.x - mt, dd = d.x - mt;
            const float m2 = (a.y + b.y) + (c.y + d.y) + 64.0f * ((da * da + db * db) + (dc * dc + dd * dd));
            __hip_atomic_store(xbuf + ((size_t)(rbase + row) * 4 + u.pn), ((unsigned long long)__float_as_uint(m2) << 32) | __float_as_uint(mt), __ATOMIC_RELAXED, __HIP_MEMORY_SCOPE_AGENT);
        }
        asm volatile("s_waitcnt vmcnt(0)" ::: "memory");
        if (lane == 0) __hip_atomic_fetch_add(cnt + 64 * u.pm, 1u, __ATOMIC_RELAXED, __HIP_MEMORY_SCOPE_AGENT);
        if (wid == 0) { unsigned sp = 0;
            while ((unsigned)__builtin_amdgcn_readfirstlane(__hip_atomic_load(cnt + 64 * u.pm, __ATOMIC_RELAXED, __HIP_MEMORY_SCOPE_AGENT)) < 32u) { __builtin_amdgcn_s_sleep(2); if (++sp > (1u << 22)) break; }
            asm volatile("" ::: "memory"); }
        asm volatile("s_waitcnt vmcnt(0) lgkmcnt(0)" ::: "memory"); __builtin_amdgcn_s_barrier(); asm volatile("" ::: "memory");
        if (lane < 32) {
            const unsigned long long* slot = xbuf + (size_t)(rbase + row) * 4; float mt[4], m2[4]; float ms = 0.f;
#pragma unroll
            for (int t = 0; t < 4; ++t) { const unsigned long long w = __hip_atomic_load(slot + t, __ATOMIC_RELAXED, __HIP_MEMORY_SCOPE_AGENT); mt[t] = __uint_as_float((unsigned)w); m2[t] = __uint_as_float((unsigned)(w >> 32)); ms += mt[t]; }
            const float mean = ms * 0.25f; float q = 0.f;
#pragma unroll
            for (int t = 0; t < 4; ++t) { const float dm = mt[t] - mean; q += m2[t] + 256.0f * dm * dm; }
            S[row] = (f32x2){mean, rsqrtf(q * (1.0f / 1024.0f) + LN_EPS)};
        }
        asm volatile("s_waitcnt lgkmcnt(0)" ::: "memory"); __builtin_amdgcn_s_barrier(); asm volatile("" ::: "memory");
        f32x4 g0[2], g1[2], b0[2], b1[2];
#pragma unroll
        for (int bj = 0; bj < 2; ++bj) { g0[bj] = *(const f32x4*)(gam + col0 + bj * 128); g1[bj] = *(const f32x4*)(gam + col0 + bj * 128 + 4); b0[bj] = *(const f32x4*)(bet + col0 + bj * 128); b1[bj] = *(const f32x4*)(bet + col0 + bj * 128 + 4); }
#pragma unroll
        for (int ai = 0; ai < 2; ++ai)
#pragma unroll
            for (int m = 0; m < 4; ++m) { const int rl = ai * 128 + wr * 64 + m * 16 + fr; const f32x2 st = S[rl];
#pragma unroll
                for (int bj = 0; bj < 2; ++bj) { const f32x4 y0 = (acc[ai][bj][m][0] - st.x) * st.y * g0[bj] + b0[bj], y1 = (acc[ai][bj][m][1] - st.x) * st.y * g1[bj] + b1[bj];
                    if (WHICH == 1) { u32x4 w; w.x = cvt_pk_bf16(y0[0], y0[1]); w.y = cvt_pk_bf16(y0[2], y0[3]); w.z = cvt_pk_bf16(y1[0], y1[1]); w.w = cvt_pk_bf16(y1[2], y1[3]);
                        *(u32x4*)(Hout + (size_t)(rbase + rl) * D + col0 + bj * 128) = w; }
                    else { float* yr = Y + (size_t)(rbase + rl) * D + col0 + bj * 128; __builtin_nontemporal_store(y0, (f32x4*)yr); __builtin_nontemporal_store(y1, (f32x4*)(yr + 4)); } } }
        asm volatile("s_waitcnt lgkmcnt(0)" ::: "memory"); __builtin_amdgcn_s_barrier(); asm volatile("" ::: "memory");
    }
};
struct EpiSwiglu {
    static constexpr bool FUSED = false;
    bf16_t* ACT;
    __device__ __forceinline__ void operator()(const Acc& acc, const Unit& u, int wr, int wc, int fr, int fq) const {
        const int col0 = u.pn * 128 + wc * 32 + 8 * fq;
#pragma unroll
        for (int ai = 0; ai < 2; ++ai)
#pragma unroll
            for (int m = 0; m < 4; ++m) { const int row = u.pm * 256 + ai * 128 + wr * 64 + m * 16 + fr;
                f32x4 a0 = acc[ai][0][m][0], a1 = acc[ai][0][m][1]; const f32x4 b0 = acc[ai][1][m][0], b1 = acc[ai][1][m][1];
#pragma unroll
                for (int j = 0; j < 4; j += 2) { const f32x2 p0 = silu_mul_pk((f32x2){a0[j], a0[j + 1]}, (f32x2){b0[j], b0[j + 1]}), p1 = silu_mul_pk((f32x2){a1[j], a1[j + 1]}, (f32x2){b1[j], b1[j + 1]});
                    a0[j] = p0.x; a0[j + 1] = p0.y; a1[j] = p1.x; a1[j + 1] = p1.y; }
                u32x4 w; w.x = cvt_pk_bf16(a0[0], a0[1]); w.y = cvt_pk_bf16(a0[2], a0[3]); w.z = cvt_pk_bf16(a1[0], a1[1]); w.w = cvt_pk_bf16(a1[2], a1[3]);
                *(u32x4*)(ACT + (size_t)row * D_FF + col0) = w; }
    }
};

__device__ __forceinline__ void transpose_tile(const float* W, bf16_t* Bt, int K, int N, int tk, int tn, int mode, LAS float* tile) {
    const int t = threadIdx.x;
    { const int r = t >> 4, c4 = (t & 15) * 4;
#pragma unroll
      for (int i = 0; i < 2; ++i) { const int k = r + 32 * i; const f32x4 v = *(const f32x4*)(W + (size_t)(tk * 64 + k) * N + tn * 64 + c4);
          tile[k * 65 + c4] = v[0]; tile[k * 65 + c4 + 1] = v[1]; tile[k * 65 + c4 + 2] = v[2]; tile[k * 65 + c4 + 3] = v[3]; } }
    __syncthreads();
    { const int n = t >> 3, k8 = (t & 7) * 8; float v[8];
#pragma unroll
      for (int j = 0; j < 8; ++j) v[j] = tile[(k8 + j) * 65 + n];
      int ng = tn * 64 + n;
      if (mode == 1) { const int up = ng >= D_FF; const int n2 = up ? ng - D_FF : ng; ng = 256 * (n2 >> 7) + (n2 & 127) + (up ? 128 : 0); }
      u32x4 w; w.x = cvt_pk_bf16(v[0], v[1]); w.y = cvt_pk_bf16(v[2], v[3]); w.z = cvt_pk_bf16(v[4], v[5]); w.w = cvt_pk_bf16(v[6], v[7]);
      *(u32x4*)(Bt + (size_t)ng * K + tk * 64 + k8) = w; }
    __syncthreads();
}
__device__ void late_transposes(const Params& p, LAS unsigned char* lds, int first, int stride, int part, int end) {
    LAS float* tile = (LAS float*)lds;
    bf16_t* W2 = (bf16_t*)(p.ws + WS_W2); bf16_t* W3 = (bf16_t*)(p.ws + WS_W3); bf16_t* W4 = (bf16_t*)(p.ws + WS_W4);
    constexpr int T2 = 16 * 16, T3 = 16 * 88, T4 = 44 * 16;
    if (part == 0) {
        for (int i = first; i < T2 + T3 && i < end; i += stride) {
            if (i < T2) transpose_tile(p.w_out, W2, D, D, i / 16, i % 16, 0, tile);
            else { const int j = i - T2; transpose_tile(p.w_gu, W3, D, 2 * D_FF, j / 88, j % 88, 1, tile); }
        }
    } else for (int j = first; j < T4 && j < end; j += stride) transpose_tile(p.w_down, W4, D_FF, D, j / 16, j % 16, 0, tile);
}
__device__ void prologue(const Params& p, LAS unsigned char* lds) {
    const int G = gridDim.x, bid = blockIdx.x, t = threadIdx.x;
    LAS float* tile = (LAS float*)lds;
    bf16_t* W1 = (bf16_t*)(p.ws + WS_W1);
    for (int i = bid; i < 16 * 28; i += G) transpose_tile(p.w_in, W1, D, D_IN, i / 28, i % 28, 0, tile);
    bf16_t* XB = (bf16_t*)(p.ws + WS_XB);
    const size_t n8 = (size_t)M * D / 8, np8 = (size_t)MP * D / 8;
    for (size_t i = (size_t)bid * NTHREADS + t; i < n8; i += (size_t)G * NTHREADS) {
        const float* src = i < np8 ? p.x_prompt + i * 8 : p.x_sample + (i - np8) * 8;
        const f32x4 a = *(const f32x4*)src, b = *(const f32x4*)(src + 4);
        u32x4 w; w.x = cvt_pk_bf16(a[0], a[1]); w.y = cvt_pk_bf16(a[2], a[3]); w.z = cvt_pk_bf16(b[0], b[1]); w.w = cvt_pk_bf16(b[2], b[3]);
        *(u32x4*)(XB + i * 8) = w;
    }
    float* rope = (float*)(p.ws + WS_ROPE);
    for (int i = bid * NTHREADS + t; i < 2048 * 8; i += G * NTHREADS) {
        const int pos = i >> 3, k = i & 7;
        const float inv = (float)exp(-(double)k * 0.125 * 13.122363377404328);
        const double ang = (double)((float)pos * inv);
        rope[pos * 16 + k] = (float)cos(ang); rope[pos * 16 + 8 + k] = (float)sin(ang);
    }
    bf16_t* WSB = (bf16_t*)(p.ws + WS_WS);
    for (int i = bid * NTHREADS + t; i < 8 * 128 * 128 / 2; i += G * NTHREADS) {
        const int e = i * 2, ri = (e >> 7) & 127, cj = e & 127; const bool ok = !(ri < 64 && cj >= 64);
        const f32x2 v = *(const f32x2*)(p.w_sp + e);
        *(unsigned*)(WSB + e) = ok ? cvt_pk_bf16(v[0], v[1]) : 0u;
    }
}

constexpr int KS_STRIDE = 72, VT_STRIDE = 200;
constexpr int LDS_KS = 0, LDS_VT = LDS_KS + 2 * 192 * KS_STRIDE * 2, LDS_ASSQ = LDS_VT + 2 * 64 * VT_STRIDE * 2;
__device__ void attn_unit(const Params& p, LAS unsigned char* lds, int unit) {
    int t_ = threadIdx.x; asm volatile("" : "+v"(t_));
    const int t = t_, wid = t >> 6, lane = t & 63, fr = lane & 15, fq = lane >> 4;
    const bool samp = unit >= 256; const int b = samp ? unit - 256 : unit >> 5, c = samp ? 2 : (unit & 31);
    const int r0 = samp ? MP + b * 64 : b * SEQ + c * 64;
    const int kstart = samp ? 0 : (c >= 2 ? 0 : (2 - c) * 64);
    const bf16_t* H = (const bf16_t*)(p.ws + WS_H);
    LAS bf16_t* Ks = (LAS bf16_t*)(lds + LDS_KS); LAS bf16_t* Vt = (LAS bf16_t*)(lds + LDS_VT); LAS float* ssq = (LAS float*)(lds + LDS_ASSQ);
    const int h = wid;
    bf16x8 qf[4][2];
#pragma unroll
    for (int qt = 0; qt < 4; ++qt)
#pragma unroll
        for (int ks = 0; ks < 2; ++ks) qf[qt][ks] = *(const bf16x8*)(H + (size_t)(r0 + qt * 16 + fr) * D_IN + C_Q + h * 64 + ks * 32 + fq * 8);
#pragma unroll
    for (int qi = 0; qi < 6; ++qi) { const int q = t + qi * NTHREADS;
        const int key = q >> 4, cc = q & 15, kvh = cc >> 3, d0 = (cc & 7) * 8;
        u32x4 kw = {0u, 0u, 0u, 0u}, vw = {0u, 0u, 0u, 0u};
        if (key >= kstart) {
            if (samp && key < 128) {
                const float* ck = p.cache_k + ((size_t)(b * 128 + key) * 2 + kvh) * 64 + d0; const float* cv = p.cache_v + ((size_t)(b * 128 + key) * 2 + kvh) * 64 + d0;
                const f32x4 a0 = *(const f32x4*)ck, a1 = *(const f32x4*)(ck + 4), b0 = *(const f32x4*)cv, b1 = *(const f32x4*)(cv + 4);
                kw.x = cvt_pk_bf16(a0[0], a0[1]); kw.y = cvt_pk_bf16(a0[2], a0[3]); kw.z = cvt_pk_bf16(a1[0], a1[1]); kw.w = cvt_pk_bf16(a1[2], a1[3]);
                vw.x = cvt_pk_bf16(b0[0], b0[1]); vw.y = cvt_pk_bf16(b0[2], b0[3]); vw.z = cvt_pk_bf16(b1[0], b1[1]); vw.w = cvt_pk_bf16(b1[2], b1[3]);
            } else {
                const bf16_t* hr = H + (size_t)(r0 - 128 + key) * D_IN;
                kw = *(const u32x4*)(hr + C_K + kvh * 64 + d0); vw = *(const u32x4*)(hr + C_V + kvh * 64 + d0);
            }
        }
        *(LAS u32x4*)(Ks + (kvh * 192 + key) * KS_STRIDE + d0) = kw;
        LAS bf16_t* vt = Vt + (kvh * 64 + d0) * VT_STRIDE + ((((key >> 3) ^ (cc & 7)) << 3) | (key & 7));
        vt[0 * VT_STRIDE] = (bf16_t)(vw.x & 0xffff); vt[1 * VT_STRIDE] = (bf16_t)(vw.x >> 16); vt[2 * VT_STRIDE] = (bf16_t)(vw.y & 0xffff); vt[3 * VT_STRIDE] = (bf16_t)(vw.y >> 16);
        vt[4 * VT_STRIDE] = (bf16_t)(vw.z & 0xffff); vt[5 * VT_STRIDE] = (bf16_t)(vw.z >> 16); vt[6 * VT_STRIDE] = (bf16_t)(vw.w & 0xffff); vt[7 * VT_STRIDE] = (bf16_t)(vw.w >> 16);
    }
    __syncthreads();
    const int kvh = h >> 2;
    const float sink = p.sinks[h] * 1.4426950408889634f;
    f32x4 o[4][4];
#pragma unroll
    for (int qp = 0; qp < 2; ++qp) {
        f32x4 s[2][12];
#pragma unroll
        for (int kt = 0; kt < 12; ++kt) {
            s[0][kt] = (f32x4){0.f, 0.f, 0.f, 0.f}; s[1][kt] = (f32x4){0.f, 0.f, 0.f, 0.f};
#pragma unroll
            for (int ks = 0; ks < 2; ++ks) { const bf16x8 kf = *(const LAS bf16x8*)(Ks + (kvh * 192 + kt * 16 + fr) * KS_STRIDE + ks * 32 + fq * 8);
                s[0][kt] = __builtin_amdgcn_mfma_f32_16x16x32_bf16(kf, qf[2 * qp][ks], s[0][kt], 0, 0, 0);
                s[1][kt] = __builtin_amdgcn_mfma_f32_16x16x32_bf16(kf, qf[2 * qp + 1][ks], s[1][kt], 0, 0, 0); }
        }
        if (kstart > 0) {
#pragma unroll
            for (int kt = 0; kt < 12; ++kt) if (kt * 16 < kstart) { s[0][kt] = (f32x4){-1e30f, -1e30f, -1e30f, -1e30f}; s[1][kt] = s[0][kt]; } }
        float inv[2];
#pragma unroll
        for (int e = 0; e < 2; ++e) {
            float mx = sink;
#pragma unroll
            for (int kt = 0; kt < 12; ++kt) mx = fmaxf(mx, fmaxf(fmaxf(s[e][kt][0], s[e][kt][1]), fmaxf(s[e][kt][2], s[e][kt][3])));
            mx = fmaxf(mx, __shfl_xor(mx, 16)); mx = fmaxf(mx, __shfl_xor(mx, 32));
            float sum = 0.f;
#pragma unroll
            for (int kt = 0; kt < 12; ++kt) {
#pragma unroll
                for (int j = 0; j < 4; ++j) { const float ex = __builtin_amdgcn_exp2f(s[e][kt][j] - mx); s[e][kt][j] = ex; sum += ex; } }
            sum += __shfl_xor(sum, 16); sum += __shfl_xor(sum, 32);
            inv[e] = 1.0f / (sum + __builtin_amdgcn_exp2f(sink - mx));
#pragma unroll
            for (int dt = 0; dt < 4; ++dt) o[2 * qp + e][dt] = (f32x4){0.f, 0.f, 0.f, 0.f};
        }
#pragma unroll
        for (int kp = 0; kp < 6; ++kp) {
            bf16x8 pf[2];
#pragma unroll
            for (int e = 0; e < 2; ++e) { u32x4 pw; pw.x = cvt_pk_bf16(s[e][2 * kp][0], s[e][2 * kp][1]); pw.y = cvt_pk_bf16(s[e][2 * kp][2], s[e][2 * kp][3]);
                pw.z = cvt_pk_bf16(s[e][2 * kp + 1][0], s[e][2 * kp + 1][1]); pw.w = cvt_pk_bf16(s[e][2 * kp + 1][2], s[e][2 * kp + 1][3]); pf[e] = __builtin_bit_cast(bf16x8, pw); }
#pragma unroll
            for (int dt = 0; dt < 4; ++dt) {
                const LAS bf16_t* vrow = Vt + (kvh * 64 + dt * 16 + fr) * VT_STRIDE; const int sw = (dt * 2 + (fr >> 3)) & 7;
                const int k0 = kp * 32 + fq * 4, k1 = k0 + 16;
                const u32x2 va = *(const LAS u32x2*)(vrow + ((((k0 >> 3) ^ sw) << 3) | (k0 & 7))), vb = *(const LAS u32x2*)(vrow + ((((k1 >> 3) ^ sw) << 3) | (k1 & 7)));
                const u32x4 vv = {va.x, va.y, vb.x, vb.y};
                o[2 * qp][dt] = __builtin_amdgcn_mfma_f32_16x16x32_bf16(__builtin_bit_cast(bf16x8, vv), pf[0], o[2 * qp][dt], 0, 0, 0);
                o[2 * qp + 1][dt] = __builtin_amdgcn_mfma_f32_16x16x32_bf16(__builtin_bit_cast(bf16x8, vv), pf[1], o[2 * qp + 1][dt], 0, 0, 0);
            }
        }
#pragma unroll
        for (int e = 0; e < 2; ++e) { const int qt = 2 * qp + e;
            float q2 = 0.f;
#pragma unroll
            for (int dt = 0; dt < 4; ++dt) { o[qt][dt] = o[qt][dt] * inv[e];
#pragma unroll
                for (int j = 0; j < 4; ++j) q2 += o[qt][dt][j] * o[qt][dt][j]; }
            q2 += __shfl_xor(q2, 16); q2 += __shfl_xor(q2, 32);
            if (fq == 0) ssq[h * 64 + qt * 16 + fr] = q2; }
    }
    __syncthreads();
    bf16_t* CAT = (bf16_t*)(p.ws + WS_CAT);
#pragma unroll
    for (int qt = 0; qt < 4; ++qt) {
        float tot = 0.f;
#pragma unroll
        for (int hh = 0; hh < 8; ++hh) tot += ssq[hh * 64 + qt * 16 + fr];
        const float rs = rsqrtf(tot * (1.0f / 512.0f) + LN_EPS);
#pragma unroll
        for (int dt = 0; dt < 4; ++dt) { const int col = h * 64 + dt * 16 + fq * 4; const f32x4 g = *(const f32x4*)(p.g_attn + col); const f32x4 v = o[qt][dt] * rs * g;
            u32x2 w; w.x = cvt_pk_bf16(v[0], v[1]); w.y = cvt_pk_bf16(v[2], v[3]);
            *(u32x2*)(CAT + (size_t)(r0 + qt * 16 + fr) * D + col) = w; }
    }
    __syncthreads();
}

constexpr int VM_STRIDE = 136;
constexpr int LDS_VMT = 0, LDS_GST = LDS_VMT + 8 * 64 * VM_STRIDE * 2, LDS_GSSQ = LDS_GST + 128 * 2 * 4;
__device__ void gate_unit(const Params& p, LAS unsigned char* lds, int unit) {
    int t_ = threadIdx.x; asm volatile("" : "+v"(t_));
    const int t = t_, wid = t >> 6, lane = t & 63, fr = lane & 15, fq = lane >> 4;
    const bool samp = unit >= 256; const int w_ = unit & 127; const int b = samp ? unit - 256 : w_ >> 4, c = samp ? 0 : 2 * (w_ & 15) + (unit < 128 ? 1 : 0), par = c & 1;
    const int r0 = samp ? MP + b * 64 : b * SEQ + c * 64;
    const int Kc = par ? 128 : 64, jr0 = par ? r0 - 64 : r0;
    const bf16_t* H = (const bf16_t*)(p.ws + WS_H);
    LAS bf16_t* VmT = (LAS bf16_t*)(lds + LDS_VMT); LAS float* st = (LAS float*)(lds + LDS_GST); LAS float* ssq = (LAS float*)(lds + LDS_GSSQ);
    const int g = wid, jl = lane >> 3, c8 = (lane & 7) * 8, col = g * 64 + c8;
    LAS f32x2* part = (LAS f32x2*)(lds + LDS_VMT);
    u32x4 raw[16];
#pragma unroll
    for (int it = 0; it < 16; ++it) if (it * 8 < Kc) raw[it] = *(const u32x4*)(H + (size_t)(jr0 + it * 8 + jl) * D_IN + C_VM + col);
#pragma unroll
    for (int it = 0; it < 16; ++it) if (it * 8 < Kc) {
        const u32x4 w = raw[it];
        const float v0 = bflo(w.x), v1 = bfhi(w.x), v2 = bflo(w.y), v3 = bfhi(w.y), v4 = bflo(w.z), v5 = bfhi(w.z), v6 = bflo(w.w), v7 = bfhi(w.w);
        float sm = ((v0 + v1) + (v2 + v3)) + ((v4 + v5) + (v6 + v7));
        float sq = ((v0 * v0 + v1 * v1) + (v2 * v2 + v3 * v3)) + ((v4 * v4 + v5 * v5) + (v6 * v6 + v7 * v7));
        sm += __shfl_xor(sm, 1); sq += __shfl_xor(sq, 1); sm += __shfl_xor(sm, 2); sq += __shfl_xor(sq, 2); sm += __shfl_xor(sm, 4); sq += __shfl_xor(sq, 4);
        if ((lane & 7) == 0) part[(it * 8 + jl) * 8 + g] = (f32x2){sm, sq};
    }
    __syncthreads();
    if (t < Kc) { float sm = 0.f, sq = 0.f;
#pragma unroll
        for (int gg = 0; gg < 8; ++gg) { const f32x2 pv = part[t * 8 + gg]; sm += pv.x; sq += pv.y; }
        const float mean = sm * (1.0f / 512.0f), var = fmaxf(sq * (1.0f / 512.0f) - mean * mean, 0.f);
        st[t * 2] = mean; st[t * 2 + 1] = rsqrtf(var + LN_EPS); }
    __syncthreads();
    { const f32x4 ga0 = *(const f32x4*)(p.ln_v_g + col), ga1 = *(const f32x4*)(p.ln_v_g + col + 4), be0 = *(const f32x4*)(p.ln_v_b + col), be1 = *(const f32x4*)(p.ln_v_b + col + 4);
#pragma unroll
      for (int it = 0; it < 16; ++it) if (it * 8 < Kc) { const int j = it * 8 + jl;
          const u32x4 w = raw[it];
          const float mean = st[j * 2], rstd = st[j * 2 + 1];
          f32x4 v0 = {bflo(w.x), bfhi(w.x), bflo(w.y), bfhi(w.y)}, v1 = {bflo(w.z), bfhi(w.z), bflo(w.w), bfhi(w.w)};
          v0 = (v0 - mean) * rstd * ga0 + be0; v1 = (v1 - mean) * rstd * ga1 + be1;
          if (samp) { float* o = p.out + O_MS + (size_t)(b * 64 + j) * 512 + col; *(f32x4*)o = v0; *(f32x4*)(o + 4) = v1; }
          const unsigned w0 = cvt_pk_bf16(v0[0], v0[1]), w1 = cvt_pk_bf16(v0[2], v0[3]), w2 = cvt_pk_bf16(v1[0], v1[1]), w3 = cvt_pk_bf16(v1[2], v1[3]);
          LAS bf16_t* d = VmT + (g * 64 + c8) * VM_STRIDE + ((it ^ (lane & 7)) * 8 + jl);
          d[0 * VM_STRIDE] = (bf16_t)(w0 & 0xffff); d[1 * VM_STRIDE] = (bf16_t)(w0 >> 16); d[2 * VM_STRIDE] = (bf16_t)(w1 & 0xffff); d[3 * VM_STRIDE] = (bf16_t)(w1 >> 16);
          d[4 * VM_STRIDE] = (bf16_t)(w2 & 0xffff); d[5 * VM_STRIDE] = (bf16_t)(w2 >> 16); d[6 * VM_STRIDE] = (bf16_t)(w3 & 0xffff); d[7 * VM_STRIDE] = (bf16_t)(w3 >> 16); } }
    __syncthreads();
    const bf16_t* WSB = (const bf16_t*)(p.ws + WS_WS) + (size_t)g * 128 * 128 + (size_t)(par * 64) * 128;
    f32x4 acc[4][4];
#pragma unroll
    for (int it = 0; it < 4; ++it)
#pragma unroll
        for (int dt = 0; dt < 4; ++dt) acc[it][dt] = (f32x4){0.f, 0.f, 0.f, 0.f};
    bf16x8 wf[4][4];
#pragma unroll
    for (int ks = 0; ks < 4; ++ks) if (ks * 32 < Kc) {
#pragma unroll
        for (int it = 0; it < 4; ++it) wf[ks][it] = *(const bf16x8*)(WSB + (size_t)(it * 16 + fr) * 128 + ks * 32 + fq * 8); }
#pragma unroll
    for (int ks = 0; ks < 4; ++ks) if (ks * 32 < Kc) {
        bf16x8 vf[4];
#pragma unroll
        for (int dt = 0; dt < 4; ++dt) vf[dt] = *(const LAS bf16x8*)(VmT + (g * 64 + dt * 16 + fr) * VM_STRIDE + (((ks * 4 + fq) ^ ((dt * 2 + (fr >> 3)) & 7)) * 8));
#pragma unroll
        for (int it = 0; it < 4; ++it)
#pragma unroll
            for (int dt = 0; dt < 4; ++dt) acc[it][dt] = __builtin_amdgcn_mfma_f32_16x16x32_bf16(vf[dt], wf[ks][it], acc[it][dt], 0, 0, 0);
    }
    u32x2 uw[4][4];
#pragma unroll
    for (int it = 0; it < 4; ++it)
#pragma unroll
        for (int dt = 0; dt < 4; ++dt) uw[it][dt] = *(const u32x2*)(H + (size_t)(r0 + it * 16 + fr) * D_IN + C_U + g * 64 + dt * 16 + fq * 4);
#pragma unroll
    for (int it = 0; it < 4; ++it) {
        const float bs = p.b_sp[g * 128 + par * 64 + it * 16 + fr]; float q2 = 0.f;
#pragma unroll
        for (int dt = 0; dt < 4; ++dt) { const f32x4 uv = {bflo(uw[it][dt].x), bfhi(uw[it][dt].x), bflo(uw[it][dt].y), bfhi(uw[it][dt].y)};
            acc[it][dt] = (acc[it][dt] + bs) * uv;
#pragma unroll
            for (int j = 0; j < 4; ++j) q2 += acc[it][dt][j] * acc[it][dt][j]; }
        q2 += __shfl_xor(q2, 16); q2 += __shfl_xor(q2, 32);
        if (fq == 0) ssq[g * 64 + it * 16 + fr] = q2;
    }
    __syncthreads();
    bf16_t* CAT = (bf16_t*)(p.ws + WS_CAT);
#pragma unroll
    for (int it = 0; it < 4; ++it) {
        float tot = 0.f;
#pragma unroll
        for (int gg = 0; gg < 8; ++gg) tot += ssq[gg * 64 + it * 16 + fr];
        const float rs = rsqrtf(tot * (1.0f / 512.0f) + LN_EPS);
#pragma unroll
        for (int dt = 0; dt < 4; ++dt) { const int col = g * 64 + dt * 16 + fq * 4; const f32x4 gm = *(const f32x4*)(p.g_cmlp + col); const f32x4 v = acc[it][dt] * rs * gm;
            u32x2 w; w.x = cvt_pk_bf16(v[0], v[1]); w.y = cvt_pk_bf16(v[2], v[3]);
            *(u32x2*)(CAT + (size_t)(r0 + it * 16 + fr) * D + 512 + col) = w; }
    }
    __syncthreads();
}

template <bool TO_BF16>
__device__ void ln_rows(const float* Z, const float* gam, const float* bet, bf16_t* Hb, float* Y) {
    const int lane = threadIdx.x & 63, gw = blockIdx.x * 8 + (threadIdx.x >> 6), nw = gridDim.x * 8;
    f32x4 g[4], be[4];
#pragma unroll
    for (int i = 0; i < 4; ++i) { g[i] = *(const f32x4*)(gam + i * 256 + lane * 4); be[i] = *(const f32x4*)(bet + i * 256 + lane * 4); }
    for (int row = gw; row < M; row += nw) {
        const float* z = Z + (size_t)row * D; f32x4 v[4]; float s = 0.f;
#pragma unroll
        for (int i = 0; i < 4; ++i) { v[i] = *(const f32x4*)(z + i * 256 + lane * 4); s += (v[i][0] + v[i][1]) + (v[i][2] + v[i][3]); }
#pragma unroll
        for (int o = 1; o < 64; o <<= 1) s += __shfl_xor(s, o);
        const float mean = s * (1.0f / 1024.0f); float q = 0.f;
#pragma unroll
        for (int i = 0; i < 4; ++i) { v[i] = v[i] - mean; q += (v[i][0] * v[i][0] + v[i][1] * v[i][1]) + (v[i][2] * v[i][2] + v[i][3] * v[i][3]); }
#pragma unroll
        for (int o = 1; o < 64; o <<= 1) q += __shfl_xor(q, o);
        const float rstd = rsqrtf(q * (1.0f / 1024.0f) + LN_EPS);
#pragma unroll
        for (int i = 0; i < 4; ++i) { const f32x4 y = v[i] * rstd * g[i] + be[i];
            if (TO_BF16) { u32x2 w; w.x = cvt_pk_bf16(y[0], y[1]); w.y = cvt_pk_bf16(y[2], y[3]); *(u32x2*)(Hb + (size_t)row * D + i * 256 + lane * 4) = w; }
            else *(f32x4*)(Y + (size_t)row * D + i * 256 + lane * 4) = y; }
    }
}

__global__ void __launch_bounds__(NTHREADS, 2) fwd_mega(Params p) {
    extern __shared__ __attribute__((aligned(16))) unsigned char smem[];
    LAS unsigned char* lds = (LAS unsigned char*)smem;
    const int G = gridDim.x, bid = blockIdx.x;
    volatile LAS unsigned* xst = (volatile LAS unsigned*)(lds + LDS_BYTES - 16);
    if (threadIdx.x == 0) { xst[0] = 0u; xst[1] = 0u; }
    __syncthreads();
    XcdBarrier xb = xcd_barrier_post((unsigned*)(p.ws + WS_BAR) + (NBAR > 1 ? p.pad * 4096 : 0), xst);
#define IN(ph) (p.ph_lo <= (ph) && (ph) < p.ph_hi)
#define REP(ph) for (int _r = 0; _r < ((ph) == PROBE_PH ? 3 : 1); ++_r)
#define SYNC(ph) do { if (p.coop && IN(ph) && IN((ph) + 1)) xcd_barrier(xb); } while (0)
    if (IN(0)) REP(0) prologue(p, lds);
    SYNC(0);
    if (IN(1)) { pg8::Gemm g{(const bf16_t*)(p.ws + WS_XB), (const bf16_t*)(p.ws + WS_W1), M, D_IN, D}; pg8::StaticOrder S; S.init(M, D_IN, D, G, bid);
        EpiProj E{(bf16_t*)(p.ws + WS_H), (const float*)(p.ws + WS_ROPE), p.out}; pg8::gemm_phase(lds, g, S, E); }
    SYNC(1);
    if (IN(2)) {
        if (G == 256) {
            for (int k = 0; k < 3; ++k) {
                int u = -1;
                if (k == 0) u = bid;
                else if (k == 1) u = bid < 32 ? 256 + bid : (bid < 160 ? 288 + (bid - 32) : 288 + 128 + (bid - 160));
                else if (bid >= 160 && bid < 224) u = 288 + 224 + (bid - 160);
                if (u < 0) break;
                if (u < 288) attn_unit(p, lds, u); else gate_unit(p, lds, u - 288);
            }
            int t0 = 0, tn = 0;
            if (bid < 32) { t0 = bid * 9; tn = 9; } else if (bid < 160) { t0 = 288 + (bid - 32) * 8; tn = 8; } else if (bid >= 224) { t0 = 1312 + (bid - 224) * 11; tn = 11; }
            if (tn) late_transposes(p, lds, t0, 1, 0, t0 + tn);
        } }
    SYNC(2);
    if (IN(3)) { for (int rep = 0; rep < (PROBE_PH == 3 ? 3 : 1); ++rep) { if (rep) xcd_barrier(xb);
        pg8::Gemm g{(const bf16_t*)(p.ws + WS_CAT), (const bf16_t*)(p.ws + WS_W2), M, D, D}; pg8::TeamOrder S; S.init(D, bid, P3_STREAMK);
        EpiLn<1> E{(PROBE_PH == 10 ? p.pad * 2 : 0) + rep}; pg8::gemm_phase(lds, g, S, E); } }
    SYNC(3);
    if (IN(4)) REP(5) { pg8::Gemm g{(const bf16_t*)(p.ws + WS_HB), (const bf16_t*)(p.ws + WS_W3), M, 2 * D_FF, D}; pg8::StaticOrder S; S.init(M, 2 * D_FF, D, G, bid);
        EpiSwiglu E{(bf16_t*)(p.ws + WS_ACT)}; pg8::gemm_phase(lds, g, S, E);
        if (G == 256 && bid >= 48) late_transposes(p, lds, bid - 48, 208, 1, 1 << 30); }
    SYNC(4);
    if (IN(5)) { for (int rep = 0; rep < (PROBE_PH == 6 ? 3 : 1); ++rep) { if (rep) xcd_barrier(xb);
        pg8::Gemm g{(const bf16_t*)(p.ws + WS_ACT), (const bf16_t*)(p.ws + WS_W4), M, D, D_FF}; pg8::TeamOrder S; S.init(D_FF, bid, 1);
        EpiLn<2> E{(PROBE_PH == 10 ? p.pad * 2 + 1 : (PROBE_PH == 3 || PROBE_PH == 6) ? 3 : 1) + rep}; pg8::gemm_phase(lds, g, S, E); } }
#undef IN
#undef SYNC
}

#undef REP
#ifndef N_LAUNCHES
#define N_LAUNCHES 1
#endif
extern "C" void kernel_launch(void* const* d_in, const int* in_sizes, int n_in, void* d_out, int out_size, void* d_ws, size_t ws_size, hipStream_t stream) {
    static int grid = 0;
    if (grid == 0) {
        int dev = 0, cus = 0, per_cu = 0;
        hipGetDevice(&dev); hipDeviceGetAttribute(&cus, hipDeviceAttributeMultiprocessorCount, dev);
        if (hipFuncSetAttribute((const void*)fwd_mega, hipFuncAttributeMaxDynamicSharedMemorySize, LDS_BYTES) != hipSuccess) { fprintf(stderr, "hipFuncSetAttribute failed\n"); grid = -1; return; }
        if (hipOccupancyMaxActiveBlocksPerMultiprocessor(&per_cu, (const void*)fwd_mega, NTHREADS, LDS_BYTES) != hipSuccess || per_cu < 1) { fprintf(stderr, "occupancy query: %d\n", per_cu); per_cu = 1; }
        (void)hipGetLastError();
        grid = cus * (per_cu > 1 ? 1 : per_cu);
        if (grid != 256) { fprintf(stderr, "this kernel needs a grid of exactly 256 workgroups (one per CU), got %d\n", grid); grid = -1; return; }
        if (ws_size < WS_END) { fprintf(stderr, "workspace too small: %zu < %zu\n", ws_size, WS_END); grid = -1; return; }
    }
    if (grid < 0) return;
    if (hipMemsetAsync((char*)d_ws + WS_BAR, 0, WS_ZERO_BYTES, stream) != hipSuccess) { fprintf(stderr, "memset failed\n"); return; }
    Params p{};
    p.x_prompt = (const float*)d_in[0]; p.x_sample = (const float*)d_in[1]; p.cache_k = (const float*)d_in[2]; p.cache_v = (const float*)d_in[3]; p.w_in = (const float*)d_in[4];
    p.ln_v_g = (const float*)d_in[5]; p.ln_v_b = (const float*)d_in[6]; p.sinks = (const float*)d_in[7]; p.w_sp = (const float*)d_in[8]; p.b_sp = (const float*)d_in[9];
    p.g_attn = (const float*)d_in[10]; p.g_cmlp = (const float*)d_in[11]; p.w_out = (const float*)d_in[12]; p.ln1_g = (const float*)d_in[13]; p.ln1_b = (const float*)d_in[14];
    p.w_gu = (const float*)d_in[15]; p.w_down = (const float*)d_in[16]; p.ln2_g = (const float*)d_in[17]; p.ln2_b = (const float*)d_in[18];
    p.out = (float*)d_out; p.ws = (unsigned char*)d_ws;
#if N_LAUNCHES == 1
    p.ph_lo = 0; p.ph_hi = 6; p.coop = 1;
    void* args[] = {&p};
    hipError_t e = hipLaunchCooperativeKernel((const void*)fwd_mega, dim3(grid), dim3(NTHREADS), args, LDS_BYTES, stream);
#if PROBE_PH == 10
    p.pad = 1; e = hipLaunchCooperativeKernel((const void*)fwd_mega, dim3(grid), dim3(NTHREADS), args, LDS_BYTES, stream);
#endif
    if (e != hipSuccess) fprintf(stderr, "cooperative launch failed: %s (grid %d)\n", hipGetErrorString(e), grid);
#else
    for (int ph = 0; ph < 6; ++ph) { p.ph_lo = ph; p.ph_hi = ph + 1; p.coop = 0;
        hipLaunchKernelGGL(fwd_mega, dim3(grid), dim3(NTHREADS), LDS_BYTES, stream, p); }
#endif
}
```

```cpp
#include <hip/hip_runtime.h>
#include <hip/hip_cooperative_groups.h>
#include <cstdio>
#include <cstdint>
namespace cg = cooperative_groups;

#define LAS __attribute__((address_space(3)))
typedef unsigned short bf16_t;
typedef short bf16x8 __attribute__((ext_vector_type(8)));
typedef short bf16x4 __attribute__((ext_vector_type(4)));
typedef float f32x4 __attribute__((ext_vector_type(4)));
typedef float f32x2 __attribute__((ext_vector_type(2)));
typedef unsigned u32x4 __attribute__((ext_vector_type(4)));
typedef unsigned u32x2 __attribute__((ext_vector_type(2)));

#ifndef GEMM_SP2
#define GEMM_SP2 1
#endif
#ifndef GEMM_ALIGN_EPI
#define GEMM_ALIGN_EPI 1
#endif
#ifndef P3_STREAMK
#define P3_STREAMK 1
#endif
#ifndef PROBE_PH
#define PROBE_PH -1
#endif
constexpr int D = 1024, SEQ = 2048, NB = 8, DEC_B = 32, DEC_L = 64, PAST = 1024;
constexpr int MP = NB * SEQ, MS = DEC_B * DEC_L, M = MP + MS;
constexpr int D_IN = 1792, D_FF = 2816;
constexpr int C_Q = 0, C_K = 512, C_V = 640, C_U = 768, C_VM = 1280;
constexpr float ALPHA = 1.189207115002721f;
constexpr float LN_EPS = 1e-5f;
constexpr size_t O_Y = 0, O_KP = (size_t)M * D, O_VP = O_KP + 131072, O_KS = O_VP + 131072, O_VS = O_KS + 262144, O_MS = O_VS + 262144;
constexpr size_t WS_XB = 0;
constexpr size_t WS_H = WS_XB + (size_t)M * D * 2;
constexpr size_t WS_ACT = 0;
constexpr size_t WS_W1 = (size_t)M * D_FF * 2;
constexpr size_t WS_W2 = WS_W1 + (size_t)D_IN * D * 2;
constexpr size_t WS_W3 = WS_W2 + (size_t)D * D * 2;
constexpr size_t WS_W4 = WS_W3 + (size_t)2 * D_FF * D * 2;
constexpr size_t WS_WS = WS_W4 + (size_t)D * D_FF * 2;
constexpr size_t WS_ROPE = WS_WS + (size_t)8 * 128 * 128 * 2;
constexpr size_t WS_CAT = WS_ROPE + (size_t)2048 * 16 * 4;
constexpr size_t WS_HB = WS_CAT + (size_t)M * D * 2;
constexpr size_t WS_BAR = WS_HB + (size_t)M * D * 2;
constexpr int NSETS = (PROBE_PH == 3 || PROBE_PH == 6 || PROBE_PH == 10) ? 6 : 2, NBAR = PROBE_PH == 10 ? 2 : 1;
constexpr size_t WS_CNT = WS_BAR + (size_t)NBAR * 16384;
constexpr size_t WS_FLG = WS_CNT + (size_t)NSETS * 72 * 256;
constexpr size_t WS_ZERO_BYTES = (size_t)NBAR * 16384 + (size_t)NSETS * 72 * 256 + (size_t)NSETS * 224 * 256;
constexpr size_t WS_XB1 = WS_FLG + (size_t)NSETS * 224 * 256;
constexpr size_t WS_XB2 = WS_XB1 + (size_t)M * 4 * 8;
constexpr size_t WS_SLAB = WS_XB2 + (size_t)M * 4 * 8;
constexpr size_t WS_END = WS_SLAB + (size_t)224 * 131072;
constexpr int LDS_BYTES = 147456;
constexpr int NTHREADS = 512;

struct Params {
    const float *x_prompt, *x_sample, *cache_k, *cache_v, *w_in, *ln_v_g, *ln_v_b, *sinks, *w_sp, *b_sp, *g_attn, *g_cmlp, *w_out, *ln1_g, *ln1_b, *w_gu, *w_down, *ln2_g, *ln2_b;
    float* out;
    unsigned char* ws;
    int ph_lo, ph_hi, coop, pad;
};

__device__ __forceinline__ unsigned cvt_pk_bf16(float lo, float hi) { unsigned r; asm volatile("v_cvt_pk_bf16_f32 %0, %1, %2" : "=v"(r) : "v"(lo), "v"(hi)); return r; }
__device__ __forceinline__ float bf2f(unsigned short b) { return __uint_as_float(((unsigned)b) << 16); }
__device__ __forceinline__ float bflo(unsigned w) { return __uint_as_float(w << 16); }
__device__ __forceinline__ float bfhi(unsigned w) { return __uint_as_float(w & 0xffff0000u); }
__device__ __forceinline__ float fast_sigmoid(float x) { return __builtin_amdgcn_rcpf(1.0f + __builtin_amdgcn_exp2f(-1.4426950408889634f * x)); }
__device__ __forceinline__ float gelu_tanh(float x) { const float u = 1.5957691216057308f * (x + 0.044715f * x * x * x); return x * fast_sigmoid(u); }
__device__ __forceinline__ float silu(float x) { return x * fast_sigmoid(x); }
__device__ __forceinline__ f32x2 silu_mul_pk(f32x2 g, f32x2 u) {
    const f32x2 m = g * (-1.4426950408889634f);
    f32x2 e; e.x = __builtin_amdgcn_exp2f(m.x); e.y = __builtin_amdgcn_exp2f(m.y);
    const f32x2 d = e + 1.0f;
    f32x2 r; r.x = __builtin_amdgcn_rcpf(d.x); r.y = __builtin_amdgcn_rcpf(d.y);
    return (g * r) * u;
}
__device__ __forceinline__ f32x2 gelu_tanh_pk(f32x2 x) {
    const f32x2 f = (x * x) * (-0.10294324f) + (-2.3022082f);
    const f32x2 w = x * f;
    f32x2 e; e.x = __builtin_amdgcn_exp2f(w.x); e.y = __builtin_amdgcn_exp2f(w.y);
    const f32x2 d = e + 1.0f;
    f32x2 r; r.x = __builtin_amdgcn_rcpf(d.x); r.y = __builtin_amdgcn_rcpf(d.y);
    return x * r;
}


#define XB_TMO      128
#define XB_XCNT(j)  (256  + 64 * (j))
#define XB_XSUB(j)  (1280 + 64 * (j))
#define XB_XGEN(j)  (2304 + 64 * (j))
#define XB_TOP      3328
#define XB_TOPGEN   3392
#define XCD_BAR_WORDS 3456
#define XB_SPIN_CAP (1u << 18)
__device__ __forceinline__ unsigned xb_ld(unsigned* p)              { return __hip_atomic_load(p, __ATOMIC_RELAXED, __HIP_MEMORY_SCOPE_AGENT); }
__device__ __forceinline__ unsigned xb_add(unsigned* p, unsigned v) { return __hip_atomic_fetch_add(p, v, __ATOMIC_RELAXED, __HIP_MEMORY_SCOPE_AGENT); }
__device__ __forceinline__ unsigned xb_xcc_id() { return (unsigned)__builtin_amdgcn_s_getreg((3 << 11) | 20) & 0xFu; }
#define XB_SPIN(cond, bar) do { unsigned _sp = 0; while (cond) { __builtin_amdgcn_s_sleep(1); \
    if ((++_sp & 255u) == 0u) { if (xb_ld(&(bar)[XB_TMO])) break; if (_sp > XB_SPIN_CAP) { atomicAdd(&(bar)[XB_TMO], 1u); break; } } } } while (0)
struct XcdBarrier { unsigned* bar; unsigned x; volatile LAS unsigned* st; };
__device__ __forceinline__ XcdBarrier xcd_barrier_post(unsigned* bar, volatile LAS unsigned* st) {
    XcdBarrier b; b.bar = bar; b.x = xb_xcc_id(); b.st = st;
    if (threadIdx.x == 0) (void)xb_add(&bar[XB_XCNT(b.x)], 1u);
    return b;
}
__device__ __forceinline__ void xcd_barrier_complete(unsigned* bar, unsigned x, unsigned& nloc, unsigned& nx) {
    const unsigned G = gridDim.x * gridDim.y * gridDim.z;
    unsigned sum, cnt, mine, sp = 0u;
    for (;;) {
        sum = 0u; cnt = 0u; mine = 0u;
#pragma unroll
        for (unsigned j = 0; j < 16; ++j) { const unsigned c = xb_ld(&bar[XB_XCNT(j)]); sum += c; cnt += (c > 0u) ? 1u : 0u; mine = (j == x) ? c : mine; }
        if (sum == G) break;
        __builtin_amdgcn_s_sleep(1);
        if ((++sp & 255u) == 0u) { if (xb_ld(&bar[XB_TMO])) break; if (sp > XB_SPIN_CAP) { atomicAdd(&bar[XB_TMO], 1u); break; } }
    }
    nloc = mine > 0u ? mine : 1u; nx = cnt > 0u ? cnt : 1u;
}
__device__ __forceinline__ void xcd_barrier(const XcdBarrier& b) {
    asm volatile("s_waitcnt vmcnt(0)" ::: "memory");
    __syncthreads();
    if (threadIdx.x == 0) {
        unsigned* bar = b.bar;
        __builtin_amdgcn_s_waitcnt(0);
        unsigned nloc = b.st[0], nx = b.st[1];
        if (nloc == 0u) { xcd_barrier_complete(bar, b.x, nloc, nx); b.st[0] = nloc; b.st[1] = nx; }
        const unsigned old = xb_add(&bar[XB_XSUB(b.x)], 1u);
        const unsigned gen = old / nloc;
        if (old + 1u == (gen + 1u) * nloc) {
            __builtin_amdgcn_fence(__ATOMIC_RELEASE, "agent");
            asm volatile("s_waitcnt vmcnt(0)" ::: "memory");
            const unsigned og = xb_add(&bar[XB_TOP], 1u);
            const unsigned tg = og / nx;
            if (og + 1u == (tg + 1u) * nx) xb_add(&bar[XB_TOPGEN], 1u);
            else XB_SPIN(xb_ld(&bar[XB_TOPGEN]) == tg, bar);
            __builtin_amdgcn_fence(__ATOMIC_ACQUIRE, "agent");
            xb_add(&bar[XB_XGEN(b.x)], 1u);
            asm volatile("s_waitcnt vmcnt(0)" ::: "memory");
        } else {
            __builtin_amdgcn_fence(__ATOMIC_ACQUIRE, "agent");
            XB_SPIN(xb_ld(&bar[XB_XGEN(b.x)]) == gen, bar);
            asm volatile("s_waitcnt vmcnt(0)" ::: "memory");
        }
    }
    __syncthreads();
}

namespace pg8 {
constexpr int BM = 256, BK = 64, HALF = 128, HTB = HALF * BK * 2, STAGE_BYTES = 8 * HTB, NXCD = 8, WGM = 8;
__host__ __device__ __forceinline__ int lds_byte(int r, int c) { const int st = (r >> 4) * 2 + (c >> 5), rr = r & 15, cc = c & 31, ob = rr * 64 + cc * 2; return st * 1024 + (ob ^ (((ob >> 9) & 1) << 5)); }
__host__ __device__ __forceinline__ void stage_rc(int b, int& R, int& C) { const int st = b / 1024, sb = b % 1024, swz = sb ^ (((sb >> 9) & 1) << 5); R = (st >> 1) * 16 + swz / 64; C = (st & 1) * 32 + (swz % 64) / 2; }
__host__ __device__ __forceinline__ int perm32(int rho) { const int n = rho >> 4, i = rho & 15; return 8 * (i >> 2) + 4 * n + (i & 3); }
struct Unit { int pm, pn, k0, nt, kind, slot; };
struct Gemm { const bf16_t* A; const bf16_t* Bt; int M, N, K; };
struct StaticOrder {
    int nM, nN, nwg, G, c, ntile;
    __host__ __device__ void init(int M_, int N_, int K_, int G_, int c_) { nM = M_ / BM; nN = N_ / BM; nwg = nM * nN; G = G_; c = c_; ntile = K_ / BK; }
    __host__ __device__ bool next(int i, Unit& u) const {
        const long L = (long)i * G + c; if (L >= nwg) return false;
        int wgid = (int)L; { const int q = nwg / NXCD, r = nwg % NXCD, xcd = wgid % NXCD, off = wgid / NXCD; wgid = (xcd < r ? xcd * (q + 1) : r * (q + 1) + (xcd - r) * q) + off; }
        const int nig = WGM * nN, gid = wgid / nig, fm = gid * WGM, gsz = (nM - fm) < WGM ? (nM - fm) : WGM;
        u.pm = fm + ((wgid % nig) % gsz); u.pn = (wgid % nig) / gsz; u.k0 = 0; u.nt = ntile; u.kind = 0; u.slot = 0; return true;
    }
};

struct TeamOrder {
    int x, j, pn, npair, streamk;
    __host__ __device__ void init(int K_, int c_, int streamk_) { x = c_ & 7; const int l = c_ >> 3; j = l >> 2; pn = l & 3; npair = K_ / (2 * BK); streamk = streamk_; }
    __host__ __device__ bool next(int i, Unit& u) const {
        if (!streamk) { const int q = i * 8 + j; if (q >= 9) return false; u.pm = 9 * x + q; u.pn = pn; u.k0 = 0; u.nt = 2 * npair; u.kind = 0; u.slot = 0; return true; }
        const int total = 9 * npair, R1 = ((j + 1) * total) / 8; int p = (j * total) / 8;
        for (int ii = 0; ; ++ii) {
            if (p >= R1) return false;
            const int panel = p / npair, off = p - panel * npair, tend = (panel + 1) * npair, end = R1 < tend ? R1 : tend;
            if (ii == i) { u.pm = 9 * x + panel; u.pn = pn; u.k0 = off * 2; u.nt = (end - p) * 2; u.kind = off > 0 ? 1 : (end < tend ? 2 : 0);
                u.slot = x * 28 + (u.kind == 1 ? j - 1 : j) * 4 + pn; return true; }
            p = end;
        }
    }
};
template <class Epi, class Sched>
__device__ __forceinline__ void gemm_phase(LAS unsigned char* lds, const Gemm g, const Sched& S, const Epi& E) {
    const int tid = threadIdx.x, wid = __builtin_amdgcn_readfirstlane(tid >> 6), lane = tid & 63, wr = wid >> 2, wc = wid & 3, fr = lane & 15, fq = lane >> 4;
    const int K = g.K;
    unsigned voffA[2], voffB[2];
#pragma unroll
    for (int i = 0; i < 2; ++i) { int R, C; stage_rc(tid * 16 + i * 8192, R, C); const int Rb = (R & ~31) + perm32(R & 31);
        voffA[i] = (unsigned)(R * K + C) * 2u; voffB[i] = (unsigned)(Rb * K + C) * 2u; }
    const size_t kstep = (size_t)(BK * 2);
    const size_t hstep = (size_t)HALF * K * 2;
    const size_t tstep = 2 * hstep;
    const unsigned ldsw = (unsigned)wid * 1024u;
    const int aoff = lds_byte(wr * 64 + fr, fq * 8), boff = lds_byte(wc * 32 + fr, fq * 8);
#define PG8_SA(b, h) (((b) * 2 + (h)) * HTB)
#define PG8_SB(b, h) ((4 + (b) * 2 + (h)) * HTB)
#define PG8_STAGE(bufoff, gbase, voff) do { _Pragma("unroll") for (int _i = 0; _i < 2; ++_i) \
        __builtin_amdgcn_global_load_lds((const unsigned*)((const char*)(gbase) + (voff)[_i]), (LAS unsigned*)(lds + (bufoff) + ldsw + _i * 8192), 16, 0, 0); } while (0)
#define PG8_LDA(dst, b, h) do { _Pragma("unroll") for (int m = 0; m < 4; ++m) _Pragma("unroll") for (int k = 0; k < 2; ++k) dst[m][k] = *(const LAS bf16x8*)(lds + PG8_SA(b, h) + aoff + m * 2048 + k * 1024); } while (0)
#define PG8_LDB(dst, b, h) do { _Pragma("unroll") for (int n = 0; n < 2; ++n) _Pragma("unroll") for (int k = 0; k < 2; ++k) dst[n][k] = *(const LAS bf16x8*)(lds + PG8_SB(b, h) + boff + n * 2048 + k * 1024); } while (0)
#define PG8_MMA(ai, bj, At, Bt) do { __builtin_amdgcn_s_setprio(1); _Pragma("unroll") for (int m = 0; m < 4; ++m) _Pragma("unroll") for (int n = 0; n < 2; ++n) _Pragma("unroll") for (int k = 0; k < 2; ++k) \
        acc[ai][bj][m][n] = __builtin_amdgcn_mfma_f32_16x16x32_bf16(Bt[n][k], At[m][k], acc[ai][bj][m][n], 0, 0, 0); __builtin_amdgcn_s_setprio(0); } while (0)
#define PG8_WAIT_V(n) asm volatile("s_waitcnt vmcnt(" #n ")" ::: "memory")
#define PG8_WAIT_L(n) asm volatile("s_waitcnt lgkmcnt(" #n ")" ::: "memory")
#define PG8_BAR __builtin_amdgcn_s_barrier()
#define PG8_SCHED __builtin_amdgcn_sched_barrier(0)
    Unit cur, nxt; int ui = 0;
    if (!S.next(0, cur)) return;
    f32x4 acc[2][2][4][2];
    if constexpr (Epi::FUSED) E.init(acc, cur, wid, lane);
    else {
#pragma unroll
    for (int a = 0; a < 2; ++a)
#pragma unroll
        for (int b = 0; b < 2; ++b)
#pragma unroll
            for (int m = 0; m < 4; ++m)
#pragma unroll
                for (int n = 0; n < 2; ++n) acc[a][b][m][n] = (f32x4){0.f, 0.f, 0.f, 0.f};
    }
    bf16x8 At[4][2], B0[2][2], B1[2][2];
    const char* cA = (const char*)g.A + (size_t)cur.pm * tstep + (size_t)cur.k0 * kstep; const char* cB = (const char*)g.Bt + (size_t)cur.pn * tstep + (size_t)cur.k0 * kstep;
#if GEMM_SP2
    PG8_STAGE(PG8_SB(0, 0), cB, voffB); PG8_STAGE(PG8_SB(0, 1), cB + hstep, voffB); PG8_STAGE(PG8_SA(0, 0), cA, voffA); PG8_STAGE(PG8_SA(0, 1), cA + hstep, voffA);
    if (wr == 1) PG8_BAR;
    PG8_WAIT_V(2); PG8_BAR;
    PG8_STAGE(PG8_SB(1, 0), cB + kstep, voffB); PG8_STAGE(PG8_SA(1, 0), cA + kstep, voffA); PG8_STAGE(PG8_SB(1, 1), cB + hstep + kstep, voffB);
    PG8_WAIT_V(6); PG8_BAR;
#else
    PG8_STAGE(PG8_SB(0, 0), cB, voffB); PG8_STAGE(PG8_SA(0, 0), cA, voffA); PG8_STAGE(PG8_SB(0, 1), cB + hstep, voffB); PG8_STAGE(PG8_SA(0, 1), cA + hstep, voffA);
    if (wr == 1) PG8_BAR;
    PG8_WAIT_V(4); PG8_BAR;
    PG8_STAGE(PG8_SB(1, 0), cB + kstep, voffB); PG8_STAGE(PG8_SA(1, 0), cA + kstep, voffA); PG8_STAGE(PG8_SB(1, 1), cB + hstep + kstep, voffB);
    PG8_WAIT_V(6); PG8_BAR;
#endif
    for (;;) {
        const bool has_next = S.next(ui + 1, nxt);
        const char* nA = has_next ? (const char*)g.A + (size_t)nxt.pm * tstep + (size_t)nxt.k0 * kstep : cA; const char* nB = has_next ? (const char*)g.Bt + (size_t)nxt.pn * tstep + (size_t)nxt.k0 * kstep : cB;
        const int nt = cur.nt;
        for (int t = 0; t < nt; t += 2) {
            const bool last = (t == nt - 2);
            const char* a1 = cA + (size_t)(t + 1) * kstep;
            const char* a2 = last ? nA : cA + (size_t)(t + 2) * kstep; const char* b2 = last ? nB : cB + (size_t)(t + 2) * kstep;
            const char* a3 = a2 + kstep; const char* b3 = b2 + kstep;
#if GEMM_SP2
            PG8_LDB(B0, 0, 0); PG8_LDB(B1, 0, 1); PG8_SCHED; PG8_LDA(At, 0, 0); PG8_STAGE(PG8_SA(1, 1), a1 + hstep, voffA);
            PG8_WAIT_V(8); PG8_WAIT_L(0); PG8_BAR; PG8_MMA(0, 0, At, B0); PG8_MMA(0, 1, At, B1); PG8_BAR; PG8_SCHED;
            PG8_LDA(At, 0, 1); PG8_STAGE(PG8_SB(0, 0), b2, voffB); PG8_STAGE(PG8_SB(0, 1), b2 + hstep, voffB); PG8_STAGE(PG8_SA(0, 0), a2, voffA);
            PG8_WAIT_V(8); PG8_WAIT_L(0); PG8_BAR; PG8_MMA(1, 0, At, B0); PG8_MMA(1, 1, At, B1); PG8_BAR; PG8_SCHED;
            PG8_LDB(B0, 1, 0); PG8_LDB(B1, 1, 1); PG8_SCHED; PG8_LDA(At, 1, 0); PG8_STAGE(PG8_SA(0, 1), a2 + hstep, voffA);
            PG8_WAIT_V(8); PG8_WAIT_L(0); PG8_BAR; PG8_MMA(0, 0, At, B0); PG8_MMA(0, 1, At, B1); PG8_BAR; PG8_SCHED;
            PG8_LDA(At, 1, 1); PG8_STAGE(PG8_SB(1, 0), b3, voffB); PG8_STAGE(PG8_SB(1, 1), b3 + hstep, voffB); PG8_STAGE(PG8_SA(1, 0), a3, voffA);
            PG8_WAIT_V(8); PG8_WAIT_L(0); PG8_BAR; PG8_MMA(1, 0, At, B0); PG8_MMA(1, 1, At, B1); PG8_BAR; PG8_SCHED;
#else
            PG8_LDB(B0, 0, 0); PG8_SCHED; PG8_LDA(At, 0, 0); PG8_STAGE(PG8_SA(1, 1), a1 + hstep, voffA);
            PG8_WAIT_L(8); PG8_BAR; PG8_WAIT_L(0); PG8_MMA(0, 0, At, B0); PG8_BAR; PG8_SCHED;
            PG8_LDB(B1, 0, 1); PG8_STAGE(PG8_SB(0, 0), b2, voffB);
            PG8_BAR; PG8_WAIT_L(0); PG8_MMA(0, 1, At, B1); PG8_BAR;
            PG8_LDA(At, 0, 1); PG8_STAGE(PG8_SA(0, 0), a2, voffA);
            PG8_BAR; PG8_WAIT_L(0); PG8_MMA(1, 0, At, B0); PG8_BAR; PG8_SCHED;
            PG8_STAGE(PG8_SB(0, 1), b2 + hstep, voffB);
            PG8_WAIT_V(6); PG8_BAR; PG8_MMA(1, 1, At, B1); PG8_BAR;
            PG8_LDB(B0, 1, 0); PG8_SCHED; PG8_LDA(At, 1, 0); PG8_STAGE(PG8_SA(0, 1), a2 + hstep, voffA);
            PG8_WAIT_L(8); PG8_BAR; PG8_WAIT_L(0); PG8_MMA(0, 0, At, B0); PG8_BAR; PG8_SCHED;
            PG8_LDB(B1, 1, 1); PG8_STAGE(PG8_SB(1, 0), b3, voffB);
            PG8_BAR; PG8_WAIT_L(0); PG8_MMA(0, 1, At, B1); PG8_BAR;
            PG8_LDA(At, 1, 1); PG8_STAGE(PG8_SA(1, 0), a3, voffA);
            PG8_BAR; PG8_WAIT_L(0); PG8_MMA(1, 0, At, B0); PG8_BAR; PG8_SCHED;
            PG8_STAGE(PG8_SB(1, 1), b3 + hstep, voffB);
            PG8_WAIT_V(6); PG8_BAR; PG8_MMA(1, 1, At, B1); PG8_BAR;
#endif
        }
        if constexpr (Epi::FUSED) {
            if (wr == 0) PG8_BAR;
            E.fused(acc, cur, wr, wc, fr, fq, lds + STAGE_BYTES, wid, lane);
            if (wr == 1) PG8_BAR;
        } else {
#if GEMM_ALIGN_EPI
            if (wr == 0) PG8_BAR;
            E(acc, cur, wr, wc, fr, fq);
            if (wr == 1) PG8_BAR;
#else
            E(acc, cur, wr, wc, fr, fq);
#endif
        }
        if (!has_next) break;
        if constexpr (Epi::FUSED) E.init(acc, nxt, wid, lane);
        else {
#pragma unroll
        for (int a = 0; a < 2; ++a)
#pragma unroll
            for (int b = 0; b < 2; ++b)
#pragma unroll
                for (int m = 0; m < 4; ++m)
#pragma unroll
                    for (int n = 0; n < 2; ++n) acc[a][b][m][n] = (f32x4){0.f, 0.f, 0.f, 0.f};
        }
        cur = nxt; cA = nA; cB = nB; ++ui;
    }
    PG8_WAIT_V(0);
    if (wr == 0) PG8_BAR;
    PG8_BAR;
#undef PG8_SA
#undef PG8_SB
#undef PG8_STAGE
#undef PG8_LDA
#undef PG8_LDB
#undef PG8_MMA
#undef PG8_WAIT_V
#undef PG8_WAIT_L
#undef PG8_BAR
#undef PG8_SCHED
}
}
using pg8::Unit;
typedef f32x4 Acc[2][2][4][2];


struct EpiProj {
    static constexpr bool FUSED = false;
    bf16_t* H; const float* rope; float* out;
    __device__ __forceinline__ void operator()(const Acc& acc, const Unit& u, int wr, int wc, int fr, int fq) const {
        const int pn = u.pn;
#pragma unroll
        for (int ai = 0; ai < 2; ++ai)
#pragma unroll
            for (int m = 0; m < 4; ++m) {
                const int row = u.pm * 256 + ai * 128 + wr * 64 + m * 16 + fr;
                const int pos = row < MP ? (row & (SEQ - 1)) : PAST + ((row - MP) & (DEC_L - 1));
                bf16_t* rowp = H + (size_t)row * D_IN + pn * 256 + wc * 32 + 8 * fq;
#pragma unroll
                for (int bj = 0; bj < 2; ++bj) {
                    f32x4 v0 = acc[ai][bj][m][0], v1 = acc[ai][bj][m][1];
                    if (pn >= 3) {
#pragma unroll
                        for (int j = 0; j < 4; j += 2) { const f32x2 a = gelu_tanh_pk((f32x2){v0[j], v0[j + 1]}), b = gelu_tanh_pk((f32x2){v1[j], v1[j + 1]}); v0[j] = a.x; v0[j + 1] = a.y; v1[j] = b.x; v1[j + 1] = b.y; }
                    } else {
                        const bool is_v = (pn == 2 && bj == 1);
                        if (!is_v) {
                            f32x4 p0, p1;
#pragma unroll
                            for (int j = 0; j < 4; ++j) { p0[j] = __shfl_xor(v0[j], 16); p1[j] = __shfl_xor(v1[j], 16); }
                            if ((wc & 1) == 0 && fq < 2) {
                                const f32x4 c0 = *(const f32x4*)(rope + pos * 16), c1 = *(const f32x4*)(rope + pos * 16 + 4), s0 = *(const f32x4*)(rope + pos * 16 + 8), s1 = *(const f32x4*)(rope + pos * 16 + 12);
                                if (fq == 0) { v0 = v0 * c0 - p0 * s0; v1 = v1 * c1 - p1 * s1; }
                                else         { v0 = v0 * c0 + p0 * s0; v1 = v1 * c1 + p1 * s1; }
                            }
                        }
                        if (pn == 2) {
                            const int c = wc * 32 + 8 * fq;
                            float* o = nullptr;
                            if (row >= MP) o = out + (bj ? O_VS : O_KS) + (size_t)(row - MP) * 128 + c;
                            else if ((row & (SEQ - 1)) >= SEQ - 128) o = out + (bj ? O_VP : O_KP) + ((size_t)(row >> 11) * 128 + ((row & (SEQ - 1)) - (SEQ - 128))) * 128 + c;
                            if (o) { *(f32x4*)o = v0; *(f32x4*)(o + 4) = v1; }
                        } else { v0 = v0 * 0.18033688011112042f; v1 = v1 * 0.18033688011112042f; }
                    }
                    u32x4 w; w.x = cvt_pk_bf16(v0[0], v0[1]); w.y = cvt_pk_bf16(v0[2], v0[3]); w.z = cvt_pk_bf16(v1[0], v1[1]); w.w = cvt_pk_bf16(v1[2], v1[3]);
                    *(u32x4*)(rowp + bj * 128) = w;
                }
            }
    }
};
template <int WHICH> struct EpiLn {
    static constexpr bool FUSED = true;
    int set;
    __device__ __forceinline__ void init(Acc& acc, const Unit& u, int wid_, int lane_) const {
        int lane = lane_, wid = wid_; asm volatile("" : "+v"(lane)); asm volatile("" : "+s"(wid));
        const int fr = lane & 15, fq = lane >> 4, wr = wid >> 2, wc = wid & 3, tid = wid * 64 + lane;
        typedef const Params __attribute__((address_space(4)))* KP;
        KP pp = (KP)__builtin_amdgcn_kernarg_segment_ptr(); asm volatile("" : "+s"(pp));
        unsigned char* ws = pp->ws;
        if (u.kind == 2) {
            unsigned* flg = (unsigned*)(ws + WS_FLG) + set * 224 * 64;
            unsigned sp = 0;
            while ((unsigned)__builtin_amdgcn_readfirstlane(__hip_atomic_load(flg + 64 * u.slot, __ATOMIC_RELAXED, __HIP_MEMORY_SCOPE_AGENT)) < 8u) { __builtin_amdgcn_s_sleep(2); if (++sp > (1u << 22)) break; }
            asm volatile("" ::: "memory");
            const unsigned long long* sl = (const unsigned long long*)(ws + WS_SLAB) + (size_t)u.slot * 16384 + (size_t)tid;
#pragma unroll
            for (int ai = 0; ai < 2; ++ai)
#pragma unroll
                for (int bj = 0; bj < 2; ++bj)
#pragma unroll
                    for (int m = 0; m < 4; ++m)
#pragma unroll
                        for (int n = 0; n < 2; ++n) {
                            const unsigned long long a = __hip_atomic_load(sl, __ATOMIC_RELAXED, __HIP_MEMORY_SCOPE_AGENT);
                            sl += 512; asm volatile("" : "+v"(sl));
                            const unsigned lo = (unsigned)a, hi = (unsigned)(a >> 32);
                            acc[ai][bj][m][n] = (f32x4){bflo(lo), bfhi(lo), bflo(hi), bfhi(hi)}; }
            return;
        }
        const int rbase = u.pm * 256, col0 = u.pn * 256 + wc * 32 + 8 * fq;
#pragma unroll
        for (int ai = 0; ai < 2; ++ai)
#pragma unroll
            for (int m = 0; m < 4; ++m) { const int rl = ai * 128 + wr * 64 + m * 16 + fr;
#pragma unroll
                for (int bj = 0; bj < 2; ++bj) {
                    { const u32x4 h = *(const u32x4*)((const bf16_t*)(ws + (WHICH == 1 ? WS_XB : WS_HB)) + (size_t)(rbase + rl) * D + col0 + bj * 128);
                        acc[ai][bj][m][0] = (f32x4){bflo(h.x), bfhi(h.x), bflo(h.y), bfhi(h.y)} * ALPHA; acc[ai][bj][m][1] = (f32x4){bflo(h.z), bfhi(h.z), bflo(h.w), bfhi(h.w)} * ALPHA; } } }
    }
    __device__ __forceinline__ void fused(const Acc& acc, const Unit& u, int wr_, int wc_, int fr_, int fq_, LAS unsigned char* lx, int wid_, int lane_) const {
        int lane = lane_, wid = wid_; asm volatile("" : "+v"(lane)); asm volatile("" : "+s"(wid));
        const int fr = lane & 15, fq = lane >> 4, wr = wid >> 2, wc = wid & 3, tid = wid * 64 + lane;
        typedef const Params __attribute__((address_space(4)))* KP;
        KP pp = (KP)__builtin_amdgcn_kernarg_segment_ptr(); asm volatile("" : "+s"(pp));
        unsigned char* ws = pp->ws;
        if (u.kind == 1) {
            unsigned* flg = (unsigned*)(ws + WS_FLG) + set * 224 * 64;
            unsigned long long* sl = (unsigned long long*)(ws + WS_SLAB) + (size_t)u.slot * 16384 + (size_t)tid;
#pragma unroll
            for (int ai = 0; ai < 2; ++ai)
#pragma unroll
                for (int bj = 0; bj < 2; ++bj)
#pragma unroll
                    for (int m = 0; m < 4; ++m)
#pragma unroll
                        for (int n = 0; n < 2; ++n) { const f32x4 v = acc[ai][bj][m][n];
                            __hip_atomic_store(sl, ((unsigned long long)cvt_pk_bf16(v[2], v[3]) << 32) | cvt_pk_bf16(v[0], v[1]), __ATOMIC_RELAXED, __HIP_MEMORY_SCOPE_AGENT);
                            sl += 512; asm volatile("" : "+v"(sl)); }
            asm volatile("s_waitcnt vmcnt(0)" ::: "memory");
            if (lane == 0) __hip_atomic_fetch_add(flg + 64 * u.slot, 1u, __ATOMIC_RELAXED, __HIP_MEMORY_SCOPE_AGENT);
            return;
        }
        bf16_t* Hout = (bf16_t*)(ws + WS_HB); float* Y = pp->out + O_Y;
        const float* gam = WHICH == 1 ? pp->ln1_g : pp->ln2_g; const float* bet = WHICH == 1 ? pp->ln1_b : pp->ln2_b;
        unsigned long long* xbuf = (unsigned long long*)(ws + (WHICH == 1 ? WS_XB1 : WS_XB2)); unsigned* cnt = (unsigned*)(ws + WS_CNT) + set * 72 * 64;
        const int rbase = u.pm * 256, col0 = u.pn * 256 + wc * 32 + 8 * fq;
        LAS f32x2* P = (LAS f32x2*)lx;
        LAS f32x2* S = (LAS f32x2*)(lx + 8192);
#pragma unroll
        for (int ai = 0; ai < 2; ++ai)
#pragma unroll
            for (int m = 0; m < 4; ++m) {
                float s = 0.f;
#pragma unroll
                for (int bj = 0; bj < 2; ++bj)
#pragma unroll
                    for (int n = 0; n < 2; ++n) { const f32x4 x = acc[ai][bj][m][n]; s += (x[0] + x[1]) + (x[2] + x[3]); }
                s += __shfl_xor(s, 16); s += __shfl_xor(s, 32);
                const float mw = s * (1.0f / 64.0f); float q = 0.f;
#pragma unroll
                for (int bj = 0; bj < 2; ++bj)
#pragma unroll
                    for (int n = 0; n < 2; ++n) { const f32x4 d = acc[ai][bj][m][n] - mw; q += (d[0] * d[0] + d[1] * d[1]) + (d[2] * d[2] + d[3] * d[3]); }
                q += __shfl_xor(q, 16); q += __shfl_xor(q, 32);
                if (fq == 0) P[(ai * 128 + wr * 64 + m * 16 + fr) * 4 + wc] = (f32x2){mw, q};
            }
        asm volatile("s_waitcnt lgkmcnt(0)" ::: "memory"); __builtin_amdgcn_s_barrier(); asm volatile("" ::: "memory");
        const int row = wid * 32 + (lane & 31);
        if (lane < 32) {
            const f32x2 a = P[row * 4 + 0], b = P[row * 4 + 1], c = P[row * 4 + 2], d = P[row * 4 + 3];
            const float mt = (a.x + b.x + c.x + d.x) * 0.25f;
            const float da = a.x - mt, db = b.x - mt, dc = c.x - mt, dd = d.x - mt;
            const float m2 = (a.y + b.y) + (c.y + d.y) + 64.0f * ((da * da + db * db) + (dc * dc + dd * dd));
            __hip_atomic_store(xbuf + ((size_t)(rbase + row) * 4 + u.pn), ((unsigned long long)__float_as_uint(m2) << 32) | __float_as_uint(mt), __ATOMIC_RELAXED, __HIP_MEMORY_SCOPE_AGENT);
        }
        asm volatile("s_waitcnt vmcnt(0)" ::: "memory");
        if (lane == 0) __hip_atomic_fetch_add(cnt + 64 * u.pm, 1u, __ATOMIC_RELAXED, __HIP_MEMORY_SCOPE_AGENT);
        if (wid == 0) { unsigned sp = 0;
            while ((unsigned)__builtin_amdgcn_readfirstlane(__hip_atomic_load(cnt + 64 * u.pm, __ATOMIC_RELAXED, __HIP_MEMORY_SCOPE_AGENT)) < 32u) { __builtin_amdgcn_s_sleep(2); if (++sp > (1u << 22)) break; }
            asm volatile("" ::: "memory"); }
        asm volatile("s_waitcnt vmcnt(0) lgkmcnt(0)" ::: "memory"); __builtin_amdgcn_s_barrier(); asm volatile("" ::: "memory");
        if (lane < 32) {
            const unsigned long long* slot = xbuf + (size_t)(rbase + row) * 4; float mt[4], m2[4]; float ms = 0.f;
#pragma unroll
            for (int t = 0; t < 4; ++t) { const unsigned long long w = __hip_atomic_load(slot + t, __ATOMIC_RELAXED, __HIP_MEMORY_SCOPE_AGENT); mt[t] = __uint_as_float((unsigned)w); m2[t] = __uint_as_float((unsigned)(w >> 32)); ms += mt[t]; }
            const float mean = ms * 0.25f; float q = 0.f;
#pragma unroll
            for (int t = 0; t < 4; ++t) { const float dm = mt[t] - mean; q += m2[t] + 256.0f * dm * dm; }
            S[row] = (f32x2){mean, rsqrtf(q * (1.0f / 1024.0f) + LN_EPS)};
        }
        asm volatile("s_waitcnt lgkmcnt(0)" ::: "memory"); __builtin_amdgcn_s_barrier(); asm volatile("" ::: "memory");
        f32x4 g0[2], g1[2], b0[2], b1[2];
#pragma unroll
        for (int bj = 0; bj < 2; ++bj) { g0[bj] = *(const f32x4*)(gam + col0 + bj * 128); g1[bj] = *(const f32x4*)(gam + col0 + bj * 128 + 4); b0[bj] = *(const f32x4*)(bet + col0 + bj * 128); b1[bj] = *(const f32x4*)(bet + col0 + bj * 128 + 4); }
#pragma unroll
        for (int ai = 0; ai < 2; ++ai)
#pragma unroll
            for (int m = 0; m < 4; ++m) { const int rl = ai * 128 + wr * 64 + m * 16 + fr; const f32x2 st = S[rl];
#pragma unroll
                for (int bj = 0; bj < 2; ++bj) { const f32x4 y0 = (acc[ai][bj][m][0] - st.x) * st.y * g0[bj] + b0[bj], y1 = (acc[ai][bj][m][1] - st.x) * st.y * g1[bj] + b1[bj];
                    if (WHICH == 1) { u32x4 w; w.x = cvt_pk_bf16(y0[0], y0[1]); w.y = cvt_pk_bf16(y0[2], y0[3]); w.z = cvt_pk_bf16(y1[0], y1[1]); w.w = cvt_pk_bf16(y1[2], y1[3]);
                        *(u32x4*)(Hout + (size_t)(rbase + rl) * D + col0 + bj * 128) = w; }
                    else { float* yr = Y + (size_t)(rbase + rl) * D + col0 + bj * 128; __builtin_nontemporal_store(y0, (f32x4*)yr); __builtin_nontemporal_store(y1, (f32x4*)(yr + 4)); } } }
        asm volatile("s_waitcnt lgkmcnt(0)" ::: "memory"); __builtin_amdgcn_s_barrier(); asm volatile("" ::: "memory");
    }
};
struct EpiSwiglu {
    static constexpr bool FUSED = false;
    bf16_t* ACT;
    __device__ __forceinline__ void operator()(const Acc& acc, const Unit& u, int wr, int wc, int fr, int fq) const {
        const int col0 = u.pn * 128 + wc * 32 + 8 * fq;
#pragma unroll
        for (int ai = 0; ai < 2; ++ai)
#pragma unroll
            for (int m = 0; m < 4; ++m) { const int row = u.pm * 256 + ai * 128 + wr * 64 + m * 16 + fr;
                f32x4 a0 = acc[ai][0][m][0], a1 = acc[ai][0][m][1]; const f32x4 b0 = acc[ai][1][m][0], b1 = acc[ai][1][m][1];
#pragma unroll
                for (int j = 0; j < 4; j += 2) { const f32x2 p0 = silu_mul_pk((f32x2){a0[j], a0[j + 1]}, (f32x2){b0[j], b0[j + 1]}), p1 = silu_mul_pk((f32x2){a1[j], a1[j + 1]}, (f32x2){b1[j], b1[j + 1]});
                    a0[j] = p0.x; a0[j + 1] = p0.y; a1[j] = p1.x; a1[j + 1] = p1.y; }
                u32x4 w; w.x = cvt_pk_bf16(a0[0], a0[1]); w.y = cvt_pk_bf16(a0[2], a0[3]); w.z = cvt_pk_bf16(a1[0], a1[1]); w.w = cvt_pk_bf16(a1[2], a1[3]);
                *(u32x4*)(ACT + (size_t)row * D_FF + col0) = w; }
    }
};

__device__ __forceinline__ void transpose_tile(const float* W, bf16_t* Bt, int K, int N, int tk, int tn, int mode, LAS float* tile) {
    const int t = threadIdx.x;
    { const int r = t >> 4, c4 = (t & 15) * 4;
#pragma unroll
      for (int i = 0; i < 2; ++i) { const int k = r + 32 * i; const f32x4 v = *(const f32x4*)(W + (size_t)(tk * 64 + k) * N + tn * 64 + c4);
          tile[k * 65 + c4] = v[0]; tile[k * 65 + c4 + 1] = v[1]; tile[k * 65 + c4 + 2] = v[2]; tile[k * 65 + c4 + 3] = v[3]; } }
    __syncthreads();
    { const int n = t >> 3, k8 = (t & 7) * 8; float v[8];
#pragma unroll
      for (int j = 0; j < 8; ++j) v[j] = tile[(k8 + j) * 65 + n];
      int ng = tn * 64 + n;
      if (mode == 1) { const int up = ng >= D_FF; const int n2 = up ? ng - D_FF : ng; ng = 256 * (n2 >> 7) + (n2 & 127) + (up ? 128 : 0); }
      u32x4 w; w.x = cvt_pk_bf16(v[0], v[1]); w.y = cvt_pk_bf16(v[2], v[3]); w.z = cvt_pk_bf16(v[4], v[5]); w.w = cvt_pk_bf16(v[6], v[7]);
      *(u32x4*)(Bt + (size_t)ng * K + tk * 64 + k8) = w; }
    __syncthreads();
}
__device__ void late_transposes(const Params& p, LAS unsigned char* lds, int first, int stride, int part, int end) {
    LAS float* tile = (LAS float*)lds;
    bf16_t* W2 = (bf16_t*)(p.ws + WS_W2); bf16_t* W3 = (bf16_t*)(p.ws + WS_W3); bf16_t* W4 = (bf16_t*)(p.ws + WS_W4);
    constexpr int T2 = 16 * 16, T3 = 16 * 88, T4 = 44 * 16;
    if (part == 0) {
        for (int i = first; i < T2 + T3 && i < end; i += stride) {
            if (i < T2) transpose_tile(p.w_out, W2, D, D, i / 16, i % 16, 0, tile);
            else { const int j = i - T2; transpose_tile(p.w_gu, W3, D, 2 * D_FF, j / 88, j % 88, 1, tile); }
        }
    } else for (int j = first; j < T4 && j < end; j += stride) transpose_tile(p.w_down, W4, D_FF, D, j / 16, j % 16, 0, tile);
}
__device__ void prologue(const Params& p, LAS unsigned char* lds) {
    const int G = gridDim.x, bid = blockIdx.x, t = threadIdx.x;
    LAS float* tile = (LAS float*)lds;
    bf16_t* W1 = (bf16_t*)(p.ws + WS_W1);
    for (int i = bid; i < 16 * 28; i += G) transpose_tile(p.w_in, W1, D, D_IN, i / 28, i % 28, 0, tile);
    bf16_t* XB = (bf16_t*)(p.ws + WS_XB);
    const size_t n8 = (size_t)M * D / 8, np8 = (size_t)MP * D / 8;
    for (size_t i = (size_t)bid * NTHREADS + t; i < n8; i += (size_t)G * NTHREADS) {
        const float* src = i < np8 ? p.x_prompt + i * 8 : p.x_sample + (i - np8) * 8;
        const f32x4 a = *(const f32x4*)src, b = *(const f32x4*)(src + 4);
        u32x4 w; w.x = cvt_pk_bf16(a[0], a[1]); w.y = cvt_pk_bf16(a[2], a[3]); w.z = cvt_pk_bf16(b[0], b[1]); w.w = cvt_pk_bf16(b[2], b[3]);
        *(u32x4*)(XB + i * 8) = w;
    }
    float* rope = (float*)(p.ws + WS_ROPE);
    for (int i = bid * NTHREADS + t; i < 2048 * 8; i += G * NTHREADS) {
        const int pos = i >> 3, k = i & 7;
        const float inv = (float)exp(-(double)k * 0.125 * 13.122363377404328);
        const double ang = (double)((float)pos * inv);
        rope[pos * 16 + k] = (float)cos(ang); rope[pos * 16 + 8 + k] = (float)sin(ang);
    }
    bf16_t* WSB = (bf16_t*)(p.ws + WS_WS);
    for (int i = bid * NTHREADS + t; i < 8 * 128 * 128 / 2; i += G * NTHREADS) {
        const int e = i * 2, ri = (e >> 7) & 127, cj = e & 127; const bool ok = !(ri < 64 && cj >= 64);
        const f32x2 v = *(const f32x2*)(p.w_sp + e);
        *(unsigned*)(WSB + e) = ok ? cvt_pk_bf16(v[0], v[1]) : 0u;
    }
}

constexpr int KS_STRIDE = 72, VT_STRIDE = 200;
constexpr int LDS_KS = 0, LDS_VT = LDS_KS + 2 * 192 * KS_STRIDE * 2, LDS_ASSQ = LDS_VT + 2 * 64 * VT_STRIDE * 2;
__device__ void attn_unit(const Params& p, LAS unsigned char* lds, int unit) {
    int t_ = threadIdx.x; asm volatile("" : "+v"(t_));
    const int t = t_, wid = t >> 6, lane = t & 63, fr = lane & 15, fq = lane >> 4;
    const bool samp = unit >= 256; const int b = samp ? unit - 256 : unit >> 5, c = samp ? 2 : (unit & 31);
    const int r0 = samp ? MP + b * 64 : b * SEQ + c * 64;
    const int kstart = samp ? 0 : (c >= 2 ? 0 : (2 - c) * 64);
    const bf16_t* H = (const bf16_t*)(p.ws + WS_H);
    LAS bf16_t* Ks = (LAS bf16_t*)(lds + LDS_KS); LAS bf16_t* Vt = (LAS bf16_t*)(lds + LDS_VT); LAS float* ssq = (LAS float*)(lds + LDS_ASSQ);
    const int h = wid;
    bf16x8 qf[4][2];
#pragma unroll
    for (int qt = 0; qt < 4; ++qt)
#pragma unroll
        for (int ks = 0; ks < 2; ++ks) qf[qt][ks] = *(const bf16x8*)(H + (size_t)(r0 + qt * 16 + fr) * D_IN + C_Q + h * 64 + ks * 32 + fq * 8);
#pragma unroll
    for (int qi = 0; qi < 6; ++qi) { const int q = t + qi * NTHREADS;
        const int key = q >> 4, cc = q & 15, kvh = cc >> 3, d0 = (cc & 7) * 8;
        u32x4 kw = {0u, 0u, 0u, 0u}, vw = {0u, 0u, 0u, 0u};
        if (key >= kstart) {
            if (samp && key < 128) {
                const float* ck = p.cache_k + ((size_t)(b * 128 + key) * 2 + kvh) * 64 + d0; const float* cv = p.cache_v + ((size_t)(b * 128 + key) * 2 + kvh) * 64 + d0;
                const f32x4 a0 = *(const f32x4*)ck, a1 = *(const f32x4*)(ck + 4), b0 = *(const f32x4*)cv, b1 = *(const f32x4*)(cv + 4);
                kw.x = cvt_pk_bf16(a0[0], a0[1]); kw.y = cvt_pk_bf16(a0[2], a0[3]); kw.z = cvt_pk_bf16(a1[0], a1[1]); kw.w = cvt_pk_bf16(a1[2], a1[3]);
                vw.x = cvt_pk_bf16(b0[0], b0[1]); vw.y = cvt_pk_bf16(b0[2], b0[3]); vw.z = cvt_pk_bf16(b1[0], b1[1]); vw.w = cvt_pk_bf16(b1[2], b1[3]);
            } else {
                const bf16_t* hr = H + (size_t)(r0 - 128 + key) * D_IN;
                kw = *(const u32x4*)(hr + C_K + kvh * 64 + d0); vw = *(const u32x4*)(hr + C_V + kvh * 64 + d0);
            }
        }
        *(LAS u32x4*)(Ks + (kvh * 192 + key) * KS_STRIDE + d0) = kw;
        LAS bf16_t* vt = Vt + (kvh * 64 + d0) * VT_STRIDE + ((((key >> 3) ^ (cc & 7)) << 3) | (key & 7));
        vt[0 * VT_STRIDE] = (bf16_t)(vw.x & 0xffff); vt[1 * VT_STRIDE] = (bf16_t)(vw.x >> 16); vt[2 * VT_STRIDE] = (bf16_t)(vw.y & 0xffff); vt[3 * VT_STRIDE] = (bf16_t)(vw.y >> 16);
        vt[4 * VT_STRIDE] = (bf16_t)(vw.z & 0xffff); vt[5 * VT_STRIDE] = (bf16_t)(vw.z >> 16); vt[6 * VT_STRIDE] = (bf16_t)(vw.w & 0xffff); vt[7 * VT_STRIDE] = (bf16_t)(vw.w >> 16);
    }
    __syncthreads();
    const int kvh = h >> 2;
    const float sink = p.sinks[h] * 1.4426950408889634f;
    f32x4 o[4][4];
#pragma unroll
    for (int qp = 0; qp < 2; ++qp) {
        f32x4 s[2][12];
#pragma unroll
        for (int kt = 0; kt < 12; ++kt) {
            s[0][kt] = (f32x4){0.f, 0.f, 0.f, 0.f}; s[1][kt] = (f32x4){0.f, 0.f, 0.f, 0.f};
#pragma unroll
            for (int ks = 0; ks < 2; ++ks) { const bf16x8 kf = *(const LAS bf16x8*)(Ks + (kvh * 192 + kt * 16 + fr) * KS_STRIDE + ks * 32 + fq * 8);
                s[0][kt] = __builtin_amdgcn_mfma_f32_16x16x32_bf16(kf, qf[2 * qp][ks], s[0][kt], 0, 0, 0);
                s[1][kt] = __builtin_amdgcn_mfma_f32_16x16x32_bf16(kf, qf[2 * qp + 1][ks], s[1][kt], 0, 0, 0); }
        }
        if (kstart > 0) {
#pragma unroll
            for (int kt = 0; kt < 12; ++kt) if (kt * 16 < kstart) { s[0][kt] = (f32x4){-1e30f, -1e30f, -1e30f, -1e30f}; s[1][kt] = s[0][kt]; } }
        float inv[2];
#pragma unroll
        for (int e = 0; e < 2; ++e) {
            float mx = sink;
#pragma unroll
            for (int kt = 0; kt < 12; ++kt) mx = fmaxf(mx, fmaxf(fmaxf(s[e][kt][0], s[e][kt][1]), fmaxf(s[e][kt][2], s[e][kt][3])));
            mx = fmaxf(mx, __shfl_xor(mx, 16)); mx = fmaxf(mx, __shfl_xor(mx, 32));
            float sum = 0.f;
#pragma unroll
            for (int kt = 0; kt < 12; ++kt) {
#pragma unroll
                for (int j = 0; j < 4; ++j) { const float ex = __builtin_amdgcn_exp2f(s[e][kt][j] - mx); s[e][kt][j] = ex; sum += ex; } }
            sum += __shfl_xor(sum, 16); sum += __shfl_xor(sum, 32);
            inv[e] = 1.0f / (sum + __builtin_amdgcn_exp2f(sink - mx));
#pragma unroll
            for (int dt = 0; dt < 4; ++dt) o[2 * qp + e][dt] = (f32x4){0.f, 0.f, 0.f, 0.f};
        }
#pragma unroll
        for (int kp = 0; kp < 6; ++kp) {
            bf16x8 pf[2];
#pragma unroll
            for (int e = 0; e < 2; ++e) { u32x4 pw; pw.x = cvt_pk_bf16(s[e][2 * kp][0], s[e][2 * kp][1]); pw.y = cvt_pk_bf16(s[e][2 * kp][2], s[e][2 * kp][3]);
                pw.z = cvt_pk_bf16(s[e][2 * kp + 1][0], s[e][2 * kp + 1][1]); pw.w = cvt_pk_bf16(s[e][2 * kp + 1][2], s[e][2 * kp + 1][3]); pf[e] = __builtin_bit_cast(bf16x8, pw); }
#pragma unroll
            for (int dt = 0; dt < 4; ++dt) {
                const LAS bf16_t* vrow = Vt + (kvh * 64 + dt * 16 + fr) * VT_STRIDE; const int sw = (dt * 2 + (fr >> 3)) & 7;
                const int k0 = kp * 32 + fq * 4, k1 = k0 + 16;
                const u32x2 va = *(const LAS u32x2*)(vrow + ((((k0 >> 3) ^ sw) << 3) | (k0 & 7))), vb = *(const LAS u32x2*)(vrow + ((((k1 >> 3) ^ sw) << 3) | (k1 & 7)));
                const u32x4 vv = {va.x, va.y, vb.x, vb.y};
                o[2 * qp][dt] = __builtin_amdgcn_mfma_f32_16x16x32_bf16(__builtin_bit_cast(bf16x8, vv), pf[0], o[2 * qp][dt], 0, 0, 0);
                o[2 * qp + 1][dt] = __builtin_amdgcn_mfma_f32_16x16x32_bf16(__builtin_bit_cast(bf16x8, vv), pf[1], o[2 * qp + 1][dt], 0, 0, 0);
            }
        }
#pragma unroll
        for (int e = 0; e < 2; ++e) { const int qt = 2 * qp + e;
            float q2 = 0.f;
#pragma unroll
            for (int dt = 0; dt < 4; ++dt) { o[qt][dt] = o[qt][dt] * inv[e];
#pragma unroll
                for (int j = 0; j < 4; ++j) q2 += o[qt][dt][j] * o[qt][dt][j]; }
            q2 += __shfl_xor(q2, 16); q2 += __shfl_xor(q2, 32);
            if (fq == 0) ssq[h * 64 + qt * 16 + fr] = q2; }
    }
    __syncthreads();
    bf16_t* CAT = (bf16_t*)(p.ws + WS_CAT);
#pragma unroll
    for (int qt = 0; qt < 4; ++qt) {
        float tot = 0.f;
#pragma unroll
        for (int hh = 0; hh < 8; ++hh) tot += ssq[hh * 64 + qt * 16 + fr];
        const float rs = rsqrtf(tot * (1.0f / 512.0f) + LN_EPS);
#pragma unroll
        for (int dt = 0; dt < 4; ++dt) { const int col = h * 64 + dt * 16 + fq * 4; const f32x4 g = *(const f32x4*)(p.g_attn + col); const f32x4 v = o[qt][dt] * rs * g;
            u32x2 w; w.x = cvt_pk_bf16(v[0], v[1]); w.y = cvt_pk_bf16(v[2], v[3]);
            *(u32x2*)(CAT + (size_t)(r0 + qt * 16 + fr) * D + col) = w; }
    }
    __syncthreads();
}

constexpr int VM_STRIDE = 136;
constexpr int LDS_VMT = 0, LDS_GST = LDS_VMT + 8 * 64 * VM_STRIDE * 2, LDS_GSSQ = LDS_GST + 128 * 2 * 4;
__device__ void gate_unit(const Params& p, LAS unsigned char* lds, int unit) {
    int t_ = threadIdx.x; asm volatile("" : "+v"(t_));
    const int t = t_, wid = t >> 6, lane = t & 63, fr = lane & 15, fq = lane >> 4;
    const bool samp = unit >= 256; const int w_ = unit & 127; const int b = samp ? unit - 256 : w_ >> 4, c = samp ? 0 : 2 * (w_ & 15) + (unit < 128 ? 1 : 0), par = c & 1;
    const int r0 = samp ? MP + b * 64 : b * SEQ + c * 64;
    const int Kc = par ? 128 : 64, jr0 = par ? r0 - 64 : r0;
    const bf16_t* H = (const bf16_t*)(p.ws + WS_H);
    LAS bf16_t* VmT = (LAS bf16_t*)(lds + LDS_VMT); LAS float* st = (LAS float*)(lds + LDS_GST); LAS float* ssq = (LAS float*)(lds + LDS_GSSQ);
    const int g = wid, jl = lane >> 3, c8 = (lane & 7) * 8, col = g * 64 + c8;
    LAS f32x2* part = (LAS f32x2*)(lds + LDS_VMT);
    u32x4 raw[16];
#pragma unroll
    for (int it = 0; it < 16; ++it) if (it * 8 < Kc) raw[it] = *(const u32x4*)(H + (size_t)(jr0 + it * 8 + jl) * D_IN + C_VM + col);
#pragma unroll
    for (int it = 0; it < 16; ++it) if (it * 8 < Kc) {
        const u32x4 w = raw[it];
        const float v0 = bflo(w.x), v1 = bfhi(w.x), v2 = bflo(w.y), v3 = bfhi(w.y), v4 = bflo(w.z), v5 = bfhi(w.z), v6 = bflo(w.w), v7 = bfhi(w.w);
        float sm = ((v0 + v1) + (v2 + v3)) + ((v4 + v5) + (v6 + v7));
        float sq = ((v0 * v0 + v1 * v1) + (v2 * v2 + v3 * v3)) + ((v4 * v4 + v5 * v5) + (v6 * v6 + v7 * v7));
        sm += __shfl_xor(sm, 1); sq += __shfl_xor(sq, 1); sm += __shfl_xor(sm, 2); sq += __shfl_xor(sq, 2); sm += __shfl_xor(sm, 4); sq += __shfl_xor(sq, 4);
        if ((lane & 7) == 0) part[(it * 8 + jl) * 8 + g] = (f32x2){sm, sq};
    }
    __syncthreads();
    if (t < Kc) { float sm = 0.f, sq = 0.f;
#pragma unroll
        for (int gg = 0; gg < 8; ++gg) { const f32x2 pv = part[t * 8 + gg]; sm += pv.x; sq += pv.y; }
        const float mean = sm * (1.0f / 512.0f), var = fmaxf(sq * (1.0f / 512.0f) - mean * mean, 0.f);
        st[t * 2] = mean; st[t * 2 + 1] = rsqrtf(var + LN_EPS); }
    __syncthreads();
    { const f32x4 ga0 = *(const f32x4*)(p.ln_v_g + col), ga1 = *(const f32x4*)(p.ln_v_g + col + 4), be0 = *(const f32x4*)(p.ln_v_b + col), be1 = *(const f32x4*)(p.ln_v_b + col + 4);
#pragma unroll
      for (int it = 0; it < 16; ++it) if (it * 8 < Kc) { const int j = it * 8 + jl;
          const u32x4 w = raw[it];
          const float mean = st[j * 2], rstd = st[j * 2 + 1];
          f32x4 v0 = {bflo(w.x), bfhi(w.x), bflo(w.y), bfhi(w.y)}, v1 = {bflo(w.z), bfhi(w.z), bflo(w.w), bfhi(w.w)};
          v0 = (v0 - mean) * rstd * ga0 + be0; v1 = (v1 - mean) * rstd * ga1 + be1;
          if (samp) { float* o = p.out + O_MS + (size_t)(b * 64 + j) * 512 + col; *(f32x4*)o = v0; *(f32x4*)(o + 4) = v1; }
          const unsigned w0 = cvt_pk_bf16(v0[0], v0[1]), w1 = cvt_pk_bf16(v0[2], v0[3]), w2 = cvt_pk_bf16(v1[0], v1[1]), w3 = cvt_pk_bf16(v1[2], v1[3]);
          LAS bf16_t* d = VmT + (g * 64 + c8) * VM_STRIDE + ((it ^ (lane & 7)) * 8 + jl);
          d[0 * VM_STRIDE] = (bf16_t)(w0 & 0xffff); d[1 * VM_STRIDE] = (bf16_t)(w0 >> 16); d[2 * VM_STRIDE] = (bf16_t)(w1 & 0xffff); d[3 * VM_STRIDE] = (bf16_t)(w1 >> 16);
          d[4 * VM_STRIDE] = (bf16_t)(w2 & 0xffff); d[5 * VM_STRIDE] = (bf16_t)(w2 >> 16); d[6 * VM_STRIDE] = (bf16_t)(w3 & 0xffff); d[7 * VM_STRIDE] = (bf16_t)(w3 >> 16); } }
    __syncthreads();
    const bf16_t* WSB = (const bf16_t*)(p.ws + WS_WS) + (size_t)g * 128 * 128 + (size_t)(par * 64) * 128;
    f32x4 acc[4][4];
#pragma unroll
    for (int it = 0; it < 4; ++it)
#pragma unroll
        for (int dt = 0; dt < 4; ++dt) acc[it][dt] = (f32x4){0.f, 0.f, 0.f, 0.f};
    bf16x8 wf[4][4];
#pragma unroll
    for (int ks = 0; ks < 4; ++ks) if (ks * 32 < Kc) {
#pragma unroll
        for (int it = 0; it < 4; ++it) wf[ks][it] = *(const bf16x8*)(WSB + (size_t)(it * 16 + fr) * 128 + ks * 32 + fq * 8); }
#pragma unroll
    for (int ks = 0; ks < 4; ++ks) if (ks * 32 < Kc) {
        bf16x8 vf[4];
#pragma unroll
        for (int dt = 0; dt < 4; ++dt) vf[dt] = *(const LAS bf16x8*)(VmT + (g * 64 + dt * 16 + fr) * VM_STRIDE + (((ks * 4 + fq) ^ ((dt * 2 + (fr >> 3)) & 7)) * 8));
#pragma unroll
        for (int it = 0; it < 4; ++it)
#pragma unroll
            for (int dt = 0; dt < 4; ++dt) acc[it][dt] = __builtin_amdgcn_mfma_f32_16x16x32_bf16(vf[dt], wf[ks][it], acc[it][dt], 0, 0, 0);
    }
    u32x2 uw[4][4];
#pragma unroll
    for (int it = 0; it < 4; ++it)
#pragma unroll
        for (int dt = 0; dt < 4; ++dt) uw[it][dt] = *(const u32x2*)(H + (size_t)(r0 + it * 16 + fr) * D_IN + C_U + g * 64 + dt * 16 + fq * 4);
#pragma unroll
    for (int it = 0; it < 4; ++it) {
        const float bs = p.b_sp[g * 128 + par * 64 + it * 16 + fr]; float q2 = 0.f;
#pragma unroll
        for (int dt = 0; dt < 4; ++dt) { const f32x4 uv = {bflo(uw[it][dt].x), bfhi(uw[it][dt].x), bflo(uw[it][dt].y), bfhi(uw[it][dt].y)};
            acc[it][dt] = (acc[it][dt] + bs) * uv;
#pragma unroll
            for (int j = 0; j < 4; ++j) q2 += acc[it][dt][j] * acc[it][dt][j]; }
        q2 += __shfl_xor(q2, 16); q2 += __shfl_xor(q2, 32);
        if (fq == 0) ssq[g * 64 + it * 16 + fr] = q2;
    }
    __syncthreads();
    bf16_t* CAT = (bf16_t*)(p.ws + WS_CAT);
#pragma unroll
    for (int it = 0; it < 4; ++it) {
        float tot = 0.f;
#pragma unroll
        for (int gg = 0; gg < 8; ++gg) tot += ssq[gg * 64 + it * 16 + fr];
        const float rs = rsqrtf(tot * (1.0f / 512.0f) + LN_EPS);
#pragma unroll
        for (int dt = 0; dt < 4; ++dt) { const int col = g * 64 + dt * 16 + fq * 4; const f32x4 gm = *(const f32x4*)(p.g_cmlp + col); const f32x4 v = acc[it][dt] * rs * gm;
            u32x2 w; w.x = cvt_pk_bf16(v[0], v[1]); w.y = cvt_pk_bf16(v[2], v[3]);
            *(u32x2*)(CAT + (size_t)(r0 + it * 16 + fr) * D + 512 + col) = w; }
    }
    __syncthreads();
}

template <bool TO_BF16>
__device__ void ln_rows(const float* Z, const float* gam, const float* bet, bf16_t* Hb, float* Y) {
    const int lane = threadIdx.x & 63, gw = blockIdx.x * 8 + (threadIdx.x >> 6), nw = gridDim.x * 8;
    f32x4 g[4], be[4];
#pragma unroll
    for (int i = 0; i < 4; ++i) { g[i] = *(const f32x4*)(gam + i * 256 + lane * 4); be[i] = *(const f32x4*)(bet + i * 256 + lane * 4); }
    for (int row = gw; row < M; row += nw) {
        const float* z = Z + (size_t)row * D; f32x4 v[4]; float s = 0.f;
#pragma unroll
        for (int i = 0; i < 4; ++i) { v[i] = *(const f32x4*)(z + i * 256 + lane * 4); s += (v[i][0] + v[i][1]) + (v[i][2] + v[i][3]); }
#pragma unroll
        for (int o = 1; o < 64; o <<= 1) s += __shfl_xor(s, o);
        const float mean = s * (1.0f / 1024.0f); float q = 0.f;
#pragma unroll
        for (int i = 0; i < 4; ++i) { v[i] = v[i] - mean; q += (v[i][0] * v[i][0] + v[i][1] * v[i][1]) + (v[i][2] * v[i][2] + v[i][3] * v[i][3]); }
#pragma unroll
        for (int o = 1; o < 64; o <<= 1) q += __shfl_xor(q, o);
        const float rstd = rsqrtf(q * (1.0f / 1024.0f) + LN_EPS);
#pragma unroll
        for (int i = 0; i < 4; ++i) { const f32x4 y = v[i] * rstd * g[i] + be[i];
            if (TO_BF16) { u32x2 w; w.x = cvt_pk_bf16(y[0], y[1]); w.y = cvt_pk_bf16(y[2], y[3]); *(u32x2*)(Hb + (size_t)row * D + i * 256 + lane * 4) = w; }
            else *(f32x4*)(Y + (size_t)row * D + i * 256 + lane * 4) = y; }
    }
}

__global__ void __launch_bounds__(NTHREADS, 2) fwd_mega(Params p) {
    extern __shared__ __attribute__((aligned(16))) unsigned char smem[];
    LAS unsigned char* lds = (LAS unsigned char*)smem;
    const int G = gridDim.x, bid = blockIdx.x;
    volatile LAS unsigned* xst = (volatile LAS unsigned*)(lds + LDS_BYTES - 16);
    if (threadIdx.x == 0) { xst[0] = 0u; xst[1] = 0u; }
    __syncthreads();
    XcdBarrier xb = xcd_barrier_post((unsigned*)(p.ws + WS_BAR) + (NBAR > 1 ? p.pad * 4096 : 0), xst);
#define IN(ph) (p.ph_lo <= (ph) && (ph) < p.ph_hi)
#define REP(ph) for (int _r = 0; _r < ((ph) == PROBE_PH ? 3 : 1); ++_r)
#define SYNC(ph) do { if (p.coop && IN(ph) && IN((ph) + 1)) xcd_barrier(xb); } while (0)
    if (IN(0)) REP(0) prologue(p, lds);
    SYNC(0);
    if (IN(1)) { pg8::Gemm g{(const bf16_t*)(p.ws + WS_XB), (const bf16_t*)(p.ws + WS_W1), M, D_IN, D}; pg8::StaticOrder S; S.init(M, D_IN, D, G, bid);
        EpiProj E{(bf16_t*)(p.ws + WS_H), (const float*)(p.ws + WS_ROPE), p.out}; pg8::gemm_phase(lds, g, S, E); }
    SYNC(1);
    if (IN(2)) {
        if (G == 256) {
            for (int k = 0; k < 3; ++k) {
                int u = -1;
                if (k == 0) u = bid;
                else if (k == 1) u = bid < 32 ? 256 + bid : (bid < 160 ? 288 + (bid - 32) : 288 + 128 + (bid - 160));
                else if (bid >= 160 && bid < 224) u = 288 + 224 + (bid - 160);
                if (u < 0) break;
                if (u < 288) attn_unit(p, lds, u); else gate_unit(p, lds, u - 288);
            }
            int t0 = 0, tn = 0;
            if (bid < 32) { t0 = bid * 9; tn = 9; } else if (bid < 160) { t0 = 288 + (bid - 32) * 8; tn = 8; } else if (bid >= 224) { t0 = 1312 + (bid - 224) * 11; tn = 11; }
            if (tn) late_transposes(p, lds, t0, 1, 0, t0 + tn);
        } }
    SYNC(2);
    if (IN(3)) { for (int rep = 0; rep < (PROBE_PH == 3 ? 3 : 1); ++rep) { if (rep) xcd_barrier(xb);
        pg8::Gemm g{(const bf16_t*)(p.ws + WS_CAT), (const bf16_t*)(p.ws + WS_W2), M, D, D}; pg8::TeamOrder S; S.init(D, bid, P3_STREAMK);
        EpiLn<1> E{(PROBE_PH == 10 ? p.pad * 2 : 0) + rep}; pg8::gemm_phase(lds, g, S, E); } }
    SYNC(3);
    if (IN(4)) REP(5) { pg8::Gemm g{(const bf16_t*)(p.ws + WS_HB), (const bf16_t*)(p.ws + WS_W3), M, 2 * D_FF, D}; pg8::StaticOrder S; S.init(M, 2 * D_FF, D, G, bid);
        EpiSwiglu E{(bf16_t*)(p.ws + WS_ACT)}; pg8::gemm_phase(lds, g, S, E);
        if (G == 256 && bid >= 48) late_transposes(p, lds, bid - 48, 208, 1, 1 << 30); }
    SYNC(4);
    if (IN(5)) { for (int rep = 0; rep < (PROBE_PH == 6 ? 3 : 1); ++rep) { if (rep) xcd_barrier(xb);
        pg8::Gemm g{(const bf16_t*)(p.ws + WS_ACT), (const bf16_t*)(p.ws + WS_W4), M, D, D_FF}; pg8::TeamOrder S; S.init(D_FF, bid, 1);
        EpiLn<2> E{(PROBE_PH == 10 ? p.pad * 2 + 1 : (PROBE_PH == 3 || PROBE_PH == 6) ? 3 : 1) + rep}; pg8::gemm_phase(lds, g, S, E); } }
#undef IN
#undef SYNC
}

#undef REP
#ifndef N_LAUNCHES
#define N_LAUNCHES 1
#endif
extern "C" void kernel_launch(void* const* d_in, const int* in_sizes, int n_in, void* d_out, int out_size, void* d_ws, size_t ws_size, hipStream_t stream) {
    static int grid = 0;
    if (grid == 0) {
        int dev = 0, cus = 0, per_cu = 0;
        hipGetDevice(&dev); hipDeviceGetAttribute(&cus, hipDeviceAttributeMultiprocessorCount, dev);
        if (hipFuncSetAttribute((const void*)fwd_mega, hipFuncAttributeMaxDynamicSharedMemorySize, LDS_BYTES) != hipSuccess) { fprintf(stderr, "hipFuncSetAttribute failed\n"); grid = -1; return; }
        if (hipOccupancyMaxActiveBlocksPerMultiprocessor(&per_cu, (const void*)fwd_mega, NTHREADS, LDS_BYTES) != hipSuccess || per_cu < 1) { fprintf(stderr, "occupancy query: %d\n", per_cu); per_cu = 1; }
        (void)hipGetLastError();
        grid = cus * (per_cu > 1 ? 1 : per_cu);
        if (grid != 256) { fprintf(stderr, "this kernel needs a grid of exactly 256 workgroups (one per CU), got %d\n", grid); grid = -1; return; }
        if (ws_size < WS_END) { fprintf(stderr, "workspace too small: %zu < %zu\n", ws_size, WS_END); grid = -1; return; }
    }
    if (grid < 0) return;
    if (hipMemsetAsync((char*)d_ws + WS_BAR, 0, WS_ZERO_BYTES, stream) != hipSuccess) { fprintf(stderr, "memset failed\n"); return; }
    Params p{};
    p.x_prompt = (const float*)d_in[0]; p.x_sample = (const float*)d_in[1]; p.cache_k = (const float*)d_in[2]; p.cache_v = (const float*)d_in[3]; p.w_in = (const float*)d_in[4];
    p.ln_v_g = (const float*)d_in[5]; p.ln_v_b = (const float*)d_in[6]; p.sinks = (const float*)d_in[7]; p.w_sp = (const float*)d_in[8]; p.b_sp = (const float*)d_in[9];
    p.g_attn = (const float*)d_in[10]; p.g_cmlp = (const float*)d_in[11]; p.w_out = (const float*)d_in[12]; p.ln1_g = (const float*)d_in[13]; p.ln1_b = (const float*)d_in[14];
    p.w_gu = (const float*)d_in[15]; p.w_down = (const float*)d_in[16]; p.ln2_g = (const float*)d_in[17]; p.ln2_b = (const float*)d_in[18];
    p.out = (float*)d_out; p.ws = (unsigned char*)d_ws;
#if N_LAUNCHES == 1
    p.ph_lo = 0; p.ph_hi = 6; p.coop = 1;
    void* args[] = {&p};
    hipError_t e = hipLaunchCooperativeKernel((const void*)fwd_mega, dim3(grid), dim3(NTHREADS), args, LDS_BYTES, stream);
#if PROBE_PH == 10
    p.pad = 1; e = hipLaunchCooperativeKernel((const void*)fwd_mega, dim3(grid), dim3(NTHREADS), args, LDS_BYTES, stream);
#endif
    if (e != hipSuccess) fprintf(stderr, "cooperative launch failed: %s (grid %d)\n", hipGetErrorString(e), grid);
#else
    for (int ph = 0; ph < 6; ++ph) { p.ph_lo = ph; p.ph_hi = ph + 1; p.coop = 0;
        hipLaunchKernelGGL(fwd_mega, dim3(grid), dim3(NTHREADS), LDS_BYTES, stream, p); }
#endif
}
```

```cpp
#include <hip/hip_runtime.h>
#include <hip/hip_cooperative_groups.h>
#include <cstdio>
#include <cstdint>
namespace cg = cooperative_groups;

#define LAS __attribute__((address_space(3)))
typedef unsigned short bf16_t;
typedef short bf16x8 __attribute__((ext_vector_type(8)));
typedef short bf16x4 __attribute__((ext_vector_type(4)));
typedef float f32x4 __attribute__((ext_vector_type(4)));
typedef float f32x2 __attribute__((ext_vector_type(2)));
typedef unsigned u32x4 __attribute__((ext_vector_type(4)));
typedef unsigned u32x2 __attribute__((ext_vector_type(2)));

#ifndef GEMM_SP2
#define GEMM_SP2 1
#endif
#ifndef GEMM_ALIGN_EPI
#define GEMM_ALIGN_EPI 1
#endif
#ifndef P3_STREAMK
#define P3_STREAMK 1
#endif
#ifndef PROBE_PH
#define PROBE_PH -1
#endif
constexpr int D = 1024, SEQ = 2048, NB = 8, DEC_B = 32, DEC_L = 64, PAST = 1024;
constexpr int MP = NB * SEQ, MS = DEC_B * DEC_L, M = MP + MS;
constexpr int D_IN = 1792, D_FF = 2816;
constexpr int C_Q = 0, C_K = 512, C_V = 640, C_U = 768, C_VM = 1280;
constexpr float ALPHA = 1.189207115002721f;
constexpr float LN_EPS = 1e-5f;
constexpr size_t O_Y = 0, O_KP = (size_t)M * D, O_VP = O_KP + 131072, O_KS = O_VP + 131072, O_VS = O_KS + 262144, O_MS = O_VS + 262144;
constexpr size_t WS_XB = 0;
constexpr size_t WS_H = WS_XB + (size_t)M * D * 2;
constexpr size_t WS_ACT = 0;
constexpr size_t WS_W1 = (size_t)M * D_FF * 2;
constexpr size_t WS_W2 = WS_W1 + (size_t)D_IN * D * 2;
constexpr size_t WS_W3 = WS_W2 + (size_t)D * D * 2;
constexpr size_t WS_W4 = WS_W3 + (size_t)2 * D_FF * D * 2;
constexpr size_t WS_WS = WS_W4 + (size_t)D * D_FF * 2;
constexpr size_t WS_ROPE = WS_WS + (size_t)8 * 128 * 128 * 2;
constexpr size_t WS_CAT = WS_ROPE + (size_t)2048 * 16 * 4;
constexpr size_t WS_HB = WS_CAT + (size_t)M * D * 2;
constexpr size_t WS_BAR = WS_HB + (size_t)M * D * 2;
constexpr int NSETS = (PROBE_PH == 3 || PROBE_PH == 6 || PROBE_PH == 10) ? 6 : 2, NBAR = PROBE_PH == 10 ? 2 : 1;
constexpr size_t WS_CNT = WS_BAR + (size_t)NBAR * 16384;
constexpr size_t WS_FLG = WS_CNT + (size_t)NSETS * 72 * 256;
constexpr size_t WS_ZERO_BYTES = (size_t)NBAR * 16384 + (size_t)NSETS * 72 * 256 + (size_t)NSETS * 224 * 256;
constexpr size_t WS_XB1 = WS_FLG + (size_t)NSETS * 224 * 256;
constexpr size_t WS_XB2 = WS_XB1 + (size_t)M * 4 * 8;
constexpr size_t WS_SLAB = WS_XB2 + (size_t)M * 4 * 8;
constexpr size_t WS_END = WS_SLAB + (size_t)224 * 131072;
constexpr int LDS_BYTES = 147456;
constexpr int NTHREADS = 512;

struct Params {
    const float *x_prompt, *x_sample, *cache_k, *cache_v, *w_in, *ln_v_g, *ln_v_b, *sinks, *w_sp, *b_sp, *g_attn, *g_cmlp, *w_out, *ln1_g, *ln1_b, *w_gu, *w_down, *ln2_g, *ln2_b;
    float* out;
    unsigned char* ws;
    int ph_lo, ph_hi, coop, pad;
};

__device__ __forceinline__ unsigned cvt_pk_bf16(float lo, float hi) { unsigned r; asm volatile("v_cvt_pk_bf16_f32 %0, %1, %2" : "=v"(r) : "v"(lo), "v"(hi)); return r; }
__device__ __forceinline__ float bf2f(unsigned short b) { return __uint_as_float(((unsigned)b) << 16); }
__device__ __forceinline__ float bflo(unsigned w) { return __uint_as_float(w << 16); }
__device__ __forceinline__ float bfhi(unsigned w) { return __uint_as_float(w & 0xffff0000u); }
__device__ __forceinline__ float fast_sigmoid(float x) { return __builtin_amdgcn_rcpf(1.0f + __builtin_amdgcn_exp2f(-1.4426950408889634f * x)); }
__device__ __forceinline__ float gelu_tanh(float x) { const float u = 1.5957691216057308f * (x + 0.044715f * x * x * x); return x * fast_sigmoid(u); }
__device__ __forceinline__ float silu(float x) { return x * fast_sigmoid(x); }
__device__ __forceinline__ f32x2 silu_mul_pk(f32x2 g, f32x2 u) {
    const f32x2 m = g * (-1.4426950408889634f);
    f32x2 e; e.x = __builtin_amdgcn_exp2f(m.x); e.y = __builtin_amdgcn_exp2f(m.y);
    const f32x2 d = e + 1.0f;
    f32x2 r; r.x = __builtin_amdgcn_rcpf(d.x); r.y = __builtin_amdgcn_rcpf(d.y);
    return (g * r) * u;
}
__device__ __forceinline__ f32x2 gelu_tanh_pk(f32x2 x) {
    const f32x2 f = (x * x) * (-0.10294324f) + (-2.3022082f);
    const f32x2 w = x * f;
    f32x2 e; e.x = __builtin_amdgcn_exp2f(w.x); e.y = __builtin_amdgcn_exp2f(w.y);
    const f32x2 d = e + 1.0f;
    f32x2 r; r.x = __builtin_amdgcn_rcpf(d.x); r.y = __builtin_amdgcn_rcpf(d.y);
    return x * r;
}


#define XB_TMO      128
#define XB_XCNT(j)  (256  + 64 * (j))
#define XB_XSUB(j)  (1280 + 64 * (j))
#define XB_XGEN(j)  (2304 + 64 * (j))
#define XB_TOP      3328
#define XB_TOPGEN   3392
#define XCD_BAR_WORDS 3456
#define XB_SPIN_CAP (1u << 18)
__device__ __forceinline__ unsigned xb_ld(unsigned* p)              { return __hip_atomic_load(p, __ATOMIC_RELAXED, __HIP_MEMORY_SCOPE_AGENT); }
__device__ __forceinline__ unsigned xb_add(unsigned* p, unsigned v) { return __hip_atomic_fetch_add(p, v, __ATOMIC_RELAXED, __HIP_MEMORY_SCOPE_AGENT); }
__device__ __forceinline__ unsigned xb_xcc_id() { return (unsigned)__builtin_amdgcn_s_getreg((3 << 11) | 20) & 0xFu; }
#define XB_SPIN(cond, bar) do { unsigned _sp = 0; while (cond) { __builtin_amdgcn_s_sleep(1); \
    if ((++_sp & 255u) == 0u) { if (xb_ld(&(bar)[XB_TMO])) break; if (_sp > XB_SPIN_CAP) { atomicAdd(&(bar)[XB_TMO], 1u); break; } } } } while (0)
struct XcdBarrier { unsigned* bar; unsigned x; volatile LAS unsigned* st; };
__device__ __forceinline__ XcdBarrier xcd_barrier_post(unsigned* bar, volatile LAS unsigned* st) {
    XcdBarrier b; b.bar = bar; b.x = xb_xcc_id(); b.st = st;
    if (threadIdx.x == 0) (void)xb_add(&bar[XB_XCNT(b.x)], 1u);
    return b;
}
__device__ __forceinline__ void xcd_barrier_complete(unsigned* bar, unsigned x, unsigned& nloc, unsigned& nx) {
    const unsigned G = gridDim.x * gridDim.y * gridDim.z;
    unsigned sum, cnt, mine, sp = 0u;
    for (;;) {
        sum = 0u; cnt = 0u; mine = 0u;
#pragma unroll
        for (unsigned j = 0; j < 16; ++j) { const unsigned c = xb_ld(&bar[XB_XCNT(j)]); sum += c; cnt += (c > 0u) ? 1u : 0u; mine = (j == x) ? c : mine; }
        if (sum == G) break;
        __builtin_amdgcn_s_sleep(1);
        if ((++sp & 255u) == 0u) { if (xb_ld(&bar[XB_TMO])) break; if (sp > XB_SPIN_CAP) { atomicAdd(&bar[XB_TMO], 1u); break; } }
    }
    nloc = mine > 0u ? mine : 1u; nx = cnt > 0u ? cnt : 1u;
}
__device__ __forceinline__ void xcd_barrier(const XcdBarrier& b) {
    asm volatile("s_waitcnt vmcnt(0)" ::: "memory");
    __syncthreads();
    if (threadIdx.x == 0) {
        unsigned* bar = b.bar;
        __builtin_amdgcn_s_waitcnt(0);
        unsigned nloc = b.st[0], nx = b.st[1];
        if (nloc == 0u) { xcd_barrier_complete(bar, b.x, nloc, nx); b.st[0] = nloc; b.st[1] = nx; }
        const unsigned old = xb_add(&bar[XB_XSUB(b.x)], 1u);
        const unsigned gen = old / nloc;
        if (old + 1u == (gen + 1u) * nloc) {
            __builtin_amdgcn_fence(__ATOMIC_RELEASE, "agent");
            asm volatile("s_waitcnt vmcnt(0)" ::: "memory");
            const unsigned og = xb_add(&bar[XB_TOP], 1u);
            const unsigned tg = og / nx;
            if (og + 1u == (tg + 1u) * nx) xb_add(&bar[XB_TOPGEN], 1u);
            else XB_SPIN(xb_ld(&bar[XB_TOPGEN]) == tg, bar);
            __builtin_amdgcn_fence(__ATOMIC_ACQUIRE, "agent");
            xb_add(&bar[XB_XGEN(b.x)], 1u);
            asm volatile("s_waitcnt vmcnt(0)" ::: "memory");
        } else {
            __builtin_amdgcn_fence(__ATOMIC_ACQUIRE, "agent");
            XB_SPIN(xb_ld(&bar[XB_TOPGEN]) == gen, bar);
            asm volatile("s_waitcnt vmcnt(0)" ::: "memory");
        }
    }
    __syncthreads();
}

namespace pg8 {
constexpr int BM = 256, BK = 64, HALF = 128, HTB = HALF * BK * 2, STAGE_BYTES = 8 * HTB, NXCD = 8, WGM = 8;
__host__ __device__ __forceinline__ int lds_byte(int r, int c) { const int st = (r >> 4) * 2 + (c >> 5), rr = r & 15, cc = c & 31, ob = rr * 64 + cc * 2; return st * 1024 + (ob ^ (((ob >> 9) & 1) << 5)); }
__host__ __device__ __forceinline__ void stage_rc(int b, int& R, int& C) { const int st = b / 1024, sb = b % 1024, swz = sb ^ (((sb >> 9) & 1) << 5); R = (st >> 1) * 16 + swz / 64; C = (st & 1) * 32 + (swz % 64) / 2; }
__host__ __device__ __forceinline__ int perm32(int rho) { const int n = rho >> 4, i = rho & 15; return 8 * (i >> 2) + 4 * n + (i & 3); }
struct Unit { int pm, pn, k0, nt, kind, slot; };
struct Gemm { const bf16_t* A; const bf16_t* Bt; int M, N, K; };
struct StaticOrder {
    int nM, nN, nwg, G, c, ntile;
    __host__ __device__ void init(int M_, int N_, int K_, int G_, int c_) { nM = M_ / BM; nN = N_ / BM; nwg = nM * nN; G = G_; c = c_; ntile = K_ / BK; }
    __host__ __device__ bool next(int i, Unit& u) const {
        const long L = (long)i * G + c; if (L >= nwg) return false;
        int wgid = (int)L; { const int q = nwg / NXCD, r = nwg % NXCD, xcd = wgid % NXCD, off = wgid / NXCD; wgid = (xcd < r ? xcd * (q + 1) : r * (q + 1) + (xcd - r) * q) + off; }
        const int nig = WGM * nN, gid = wgid / nig, fm = gid * WGM, gsz = (nM - fm) < WGM ? (nM - fm) : WGM;
        u.pm = fm + ((wgid % nig) % gsz); u.pn = (wgid % nig) / gsz; u.k0 = 0; u.nt = ntile; u.kind = 0; u.slot = 0; return true;
    }
};

struct TeamOrder {
    int x, j, pn, npair, streamk;
    __host__ __device__ void init(int K_, int c_, int streamk_) { x = c_ & 7; const int l = c_ >> 3; j = l >> 2; pn = l & 3; npair = K_ / (2 * BK); streamk = streamk_; }
    __host__ __device__ bool next(int i, Unit& u) const {
        if (!streamk) { const int q = i * 8 + j; if (q >= 9) return false; u.pm = 9 * x + q; u.pn = pn; u.k0 = 0; u.nt = 2 * npair; u.kind = 0; u.slot = 0; return true; }
        const int total = 9 * npair, R1 = ((j + 1) * total) / 8; int p = (j * total) / 8;
        for (int ii = 0; ; ++ii) {
            if (p >= R1) return false;
            const int panel = p / npair, off = p - panel * npair, tend = (panel + 1) * npair, end = R1 < tend ? R1 : tend;
            if (ii == i) { u.pm = 9 * x + panel; u.pn = pn; u.k0 = off * 2; u.nt = (end - p) * 2; u.kind = off > 0 ? 1 : (end < tend ? 2 : 0);
                u.slot = x * 28 + (u.kind == 1 ? j - 1 : j) * 4 + pn; return true; }
            p = end;
        }
    }
};
template <class Epi, class Sched>
__device__ __forceinline__ void gemm_phase(LAS unsigned char* lds, const Gemm g, const Sched& S, const Epi& E) {
    const int tid = threadIdx.x, wid = __builtin_amdgcn_readfirstlane(tid >> 6), lane = tid & 63, wr = wid >> 2, wc = wid & 3, fr = lane & 15, fq = lane >> 4;
    const int K = g.K;
    unsigned voffA[2], voffB[2];
#pragma unroll
    for (int i = 0; i < 2; ++i) { int R, C; stage_rc(tid * 16 + i * 8192, R, C); const int Rb = (R & ~31) + perm32(R & 31);
        voffA[i] = (unsigned)(R * K + C) * 2u; voffB[i] = (unsigned)(Rb * K + C) * 2u; }
    const size_t kstep = (size_t)(BK * 2);
    const size_t hstep = (size_t)HALF * K * 2;
    const size_t tstep = 2 * hstep;
    const unsigned ldsw = (unsigned)wid * 1024u;
    const int aoff = lds_byte(wr * 64 + fr, fq * 8), boff = lds_byte(wc * 32 + fr, fq * 8);
#define PG8_SA(b, h) (((b) * 2 + (h)) * HTB)
#define PG8_SB(b, h) ((4 + (b) * 2 + (h)) * HTB)
#define PG8_STAGE(bufoff, gbase, voff) do { _Pragma("unroll") for (int _i = 0; _i < 2; ++_i) \
        __builtin_amdgcn_global_load_lds((const unsigned*)((const char*)(gbase) + (voff)[_i]), (LAS unsigned*)(lds + (bufoff) + ldsw + _i * 8192), 16, 0, 0); } while (0)
#define PG8_LDA(dst, b, h) do { _Pragma("unroll") for (int m = 0; m < 4; ++m) _Pragma("unroll") for (int k = 0; k < 2; ++k) dst[m][k] = *(const LAS bf16x8*)(lds + PG8_SA(b, h) + aoff + m * 2048 + k * 1024); } while (0)
#define PG8_LDB(dst, b, h) do { _Pragma("unroll") for (int n = 0; n < 2; ++n) _Pragma("unroll") for (int k = 0; k < 2; ++k) dst[n][k] = *(const LAS bf16x8*)(lds + PG8_SB(b, h) + boff + n * 2048 + k * 1024); } while (0)
#define PG8_MMA(ai, bj, At, Bt) do { __builtin_amdgcn_s_setprio(1); _Pragma("unroll") for (int m = 0; m < 4; ++m) _Pragma("unroll") for (int n = 0; n < 2; ++n) _Pragma("unroll") for (int k = 0; k < 2; ++k) \
        acc[ai][bj][m][n] = __builtin_amdgcn_mfma_f32_16x16x32_bf16(Bt[n][k], At[m][k], acc[ai][bj][m][n], 0, 0, 0); __builtin_amdgcn_s_setprio(0); } while (0)
#define PG8_WAIT_V(n) asm volatile("s_waitcnt vmcnt(" #n ")" ::: "memory")
#define PG8_WAIT_L(n) asm volatile("s_waitcnt lgkmcnt(" #n ")" ::: "memory")
#define PG8_BAR __builtin_amdgcn_s_barrier()
#define PG8_SCHED __builtin_amdgcn_sched_barrier(0)
    Unit cur, nxt; int ui = 0;
    if (!S.next(0, cur)) return;
    f32x4 acc[2][2][4][2];
    if constexpr (Epi::FUSED) E.init(acc, cur, wid, lane);
    else {
#pragma unroll
    for (int a = 0; a < 2; ++a)
#pragma unroll
        for (int b = 0; b < 2; ++b)
#pragma unroll
            for (int m = 0; m < 4; ++m)
#pragma unroll
                for (int n = 0; n < 2; ++n) acc[a][b][m][n] = (f32x4){0.f, 0.f, 0.f, 0.f};
    }
    bf16x8 At[4][2], B0[2][2], B1[2][2];
    const char* cA = (const char*)g.A + (size_t)cur.pm * tstep + (size_t)cur.k0 * kstep; const char* cB = (const char*)g.Bt + (size_t)cur.pn * tstep + (size_t)cur.k0 * kstep;
#if GEMM_SP2
    PG8_STAGE(PG8_SB(0, 0), cB, voffB); PG8_STAGE(PG8_SB(0, 1), cB + hstep, voffB); PG8_STAGE(PG8_SA(0, 0), cA, voffA); PG8_STAGE(PG8_SA(0, 1), cA + hstep, voffA);
    if (wr == 1) PG8_BAR;
    PG8_WAIT_V(2); PG8_BAR;
    PG8_STAGE(PG8_SB(1, 0), cB + kstep, voffB); PG8_STAGE(PG8_SA(1, 0), cA + kstep, voffA); PG8_STAGE(PG8_SB(1, 1), cB + hstep + kstep, voffB);
    PG8_WAIT_V(6); PG8_BAR;
#else
    PG8_STAGE(PG8_SB(0, 0), cB, voffB); PG8_STAGE(PG8_SA(0, 0), cA, voffA); PG8_STAGE(PG8_SB(0, 1), cB + hstep, voffB); PG8_STAGE(PG8_SA(0, 1), cA + hstep, voffA);
    if (wr == 1) PG8_BAR;
    PG8_WAIT_V(4); PG8_BAR;
    PG8_STAGE(PG8_SB(1, 0), cB + kstep, voffB); PG8_STAGE(PG8_SA(1, 0), cA + kstep, voffA); PG8_STAGE(PG8_SB(1, 1), cB + hstep + kstep, voffB);
    PG8_WAIT_V(6); PG8_BAR;
#endif
    for (;;) {
        const bool has_next = S.next(ui + 1, nxt);
        const char* nA = has_next ? (const char*)g.A + (size_t)nxt.pm * tstep + (size_t)nxt.k0 * kstep : cA; const char* nB = has_next ? (const char*)g.Bt + (size_t)nxt.pn * tstep + (size_t)nxt.k0 * kstep : cB;
        const int nt = cur.nt;
        for (int t = 0; t < nt; t += 2) {
            const bool last = (t == nt - 2);
            const char* a1 = cA + (size_t)(t + 1) * kstep;
            const char* a2 = last ? nA : cA + (size_t)(t + 2) * kstep; const char* b2 = last ? nB : cB + (size_t)(t + 2) * kstep;
            const char* a3 = a2 + kstep; const char* b3 = b2 + kstep;
#if GEMM_SP2
            PG8_LDB(B0, 0, 0); PG8_LDB(B1, 0, 1); PG8_SCHED; PG8_LDA(At, 0, 0); PG8_STAGE(PG8_SA(1, 1), a1 + hstep, voffA);
            PG8_WAIT_V(8); PG8_WAIT_L(0); PG8_BAR; PG8_MMA(0, 0, At, B0); PG8_MMA(0, 1, At, B1); PG8_BAR; PG8_SCHED;
            PG8_LDA(At, 0, 1); PG8_STAGE(PG8_SB(0, 0), b2, voffB); PG8_STAGE(PG8_SB(0, 1), b2 + hstep, voffB); PG8_STAGE(PG8_SA(0, 0), a2, voffA);
            PG8_WAIT_V(8); PG8_WAIT_L(0); PG8_BAR; PG8_MMA(1, 0, At, B0); PG8_MMA(1, 1, At, B1); PG8_BAR; PG8_SCHED;
            PG8_LDB(B0, 1, 0); PG8_LDB(B1, 1, 1); PG8_SCHED; PG8_LDA(At, 1, 0); PG8_STAGE(PG8_SA(0, 1), a2 + hstep, voffA);
            PG8_WAIT_V(8); PG8_WAIT_L(0); PG8_BAR; PG8_MMA(0, 0, At, B0); PG8_MMA(0, 1, At, B1); PG8_BAR; PG8_SCHED;
            PG8_LDA(At, 1, 1); PG8_STAGE(PG8_SB(1, 0), b3, voffB); PG8_STAGE(PG8_SB(1, 1), b3 + hstep, voffB); PG8_STAGE(PG8_SA(1, 0), a3, voffA);
            PG8_WAIT_V(8); PG8_WAIT_L(0); PG8_BAR; PG8_MMA(1, 0, At, B0); PG8_MMA(1, 1, At, B1); PG8_BAR; PG8_SCHED;
#else
            PG8_LDB(B0, 0, 0); PG8_SCHED; PG8_LDA(At, 0, 0); PG8_STAGE(PG8_SA(1, 1), a1 + hstep, voffA);
            PG8_WAIT_L(8); PG8_BAR; PG8_WAIT_L(0); PG8_MMA(0, 0, At, B0); PG8_BAR; PG8_SCHED;
            PG8_LDB(B1, 0, 1); PG8_STAGE(PG8_SB(0, 0), b2, voffB);
            PG8_BAR; PG8_WAIT_L(0); PG8_MMA(0, 1, At, B1); PG8_BAR;
            PG8_LDA(At, 0, 1); PG8_STAGE(PG8_SA(0, 0), a2, voffA);
            PG8_BAR; PG8_WAIT_L(0); PG8_MMA(1, 0, At, B0); PG8_BAR; PG8_SCHED;
            PG8_STAGE(PG8_SB(0, 1), b2 + hstep, voffB);
            PG8_WAIT_V(6); PG8_BAR; PG8_MMA(1, 1, At, B1); PG8_BAR;
            PG8_LDB(B0, 1, 0); PG8_SCHED; PG8_LDA(At, 1, 0); PG8_STAGE(PG8_SA(0, 1), a2 + hstep, voffA);
            PG8_WAIT_L(8); PG8_BAR; PG8_WAIT_L(0); PG8_MMA(0, 0, At, B0); PG8_BAR; PG8_SCHED;
            PG8_LDB(B1, 1, 1); PG8_STAGE(PG8_SB(1, 0), b3, voffB);
            PG8_BAR; PG8_WAIT_L(0); PG8_MMA(0, 1, At, B1); PG8_BAR;
            PG8_LDA(At, 1, 1); PG8_STAGE(PG8_SA(1, 0), a3, voffA);
            PG8_BAR; PG8_WAIT_L(0); PG8_MMA(1, 0, At, B0); PG8_BAR; PG8_SCHED;
            PG8_STAGE(PG8_SB(1, 1), b3 + hstep, voffB);
            PG8_WAIT_V(6); PG8_BAR; PG8_MMA(1, 1, At, B1); PG8_BAR;
#endif
        }
        if constexpr (Epi::FUSED) {
            if (wr == 0) PG8_BAR;
            E.fused(acc, cur, wr, wc, fr, fq, lds + STAGE_BYTES, wid, lane);
            if (wr == 1) PG8_BAR;
        } else {
#if GEMM_ALIGN_EPI
            if (wr == 0) PG8_BAR;
            E(acc, cur, wr, wc, fr, fq);
            if (wr == 1) PG8_BAR;
#else
            E(acc, cur, wr, wc, fr, fq);
#endif
        }
        if (!has_next) break;
        if constexpr (Epi::FUSED) E.init(acc, nxt, wid, lane);
        else {
#pragma unroll
        for (int a = 0; a < 2; ++a)
#pragma unroll
            for (int b = 0; b < 2; ++b)
#pragma unroll
                for (int m = 0; m < 4; ++m)
#pragma unroll
                    for (int n = 0; n < 2; ++n) acc[a][b][m][n] = (f32x4){0.f, 0.f, 0.f, 0.f};
        }
        cur = nxt; cA = nA; cB = nB; ++ui;
    }
    PG8_WAIT_V(0);
    if (wr == 0) PG8_BAR;
    PG8_BAR;
#undef PG8_SA
#undef PG8_SB
#undef PG8_STAGE
#undef PG8_LDA
#undef PG8_LDB
#undef PG8_MMA
#undef PG8_WAIT_V
#undef PG8_WAIT_L
#undef PG8_BAR
#undef PG8_SCHED
}
}
using pg8::Unit;
typedef f32x4 Acc[2][2][4][2];


struct EpiProj {
    static constexpr bool FUSED = false;
    bf16_t* H; const float* rope; float* out;
    __device__ __forceinline__ void operator()(const Acc& acc, const Unit& u, int wr, int wc, int fr, int fq) const {
        const int pn = u.pn;
#pragma unroll
        for (int ai = 0; ai < 2; ++ai)
#pragma unroll
            for (int m = 0; m < 4; ++m) {
                const int row = u.pm * 256 + ai * 128 + wr * 64 + m * 16 + fr;
                const int pos = row < MP ? (row & (SEQ - 1)) : PAST + ((row - MP) & (DEC_L - 1));
                bf16_t* rowp = H + (size_t)row * D_IN + pn * 256 + wc * 32 + 8 * fq;
#pragma unroll
                for (int bj = 0; bj < 2; ++bj) {
                    f32x4 v0 = acc[ai][bj][m][0], v1 = acc[ai][bj][m][1];
                    if (pn >= 3) {
#pragma unroll
                        for (int j = 0; j < 4; j += 2) { const f32x2 a = gelu_tanh_pk((f32x2){v0[j], v0[j + 1]}), b = gelu_tanh_pk((f32x2){v1[j], v1[j + 1]}); v0[j] = a.x; v0[j + 1] = a.y; v1[j] = b.x; v1[j + 1] = b.y; }
                    } else {
                        const bool is_v = (pn == 2 && bj == 1);
                        if (!is_v) {
                            f32x4 p0, p1;
#pragma unroll
                            for (int j = 0; j < 4; ++j) { p0[j] = __shfl_xor(v0[j], 16); p1[j] = __shfl_xor(v1[j], 16); }
                            if ((wc & 1) == 0 && fq < 2) {
                                const f32x4 c0 = *(const f32x4*)(rope + pos * 16), c1 = *(const f32x4*)(rope + pos * 16 + 4), s0 = *(const f32x4*)(rope + pos * 16 + 8), s1 = *(const f32x4*)(rope + pos * 16 + 12);
                                if (fq == 0) { v0 = v0 * c0 - p0 * s0; v1 = v1 * c1 - p1 * s1; }
                                else         { v0 = v0 * c0 + p0 * s0; v1 = v1 * c1 + p1 * s1; }
                            }
                        }
                        if (pn == 2) {
                            const int c = wc * 32 + 8 * fq;
                            float* o = nullptr;
                            if (row >= MP) o = out + (bj ? O_VS : O_KS) + (size_t)(row - MP) * 128 + c;
                            else if ((row & (SEQ - 1)) >= SEQ - 128) o = out + (bj ? O_VP : O_KP) + ((size_t)(row >> 11) * 128 + ((row & (SEQ - 1)) - (SEQ - 128))) * 128 + c;
                            if (o) { *(f32x4*)o = v0; *(f32x4*)(o + 4) = v1; }
                        } else { v0 = v0 * 0.18033688011112042f; v1 = v1 * 0.18033688011112042f; }
                    }
                    u32x4 w; w.x = cvt_pk_bf16(v0[0], v0[1]); w.y = cvt_pk_bf16(v0[2], v0[3]); w.z = cvt_pk_bf16(v1[0], v1[1]); w.w = cvt_pk_bf16(v1[2], v1[3]);
                    *(u32x4*)(rowp + bj * 128) = w;
                }
            }
    }
};
template <int WHICH> struct EpiLn {
    static constexpr bool FUSED = true;
    int set;
    __device__ __forceinline__ void init(Acc& acc, const Unit& u, int wid_, int lane_) const {
        int lane = lane_, wid = wid_; asm volatile("" : "+v"(lane)); asm volatile("" : "+s"(wid));
        const int fr = lane & 15, fq = lane >> 4, wr = wid >> 2, wc = wid & 3, tid = wid * 64 + lane;
        typedef const Params __attribute__((address_space(4)))* KP;
        KP pp = (KP)__builtin_amdgcn_kernarg_segment_ptr(); asm volatile("" : "+s"(pp));
        unsigned char* ws = pp->ws;
        if (u.kind == 2) {
            unsigned* flg = (unsigned*)(ws + WS_FLG) + set * 224 * 64;
            unsigned sp = 0;
            while ((unsigned)__builtin_amdgcn_readfirstlane(__hip_atomic_load(flg + 64 * u.slot, __ATOMIC_RELAXED, __HIP_MEMORY_SCOPE_AGENT)) < 8u) { __builtin_amdgcn_s_sleep(2); if (++sp > (1u << 22)) break; }
            asm volatile("" ::: "memory");
            const unsigned long long* sl = (const unsigned long long*)(ws + WS_SLAB) + (size_t)u.slot * 16384 + (size_t)tid;
#pragma unroll
            for (int ai = 0; ai < 2; ++ai)
#pragma unroll
                for (int bj = 0; bj < 2; ++bj)
#pragma unroll
                    for (int m = 0; m < 4; ++m)
#pragma unroll
                        for (int n = 0; n < 2; ++n) {
                            const unsigned long long a = __hip_atomic_load(sl, __ATOMIC_RELAXED, __HIP_MEMORY_SCOPE_AGENT);
                            sl += 512; asm volatile("" : "+v"(sl));
                            const unsigned lo = (unsigned)a, hi = (unsigned)(a >> 32);
                            acc[ai][bj][m][n] = (f32x4){bflo(lo), bfhi(lo), bflo(hi), bfhi(hi)}; }
            return;
        }
        const int rbase = u.pm * 256, col0 = u.pn * 256 + wc * 32 + 8 * fq;
#pragma unroll
        for (int ai = 0; ai < 2; ++ai)
#pragma unroll
            for (int m = 0; m < 4; ++m) { const int rl = ai * 128 + wr * 64 + m * 16 + fr;
#pragma unroll
                for (int bj = 0; bj < 2; ++bj) {
                    { const u32x4 h = *(const u32x4*)((const bf16_t*)(ws + (WHICH == 1 ? WS_XB : WS_HB)) + (size_t)(rbase + rl) * D + col0 + bj * 128);
                        acc[ai][bj][m][0] = (f32x4){bflo(h.x), bfhi(h.x), bflo(h.y), bfhi(h.y)} * ALPHA; acc[ai][bj][m][1] = (f32x4){bflo(h.z), bfhi(h.z), bflo(h.w), bfhi(h.w)} * ALPHA; } } }
    }
    __device__ __forceinline__ void fused(const Acc& acc, const Unit& u, int wr_, int wc_, int fr_, int fq_, LAS unsigned char* lx, int wid_, int lane_) const {
        int lane = lane_, wid = wid_; asm volatile("" : "+v"(lane)); asm volatile("" : "+s"(wid));
        const int fr = lane & 15, fq = lane >> 4, wr = wid >> 2, wc = wid & 3, tid = wid * 64 + lane;
        typedef const Params __attribute__((address_space(4)))* KP;
        KP pp = (KP)__builtin_amdgcn_kernarg_segment_ptr(); asm volatile("" : "+s"(pp));
        unsigned char* ws = pp->ws;
        if (u.kind == 1) {
            unsigned* flg = (unsigned*)(ws + WS_FLG) + set * 224 * 64;
            unsigned long long* sl = (unsigned long long*)(ws + WS_SLAB) + (size_t)u.slot * 16384 + (size_t)tid;
#pragma unroll
            for (int ai = 0; ai < 2; ++ai)
#pragma unroll
                for (int bj = 0; bj < 2; ++bj)
#pragma unroll
                    for (int m = 0; m < 4; ++m)
#pragma unroll
                        for (int n = 0; n < 2; ++n) { const f32x4 v = acc[ai][bj][m][n];
                            __hip_atomic_store(sl, ((unsigned long long)cvt_pk_bf16(v[2], v[3]) << 32) | cvt_pk_bf16(v[0], v[1]), __ATOMIC_RELAXED, __HIP_MEMORY_SCOPE_AGENT);
                            sl += 512; asm volatile("" : "+v"(sl)); }
            asm volatile("s_waitcnt vmcnt(0)" ::: "memory");
            if (lane == 0) __hip_atomic_fetch_add(flg + 64 * u.slot, 1u, __ATOMIC_RELAXED, __HIP_MEMORY_SCOPE_AGENT);
            return;
        }
        bf16_t* Hout = (bf16_t*)(ws + WS_HB); float* Y = pp->out + O_Y;
        const float* gam = WHICH == 1 ? pp->ln1_g : pp->ln2_g; const float* bet = WHICH == 1 ? pp->ln1_b : pp->ln2_b;
        unsigned long long* xbuf = (unsigned long long*)(ws + (WHICH == 1 ? WS_XB1 : WS_XB2)); unsigned* cnt = (unsigned*)(ws + WS_CNT) + set * 72 * 64;
        const int rbase = u.pm * 256, col0 = u.pn * 256 + wc * 32 + 8 * fq;
        LAS f32x2* P = (LAS f32x2*)lx;
        LAS f32x2* S = (LAS f32x2*)(lx + 8192);
#pragma unroll
        for (int ai = 0; ai < 2; ++ai)
#pragma unroll
            for (int m = 0; m < 4; ++m) {
                float s = 0.f;
#pragma unroll
                for (int bj = 0; bj < 2; ++bj)
#pragma unroll
                    for (int n = 0; n < 2; ++n) { const f32x4 x = acc[ai][bj][m][n]; s += (x[0] + x[1]) + (x[2] + x[3]); }
                s += __shfl_xor(s, 16); s += __shfl_xor(s, 32);
                const float mw = s * (1.0f / 64.0f); float q = 0.f;
#pragma unroll
                for (int bj = 0; bj < 2; ++bj)
#pragma unroll
                    for (int n = 0; n < 2; ++n) { const f32x4 d = acc[ai][bj][m][n] - mw; q += (d[0] * d[0] + d[1] * d[1]) + (d[2] * d[2] + d[3] * d[3]); }
                q += __shfl_xor(q, 16); q += __shfl_xor(q, 32);
                if (fq == 0) P[(ai * 128 + wr * 64 + m * 16 + fr) * 4 + wc] = (f32x2){mw, q};
            }
        asm volatile("s_waitcnt lgkmcnt(0)" ::: "memory"); __builtin_amdgcn_s_barrier(); asm volatile("" ::: "memory");
        const int row = wid * 32 + (lane & 31);
        if (lane < 32) {
            const f32x2 a = P[row * 4 + 0], b = P[row * 4 + 1], c = P[row * 4 + 2], d = P[row * 4 + 3];
            const float mt = (a.x + b.x + c.x + d.x) * 0.25f;
            const float da = a.x - mt, db = b.x - mt, dc = c.x - mt, dd = d.x - mt;
            const float m2 = (a.y + b.y) + (c.y + d.y) + 64.0f * ((da * da + db * db) + (dc * dc + dd * dd));
            __hip_atomic_store(xbuf + ((size_t)(rbase + row) * 4 + u.pn), ((unsigned long long)__float_as_uint(m2) << 32) | __float_as_uint(mt), __ATOMIC_RELAXED, __HIP_MEMORY_SCOPE_AGENT);
        }
        asm volatile("s_waitcnt vmcnt(0)" ::: "memory");
        if (lane == 0) __hip_atomic_fetch_add(cnt + 64 * u.pm, 1u, __ATOMIC_RELAXED, __HIP_MEMORY_SCOPE_AGENT);
        if (wid == 0) { unsigned sp = 0;
            while ((unsigned)__builtin_amdgcn_readfirstlane(__hip_atomic_load(cnt + 64 * u.pm, __ATOMIC_RELAXED, __HIP_MEMORY_SCOPE_AGENT)) < 32u) { __builtin_amdgcn_s_sleep(2); if (++sp > (1u << 22)) break; }
            asm volatile("" ::: "memory"); }
        asm volatile("s_waitcnt vmcnt(0) lgkmcnt(0)" ::: "memory"); __builtin_amdgcn_s_barrier(); asm volatile("" ::: "memory");
        if (lane < 32) {
            const unsigned long long* slot = xbuf + (size_t)(rbase + row) * 4; float mt[4], m2[4]; float ms = 0.f;
#pragma unroll
            for (int t = 0; t < 4; ++t) { const unsigned long long w = __hip_atomic_load(slot + t, __ATOMIC_RELAXED, __HIP_MEMORY_SCOPE_AGENT); mt[t] = __uint_as_float((unsigned)w); m2[t] = __uint_as_float((unsigned)(w >> 32)); ms += mt[t]; }
            const float mean = ms * 0.25f; float q = 0.f;
#pragma unroll
            for (int t = 0; t < 4; ++t) { const float dm = mt[t] - mean; q += m2[t] + 256.0f * dm * dm; }
            S[row] = (f32x2){mean, rsqrtf(q * (1.0f / 1024.0f) + LN_EPS)};
        }
        asm volatile("s_waitcnt lgkmcnt(0)" ::: "memory"); __builtin_amdgcn_s_barrier(); asm volatile("" ::: "memory");
        f32x4 g0[2], g1[2], b0[2], b1[2];
#pragma unroll
        for (int bj = 0; bj < 2; ++bj) { g0[bj] = *(const f32x4*)(gam + col0 + bj * 128); g1[bj] = *(const f32x4*)(gam + col0 + bj * 128 + 4); b0[bj] = *(const f32x4*)(bet + col0 + bj * 128); b1[bj] = *(const f32x4*)(bet + col0 + bj * 128 + 4); }
#pragma unroll
        for (int ai = 0; ai < 2; ++ai)
#pragma unroll
            for (int m = 0; m < 4; ++m) { const int rl = ai * 128 + wr * 64 + m * 16 + fr; const f32x2 st = S[rl];
#pragma unroll
                for (int bj = 0; bj < 2; ++bj) { const f32x4 y0 = (acc[ai][bj][m][0] - st.x) * st.y * g0[bj] + b0[bj], y1 = (acc[ai][bj][m][1] - st.x) * st.y * g1[bj] + b1[bj];
                    if (WHICH == 1) { u32x4 w; w.x = cvt_pk_bf16(y0[0], y0[1]); w.y = cvt_pk_bf16(y0[2], y0[3]); w.z = cvt_pk_bf16(y1[0], y1[1]); w.w = cvt_pk_bf16(y1[2], y1[3]);
                        *(u32x4*)(Hout + (size_t)(rbase + rl) * D + col0 + bj * 128) = w; }
                    else { float* yr = Y + (size_t)(rbase + rl) * D + col0 + bj * 128; __builtin_nontemporal_store(y0, (f32x4*)yr); __builtin_nontemporal_store(y1, (f32x4*)(yr + 4)); } } }
        asm volatile("s_waitcnt lgkmcnt(0)" ::: "memory"); __builtin_amdgcn_s_barrier(); asm volatile("" ::: "memory");
    }
};
struct EpiSwiglu {
    static constexpr bool FUSED = false;
    bf16_t* ACT;
    __device__ __forceinline__ void operator()(const Acc& acc, const Unit& u, int wr, int wc, int fr, int fq) const {
        const int col0 = u.pn * 128 + wc * 32 + 8 * fq;
#pragma unroll
        for (int ai = 0; ai < 2; ++ai)
#pragma unroll
            for (int m = 0; m < 4; ++m) { const int row = u.pm * 256 + ai * 128 + wr * 64 + m * 16 + fr;
                f32x4 a0 = acc[ai][0][m][0], a1 = acc[ai][0][m][1]; const f32x4 b0 = acc[ai][1][m][0], b1 = acc[ai][1][m][1];
#pragma unroll
                for (int j = 0; j < 4; j += 2) { const f32x2 p0 = silu_mul_pk((f32x2){a0[j], a0[j + 1]}, (f32x2){b0[j], b0[j + 1]}), p1 = silu_mul_pk((f32x2){a1[j], a1[j + 1]}, (f32x2){b1[j], b1[j + 1]});
                    a0[j] = p0.x; a0[j + 1] = p0.y; a1[j] = p1.x; a1[j + 1] = p1.y; }
                u32x4 w; w.x = cvt_pk_bf16(a0[0], a0[1]); w.y = cvt_pk_bf16(a0[2], a0[3]); w.z = cvt_pk_bf16(a1[0], a1[1]); w.w = cvt_pk_bf16(a1[2], a1[3]);
                *(u32x4*)(ACT + (size_t)row * D_FF + col0) = w; }
    }
};

__device__ __forceinline__ void transpose_tile(const float* W, bf16_t* Bt, int K, int N, int tk, int tn, int mode, LAS float* tile) {
    const int t = threadIdx.x;
    { const int r = t >> 4, c4 = (t & 15) * 4;
#pragma unroll
      for (int i = 0; i < 2; ++i) { const int k = r + 32 * i; const f32x4 v = *(const f32x4*)(W + (size_t)(tk * 64 + k) * N + tn * 64 + c4);
          tile[k * 65 + c4] = v[0]; tile[k * 65 + c4 + 1] = v[1]; tile[k * 65 + c4 + 2] = v[2]; tile[k * 65 + c4 + 3] = v[3]; } }
    __syncthreads();
    { const int n = t >> 3, k8 = (t & 7) * 8; float v[8];
#pragma unroll
      for (int j = 0; j < 8; ++j) v[j] = tile[(k8 + j) * 65 + n];
      int ng = tn * 64 + n;
      if (mode == 1) { const int up = ng >= D_FF; const int n2 = up ? ng - D_FF : ng; ng = 256 * (n2 >> 7) + (n2 & 127) + (up ? 128 : 0); }
      u32x4 w; w.x = cvt_pk_bf16(v[0], v[1]); w.y = cvt_pk_bf16(v[2], v[3]); w.z = cvt_pk_bf16(v[4], v[5]); w.w = cvt_pk_bf16(v[6], v[7]);
      *(u32x4*)(Bt + (size_t)ng * K + tk * 64 + k8) = w; }
    __syncthreads();
}
__device__ void late_transposes(const Params& p, LAS unsigned char* lds, int first, int stride, int part, int end) {
    LAS float* tile = (LAS float*)lds;
    bf16_t* W2 = (bf16_t*)(p.ws + WS_W2); bf16_t* W3 = (bf16_t*)(p.ws + WS_W3); bf16_t* W4 = (bf16_t*)(p.ws + WS_W4);
    constexpr int T2 = 16 * 16, T3 = 16 * 88, T4 = 44 * 16;
    if (part == 0) {
        for (int i = first; i < T2 + T3 && i < end; i += stride) {
            if (i < T2) transpose_tile(p.w_out, W2, D, D, i / 16, i % 16, 0, tile);
            else { const int j = i - T2; transpose_tile(p.w_gu, W3, D, 2 * D_FF, j / 88, j % 88, 1, tile); }
        }
    } else for (int j = first; j < T4 && j < end; j += stride) transpose_tile(p.w_down, W4, D_FF, D, j / 16, j % 16, 0, tile);
}
__device__ void prologue(const Params& p, LAS unsigned char* lds) {
    const int G = gridDim.x, bid = blockIdx.x, t = threadIdx.x;
    LAS float* tile = (LAS float*)lds;
    bf16_t* W1 = (bf16_t*)(p.ws + WS_W1);
    for (int i = bid; i < 16 * 28; i += G) transpose_tile(p.w_in, W1, D, D_IN, i / 28, i % 28, 0, tile);
    bf16_t* XB = (bf16_t*)(p.ws + WS_XB);
    const size_t n8 = (size_t)M * D / 8, np8 = (size_t)MP * D / 8;
    for (size_t i = (size_t)bid * NTHREADS + t; i < n8; i += (size_t)G * NTHREADS) {
        const float* src = i < np8 ? p.x_prompt + i * 8 : p.x_sample + (i - np8) * 8;
        const f32x4 a = *(const f32x4*)src, b = *(const f32x4*)(src + 4);
        u32x4 w; w.x = cvt_pk_bf16(a[0], a[1]); w.y = cvt_pk_bf16(a[2], a[3]); w.z = cvt_pk_bf16(b[0], b[1]); w.w = cvt_pk_bf16(b[2], b[3]);
        *(u32x4*)(XB + i * 8) = w;
    }
    float* rope = (float*)(p.ws + WS_ROPE);
    for (int i = bid * NTHREADS + t; i < 2048 * 8; i += G * NTHREADS) {
        const int pos = i >> 3, k = i & 7;
        const float inv = (float)exp(-(double)k * 0.125 * 13.122363377404328);
        const double ang = (double)((float)pos * inv);
        rope[pos * 16 + k] = (float)cos(ang); rope[pos * 16 + 8 + k] = (float)sin(ang);
    }
    bf16_t* WSB = (bf16_t*)(p.ws + WS_WS);
    for (int i = bid * NTHREADS + t; i < 8 * 128 * 128 / 2; i += G * NTHREADS) {
        const int e = i * 2, ri = (e >> 7) & 127, cj = e & 127; const bool ok = !(ri < 64 && cj >= 64);
        const f32x2 v = *(const f32x2*)(p.w_sp + e);
        *(unsigned*)(WSB + e) = ok ? cvt_pk_bf16(v[0], v[1]) : 0u;
    }
}

constexpr int KS_STRIDE = 72, VT_STRIDE = 200;
constexpr int LDS_KS = 0, LDS_VT = LDS_KS + 2 * 192 * KS_STRIDE * 2, LDS_ASSQ = LDS_VT + 2 * 64 * VT_STRIDE * 2;
__device__ void attn_unit(const Params& p, LAS unsigned char* lds, int unit) {
    int t_ = threadIdx.x; asm volatile("" : "+v"(t_));
    const int t = t_, wid = t >> 6, lane = t & 63, fr = lane & 15, fq = lane >> 4;
    const bool samp = unit >= 256; const int b = samp ? unit - 256 : unit >> 5, c = samp ? 2 : (unit & 31);
    const int r0 = samp ? MP + b * 64 : b * SEQ + c * 64;
    const int kstart = samp ? 0 : (c >= 2 ? 0 : (2 - c) * 64);
    const bf16_t* H = (const bf16_t*)(p.ws + WS_H);
    LAS bf16_t* Ks = (LAS bf16_t*)(lds + LDS_KS); LAS bf16_t* Vt = (LAS bf16_t*)(lds + LDS_VT); LAS float* ssq = (LAS float*)(lds + LDS_ASSQ);
    const int h = wid;
    bf16x8 qf[4][2];
#pragma unroll
    for (int qt = 0; qt < 4; ++qt)
#pragma unroll
        for (int ks = 0; ks < 2; ++ks) qf[qt][ks] = *(const bf16x8*)(H + (size_t)(r0 + qt * 16 + fr) * D_IN + C_Q + h * 64 + ks * 32 + fq * 8);
#pragma unroll
    for (int qi = 0; qi < 6; ++qi) { const int q = t + qi * NTHREADS;
        const int key = q >> 4, cc = q & 15, kvh = cc >> 3, d0 = (cc & 7) * 8;
        u32x4 kw = {0u, 0u, 0u, 0u}, vw = {0u, 0u, 0u, 0u};
        if (key >= kstart) {
            if (samp && key < 128) {
                const float* ck = p.cache_k + ((size_t)(b * 128 + key) * 2 + kvh) * 64 + d0; const float* cv = p.cache_v + ((size_t)(b * 128 + key) * 2 + kvh) * 64 + d0;
                const f32x4 a0 = *(const f32x4*)ck, a1 = *(const f32x4*)(ck + 4), b0 = *(const f32x4*)cv, b1 = *(const f32x4*)(cv + 4);
                kw.x = cvt_pk_bf16(a0[0], a0[1]); kw.y = cvt_pk_bf16(a0[2], a0[3]); kw.z = cvt_pk_bf16(a1[0], a1[1]); kw.w = cvt_pk_bf16(a1[2], a1[3]);
                vw.x = cvt_pk_bf16(b0[0], b0[1]); vw.y = cvt_pk_bf16(b0[2], b0[3]); vw.z = cvt_pk_bf16(b1[0], b1[1]); vw.w = cvt_pk_bf16(b1[2], b1[3]);
            } else {
                const bf16_t* hr = H + (size_t)(r0 - 128 + key) * D_IN;
                kw = *(const u32x4*)(hr + C_K + kvh * 64 + d0); vw = *(const u32x4*)(hr + C_V + kvh * 64 + d0);
            }
        }
        *(LAS u32x4*)(Ks + (kvh * 192 + key) * KS_STRIDE + d0) = kw;
        LAS bf16_t* vt = Vt + (kvh * 64 + d0) * VT_STRIDE + ((((key >> 3) ^ (cc & 7)) << 3) | (key & 7));
        vt[0 * VT_STRIDE] = (bf16_t)(vw.x & 0xffff); vt[1 * VT_STRIDE] = (bf16_t)(vw.x >> 16); vt[2 * VT_STRIDE] = (bf16_t)(vw.y & 0xffff); vt[3 * VT_STRIDE] = (bf16_t)(vw.y >> 16);
        vt[4 * VT_STRIDE] = (bf16_t)(vw.z & 0xffff); vt[5 * VT_STRIDE] = (bf16_t)(vw.z >> 16); vt[6 * VT_STRIDE] = (bf16_t)(vw.w & 0xffff); vt[7 * VT_STRIDE] = (bf16_t)(vw.w >> 16);
    }
    __syncthreads();
    const int kvh = h >> 2;
    const float sink = p.sinks[h] * 1.4426950408889634f;
    f32x4 o[4][4];
#pragma unroll
    for (int qp = 0; qp < 2; ++qp) {
        f32x4 s[2][12];
#pragma unroll
        for (int kt = 0; kt < 12; ++kt) {
            s[0][kt] = (f32x4){0.f, 0.f, 0.f, 0.f}; s[1][kt] = (f32x4){0.f, 0.f, 0.f, 0.f};
#pragma unroll
            for (int ks = 0; ks < 2; ++ks) { const bf16x8 kf = *(const LAS bf16x8*)(Ks + (kvh * 192 + kt * 16 + fr) * KS_STRIDE + ks * 32 + fq * 8);
                s[0][kt] = __builtin_amdgcn_mfma_f32_16x16x32_bf16(kf, qf[2 * qp][ks], s[0][kt], 0, 0, 0);
                s[1][kt] = __builtin_amdgcn_mfma_f32_16x16x32_bf16(kf, qf[2 * qp + 1][ks], s[1][kt], 0, 0, 0); }
        }
        if (kstart > 0) {
#pragma unroll
            for (int kt = 0; kt < 12; ++kt) if (kt * 16 < kstart) { s[0][kt] = (f32x4){-1e30f, -1e30f, -1e30f, -1e30f}; s[1][kt] = s[0][kt]; } }
        float inv[2];
#pragma unroll
        for (int e = 0; e < 2; ++e) {
            float mx = sink;
#pragma unroll
            for (int kt = 0; kt < 12; ++kt) mx = fmaxf(mx, fmaxf(fmaxf(s[e][kt][0], s[e][kt][1]), fmaxf(s[e][kt][2], s[e][kt][3])));
            mx = fmaxf(mx, __shfl_xor(mx, 16)); mx = fmaxf(mx, __shfl_xor(mx, 32));
            float sum = 0.f;
#pragma unroll
            for (int kt = 0; kt < 12; ++kt) {
#pragma unroll
                for (int j = 0; j < 4; ++j) { const float ex = __builtin_amdgcn_exp2f(s[e][kt][j] - mx); s[e][kt][j] = ex; sum += ex; } }
            sum += __shfl_xor(sum, 16); sum += __shfl_xor(sum, 32);
            inv[e] = 1.0f / (sum + __builtin_amdgcn_exp2f(sink - mx));
#pragma unroll
            for (int dt = 0; dt < 4; ++dt) o[2 * qp + e][dt] = (f32x4){0.f, 0.f, 0.f, 0.f};
        }
#pragma unroll
        for (int kp = 0; kp < 6; ++kp) {
            bf16x8 pf[2];
#pragma unroll
            for (int e = 0; e < 2; ++e) { u32x4 pw; pw.x = cvt_pk_bf16(s[e][2 * kp][0], s[e][2 * kp][1]); pw.y = cvt_pk_bf16(s[e][2 * kp][2], s[e][2 * kp][3]);
                pw.z = cvt_pk_bf16(s[e][2 * kp + 1][0], s[e][2 * kp + 1][1]); pw.w = cvt_pk_bf16(s[e][2 * kp + 1][2], s[e][2 * kp + 1][3]); pf[e] = __builtin_bit_cast(bf16x8, pw); }
#pragma unroll
            for (int dt = 0; dt < 4; ++dt) {
                const LAS bf16_t* vrow = Vt + (kvh * 64 + dt * 16 + fr) * VT_STRIDE; const int sw = (dt * 2 + (fr >> 3)) & 7;
                const int k0 = kp * 32 + fq * 4, k1 = k0 + 16;
                const u32x2 va = *(const LAS u32x2*)(vrow + ((((k0 >> 3) ^ sw) << 3) | (k0 & 7))), vb = *(const LAS u32x2*)(vrow + ((((k1 >> 3) ^ sw) << 3) | (k1 & 7)));
                const u32x4 vv = {va.x, va.y, vb.x, vb.y};
                o[2 * qp][dt] = __builtin_amdgcn_mfma_f32_16x16x32_bf16(__builtin_bit_cast(bf16x8, vv), pf[0], o[2 * qp][dt], 0, 0, 0);
                o[2 * qp + 1][dt] = __builtin_amdgcn_mfma_f32_16x16x32_bf16(__builtin_bit_cast(bf16x8, vv), pf[1], o[2 * qp + 1][dt], 0, 0, 0);
            }
        }
#pragma unroll
        for (int e = 0; e < 2; ++e) { const int qt = 2 * qp + e;
            float q2 = 0.f;
#pragma unroll
            for (int dt = 0; dt < 4; ++dt) { o[qt][dt] = o[qt][dt] * inv[e];
#pragma unroll
                for (int j = 0; j < 4; ++j) q2 += o[qt][dt][j] * o[qt][dt][j]; }
            q2 += __shfl_xor(q2, 16); q2 += __shfl_xor(q2, 32);
            if (fq == 0) ssq[h * 64 + qt * 16 + fr] = q2; }
    }
    __syncthreads();
    bf16_t* CAT = (bf16_t*)(p.ws + WS_CAT);
#pragma unroll
    for (int qt = 0; qt < 4; ++qt) {
        float tot = 0.f;
#pragma unroll
        for (int hh = 0; hh < 8; ++hh) tot += ssq[hh * 64 + qt * 16 + fr];
        const float rs = rsqrtf(tot * (1.0f / 512.0f) + LN_EPS);
#pragma unroll
        for (int dt = 0; dt < 4; ++dt) { const int col = h * 64 + dt * 16 + fq * 4; const f32x4 g = *(const f32x4*)(p.g_attn + col); const f32x4 v = o[qt][dt] * rs * g;
            u32x2 w; w.x = cvt_pk_bf16(v[0], v[1]); w.y = cvt_pk_bf16(v[2], v[3]);
            *(u32x2*)(CAT + (size_t)(r0 + qt * 16 + fr) * D + col) = w; }
    }
    __syncthreads();
}

constexpr int VM_STRIDE = 136;
constexpr int LDS_VMT = 0, LDS_GST = LDS_VMT + 8 * 64 * VM_STRIDE * 2, LDS_GSSQ = LDS_GST + 128 * 2 * 4;
__device__ void gate_unit(const Params& p, LAS unsigned char* lds, int unit) {
    int t_ = threadIdx.x; asm volatile("" : "+v"(t_));
    const int t = t_, wid = t >> 6, lane = t & 63, fr = lane & 15, fq = lane >> 4;
    const bool samp = unit >= 256; const int w_ = unit & 127; const int b = samp ? unit - 256 : w_ >> 4, c = samp ? 0 : 2 * (w_ & 15) + (unit < 128 ? 1 : 0), par = c & 1;
    const int r0 = samp ? MP + b * 64 : b * SEQ + c * 64;
    const int Kc = par ? 128 : 64, jr0 = par ? r0 - 64 : r0;
    const bf16_t* H = (const bf16_t*)(p.ws + WS_H);
    LAS bf16_t* VmT = (LAS bf16_t*)(lds + LDS_VMT); LAS float* st = (LAS float*)(lds + LDS_GST); LAS float* ssq = (LAS float*)(lds + LDS_GSSQ);
    const int g = wid, jl = lane >> 3, c8 = (lane & 7) * 8, col = g * 64 + c8;
    LAS f32x2* part = (LAS f32x2*)(lds + LDS_VMT);
    u32x4 raw[16];
#pragma unroll
    for (int it = 0; it < 16; ++it) if (it * 8 < Kc) raw[it] = *(const u32x4*)(H + (size_t)(jr0 + it * 8 + jl) * D_IN + C_VM + col);
#pragma unroll
    for (int it = 0; it < 16; ++it) if (it * 8 < Kc) {
        const u32x4 w = raw[it];
        const float v0 = bflo(w.x), v1 = bfhi(w.x), v2 = bflo(w.y), v3 = bfhi(w.y), v4 = bflo(w.z), v5 = bfhi(w.z), v6 = bflo(w.w), v7 = bfhi(w.w);
        float sm = ((v0 + v1) + (v2 + v3)) + ((v4 + v5) + (v6 + v7));
        float sq = ((v0 * v0 + v1 * v1) + (v2 * v2 + v3 * v3)) + ((v4 * v4 + v5 * v5) + (v6 * v6 + v7 * v7));
        sm += __shfl_xor(sm, 1); sq += __shfl_xor(sq, 1); sm += __shfl_xor(sm, 2); sq += __shfl_xor(sq, 2); sm += __shfl_xor(sm, 4); sq += __shfl_xor(sq, 4);
        if ((lane & 7) == 0) part[(it * 8 + jl) * 8 + g] = (f32x2){sm, sq};
    }
    __syncthreads();
    if (t < Kc) { float sm = 0.f, sq = 0.f;
#pragma unroll
        for (int gg = 0; gg < 8; ++gg) { const f32x2 pv = part[t * 8 + gg]; sm += pv.x; sq += pv.y; }
        const float mean = sm * (1.0f / 512.0f), var = fmaxf(sq * (1.0f / 512.0f) - mean * mean, 0.f);
        st[t * 2] = mean; st[t * 2 + 1] = rsqrtf(var + LN_EPS); }
    __syncthreads();
    { const f32x4 ga0 = *(const f32x4*)(p.ln_v_g + col), ga1 = *(const f32x4*)(p.ln_v_g + col + 4), be0 = *(const f32x4*)(p.ln_v_b + col), be1 = *(const f32x4*)(p.ln_v_b + col + 4);
#pragma unroll
      for (int it = 0; it < 16; ++it) if (it * 8 < Kc) { const int j = it * 8 + jl;
          const u32x4 w = raw[it];
          const float mean = st[j * 2], rstd = st[j * 2 + 1];
          f32x4 v0 = {bflo(w.x), bfhi(w.x), bflo(w.y), bfhi(w.y)}, v1 = {bflo(w.z), bfhi(w.z), bflo(w.w), bfhi(w.w)};
          v0 = (v0 - mean) * rstd * ga0 + be0; v1 = (v1 - mean) * rstd * ga1 + be1;
          if (samp) { float* o = p.out + O_MS + (size_t)(b * 64 + j) * 512 + col; *(f32x4*)o = v0; *(f32x4*)(o + 4) = v1; }
          const unsigned w0 = cvt_pk_bf16(v0[0], v0[1]), w1 = cvt_pk_bf16(v0[2], v0[3]), w2 = cvt_pk_bf16(v1[0], v1[1]), w3 = cvt_pk_bf16(v1[2], v1[3]);
          LAS bf16_t* d = VmT + (g * 64 + c8) * VM_STRIDE + ((it ^ (lane & 7)) * 8 + jl);
          d[0 * VM_STRIDE] = (bf16_t)(w0 & 0xffff); d[1 * VM_STRIDE] = (bf16_t)(w0 >> 16); d[2 * VM_STRIDE] = (bf16_t)(w1 & 0xffff); d[3 * VM_STRIDE] = (bf16_t)(w1 >> 16);
          d[4 * VM_STRIDE] = (bf16_t)(w2 & 0xffff); d[5 * VM_STRIDE] = (bf16_t)(w2 >> 16); d[6 * VM_STRIDE] = (bf16_t)(w3 & 0xffff); d[7 * VM_STRIDE] = (bf16_t)(w3 >> 16); } }
    __syncthreads();
    const bf16_t* WSB = (const bf16_t*)(p.ws + WS_WS) + (size_t)g * 128 * 128 + (size_t)(par * 64) * 128;
    f32x4 acc[4][4];
#pragma unroll
    for (int it = 0; it < 4; ++it)
#pragma unroll
        for (int dt = 0; dt < 4; ++dt) acc[it][dt] = (f32x4){0.f, 0.f, 0.f, 0.f};
    bf16x8 wf[4][4];
#pragma unroll
    for (int ks = 0; ks < 4; ++ks) if (ks * 32 < Kc) {
#pragma unroll
        for (int it = 0; it < 4; ++it) wf[ks][it] = *(const bf16x8*)(WSB + (size_t)(it * 16 + fr) * 128 + ks * 32 + fq * 8); }
#pragma unroll
    for (int ks = 0; ks < 4; ++ks) if (ks * 32 < Kc) {
        bf16x8 vf[4];
#pragma unroll
        for (int dt = 0; dt < 4; ++dt) vf[dt] = *(const LAS bf16x8*)(VmT + (g * 64 + dt * 16 + fr) * VM_STRIDE + (((ks * 4 + fq) ^ ((dt * 2 + (fr >> 3)) & 7)) * 8));
#pragma unroll
        for (int it = 0; it < 4; ++it)
#pragma unroll
            for (int dt = 0; dt < 4; ++dt) acc[it][dt] = __builtin_amdgcn_mfma_f32_16x16x32_bf16(vf[dt], wf[ks][it], acc[it][dt], 0, 0, 0);
    }
    u32x2 uw[4][4];
#pragma unroll
    for (int it = 0; it < 4; ++it)
#pragma unroll
        for (int dt = 0; dt < 4; ++dt) uw[it][dt] = *(const u32x2*)(H + (size_t)(r0 + it * 16 + fr) * D_IN + C_U + g * 64 + dt * 16 + fq * 4);
#pragma unroll
    for (int it = 0; it < 4; ++it) {
        const float bs = p.b_sp[g * 128 + par * 64 + it * 16 + fr]; float q2 = 0.f;
#pragma unroll
        for (int dt = 0; dt < 4; ++dt) { const f32x4 uv = {bflo(uw[it][dt].x), bfhi(uw[it][dt].x), bflo(uw[it][dt].y), bfhi(uw[it][dt].y)};
            acc[it][dt] = (acc[it][dt] + bs) * uv;
#pragma unroll
            for (int j = 0; j < 4; ++j) q2 += acc[it][dt][j] * acc[it][dt][j]; }
        q2 += __shfl_xor(q2, 16); q2 += __shfl_xor(q2, 32);
        if (fq == 0) ssq[g * 64 + it * 16 + fr] = q2;
    }
    __syncthreads();
    bf16_t* CAT = (bf16_t*)(p.ws + WS_CAT);
#pragma unroll
    for (int it = 0; it < 4; ++it) {
        float tot = 0.f;
#pragma unroll
        for (int gg = 0; gg < 8; ++gg) tot += ssq[gg * 64 + it * 16 + fr];
        const float rs = rsqrtf(tot * (1.0f / 512.0f) + LN_EPS);
#pragma unroll
        for (int dt = 0; dt < 4; ++dt) { const int col = g * 64 + dt * 16 + fq * 4; const f32x4 gm = *(const f32x4*)(p.g_cmlp + col); const f32x4 v = acc[it][dt] * rs * gm;
            u32x2 w; w.x = cvt_pk_bf16(v[0], v[1]); w.y = cvt_pk_bf16(v[2], v[3]);
            *(u32x2*)(CAT + (size_t)(r0 + it * 16 + fr) * D + 512 + col) = w; }
    }
    __syncthreads();
}

template <bool TO_BF16>
__device__ void ln_rows(const float* Z, const float* gam, const float* bet, bf16_t* Hb, float* Y) {
    const int lane = threadIdx.x & 63, gw = blockIdx.x * 8 + (threadIdx.x >> 6), nw = gridDim.x * 8;
    f32x4 g[4], be[4];
#pragma unroll
    for (int i = 0; i < 4; ++i) { g[i] = *(const f32x4*)(gam + i * 256 + lane * 4); be[i] = *(const f32x4*)(bet + i * 256 + lane * 4); }
    for (int row = gw; row < M; row += nw) {
        const float* z = Z + (size_t)row * D; f32x4 v[4]; float s = 0.f;
#pragma unroll
        for (int i = 0; i < 4; ++i) { v[i] = *(const f32x4*)(z + i * 256 + lane * 4); s += (v[i][0] + v[i][1]) + (v[i][2] + v[i][3]); }
#pragma unroll
        for (int o = 1; o < 64; o <<= 1) s += __shfl_xor(s, o);
        const float mean = s * (1.0f / 1024.0f); float q = 0.f;
#pragma unroll
        for (int i = 0; i < 4; ++i) { v[i] = v[i] - mean; q += (v[i][0] * v[i][0] + v[i][1] * v[i][1]) + (v[i][2] * v[i][2] + v[i][3] * v[i][3]); }
#pragma unroll
        for (int o = 1; o < 64; o <<= 1) q += __shfl_xor(q, o);
        const float rstd = rsqrtf(q * (1.0f / 1024.0f) + LN_EPS);
#pragma unroll
        for (int i = 0; i < 4; ++i) { const f32x4 y = v[i] * rstd * g[i] + be[i];
            if (TO_BF16) { u32x2 w; w.x = cvt_pk_bf16(y[0], y[1]); w.y = cvt_pk_bf16(y[2], y[3]); *(u32x2*)(Hb + (size_t)row * D + i * 256 + lane * 4) = w; }
            else *(f32x4*)(Y + (size_t)row * D + i * 256 + lane * 4) = y; }
    }
}

__global__ void __launch_bounds__(NTHREADS, 2) fwd_mega(Params p) {
    extern __shared__ __attribute__((aligned(16))) unsigned char smem[];
    LAS unsigned char* lds = (LAS unsigned char*)smem;
    const int G = gridDim.x, bid = blockIdx.x;
    volatile LAS unsigned* xst = (volatile LAS unsigned*)(lds + LDS_BYTES - 16);
    if (threadIdx.x == 0) { xst[0] = 0u; xst[1] = 0u; }
    __syncthreads();
    XcdBarrier xb = xcd_barrier_post((unsigned*)(p.ws + WS_BAR) + (NBAR > 1 ? p.pad * 4096 : 0), xst);
#define IN(ph) (p.ph_lo <= (ph) && (ph) < p.ph_hi)
#define REP(ph) for (int _r = 0; _r < ((ph) == PROBE_PH ? 3 : 1); ++_r)
#define SYNC(ph) do { if (p.coop && IN(ph) && IN((ph) + 1)) xcd_barrier(xb); } while (0)
    if (IN(0)) REP(0) prologue(p, lds);
    SYNC(0);
    if (IN(1)) { pg8::Gemm g{(const bf16_t*)(p.ws + WS_XB), (const bf16_t*)(p.ws + WS_W1), M, D_IN, D}; pg8::StaticOrder S; S.init(M, D_IN, D, G, bid);
        EpiProj E{(bf16_t*)(p.ws + WS_H), (const float*)(p.ws + WS_ROPE), p.out}; pg8::gemm_phase(lds, g, S, E); }
    SYNC(1);
    if (IN(2)) {
        if (G == 256) {
            for (int k = 0; k < 3; ++k) {
                int u = -1;
                if (k == 0) u = bid;
                else if (k == 1) u = bid < 32 ? 256 + bid : (bid < 160 ? 288 + (bid - 32) : 288 + 128 + (bid - 160));
                else if (bid >= 160 && bid < 224) u = 288 + 224 + (bid - 160);
                if (u < 0) break;
                if (u < 288) attn_unit(p, lds, u); else gate_unit(p, lds, u - 288);
            }
            int t0 = 0, tn = 0;
            if (bid < 32) { t0 = bid * 9; tn = 9; } else if (bid < 160) { t0 = 288 + (bid - 32) * 8; tn = 8; } else if (bid >= 224) { t0 = 1312 + (bid - 224) * 11; tn = 11; }
            if (tn) late_transposes(p, lds, t0, 1, 0, t0 + tn);
        } }
    SYNC(2);
    if (IN(3)) { for (int rep = 0; rep < (PROBE_PH == 3 ? 3 : 1); ++rep) { if (rep) xcd_barrier(xb);
        pg8::Gemm g{(const bf16_t*)(p.ws + WS_CAT), (const bf16_t*)(p.ws + WS_W2), M, D, D}; pg8::TeamOrder S; S.init(D, bid, P3_STREAMK);
        EpiLn<1> E{(PROBE_PH == 10 ? p.pad * 2 : 0) + rep}; pg8::gemm_phase(lds, g, S, E); } }
    SYNC(3);
    if (IN(4)) REP(5) { pg8::Gemm g{(const bf16_t*)(p.ws + WS_HB), (const bf16_t*)(p.ws + WS_W3), M, 2 * D_FF, D}; pg8::StaticOrder S; S.init(M, 2 * D_FF, D, G, bid);
        EpiSwiglu E{(bf16_t*)(p.ws + WS_ACT)}; pg8::gemm_phase(lds, g, S, E);
        if (G == 256 && bid >= 48) late_transposes(p, lds, bid - 48, 208, 1, 1 << 30); }
    SYNC(4);
    if (IN(5)) { for (int rep = 0; rep < (PROBE_PH == 6 ? 3 : 1); ++rep) { if (rep) xcd_barrier(xb);
        pg8::Gemm g{(const bf16_t*)(p.ws + WS_ACT), (const bf16_t*)(p.ws + WS_W4), M, D, D_FF}; pg8::TeamOrder S; S.init(D_FF, bid, 1);
        EpiLn<2> E{(PROBE_PH == 10 ? p.pad * 2 + 1 : (PROBE_PH == 3 || PROBE_PH == 6) ? 3 : 1) + rep}; pg8::gemm_phase(lds, g, S, E); } }
#undef IN
#undef SYNC
}

#undef REP
#ifndef N_LAUNCHES
#define N_LAUNCHES 1
#endif
extern "C" void kernel_launch(void* const* d_in, const int* in_sizes, int n_in, void* d_out, int out_size, void* d_ws, size_t ws_size, hipStream_t stream) {
    static int grid = 0;
    if (grid == 0) {
        int dev = 0, cus = 0, per_cu = 0;
        hipGetDevice(&dev); hipDeviceGetAttribute(&cus, hipDeviceAttributeMultiprocessorCount, dev);
        if (hipFuncSetAttribute((const void*)fwd_mega, hipFuncAttributeMaxDynamicSharedMemorySize, LDS_BYTES) != hipSuccess) { fprintf(stderr, "hipFuncSetAttribute failed\n"); grid = -1; return; }
        if (hipOccupancyMaxActiveBlocksPerMultiprocessor(&per_cu, (const void*)fwd_mega, NTHREADS, LDS_BYTES) != hipSuccess || per_cu < 1) { fprintf(stderr, "occupancy query: %d\n", per_cu); per_cu = 1; }
        (void)hipGetLastError();
        grid = cus * (per_cu > 1 ? 1 : per_cu);
        if (grid != 256) { fprintf(stderr, "this kernel needs a grid of exactly 256 workgroups (one per CU), got %d\n", grid); grid = -1; return; }
        if (ws_size < WS_END) { fprintf(stderr, "workspace too small: %zu < %zu\n", ws_size, WS_END); grid = -1; return; }
    }
    if (grid < 0) return;
    if (hipMemsetAsync((char*)d_ws + WS_BAR, 0, WS_ZERO_BYTES, stream) != hipSuccess) { fprintf(stderr, "memset failed\n"); return; }
    Params p{};
    p.x_prompt = (const float*)d_in[0]; p.x_sample = (const float*)d_in[1]; p.cache_k = (const float*)d_in[2]; p.cache_v = (const float*)d_in[3]; p.w_in = (const float*)d_in[4];
    p.ln_v_g = (const float*)d_in[5]; p.ln_v_b = (const float*)d_in[6]; p.sinks = (const float*)d_in[7]; p.w_sp = (const float*)d_in[8]; p.b_sp = (const float*)d_in[9];
    p.g_attn = (const float*)d_in[10]; p.g_cmlp = (const float*)d_in[11]; p.w_out = (const float*)d_in[12]; p.ln1_g = (const float*)d_in[13]; p.ln1_b = (const float*)d_in[14];
    p.w_gu = (const float*)d_in[15]; p.w_down = (const float*)d_in[16]; p.ln2_g = (const float*)d_in[17]; p.ln2_b = (const float*)d_in[18];
    p.out = (float*)d_out; p.ws = (unsigned char*)d_ws;
#if N_LAUNCHES == 1
    p.ph_lo = 0; p.ph_hi = 6; p.coop = 1;
    void* args[] = {&p};
    hipError_t e = hipLaunchCooperativeKernel((const void*)fwd_mega, dim3(grid), dim3(NTHREADS), args, LDS_BYTES, stream);
#if PROBE_PH == 10
    p.pad = 1; e = hipLaunchCooperativeKernel((const void*)fwd_mega, dim3(grid), dim3(NTHREADS), args, LDS_BYTES, stream);
#endif
    if (e != hipSuccess) fprintf(stderr, "cooperative launch failed: %s (grid %d)\n", hipGetErrorString(e), grid);
#else
    for (int ph = 0; ph < 6; ++ph) { p.ph_lo = ph; p.ph_hi = ph + 1; p.coop = 0;
        hipLaunchKernelGGL(fwd_mega, dim3(grid), dim3(NTHREADS), LDS_BYTES, stream, p); }
#endif
}
```

```cpp
#include <hip/hip_runtime.h>
#include <hip/hip_cooperative_groups.h>
#include <cstdio>
#include <cstdint>
namespace cg = cooperative_groups;

#define LAS __attribute__((address_space(3)))
typedef unsigned short bf16_t;
typedef short bf16x8 __attribute__((ext_vector_type(8)));
typedef short bf16x4 __attribute__((ext_vector_type(4)));
typedef float f32x4 __attribute__((ext_vector_type(4)));
typedef float f32x2 __attribute__((ext_vector_type(2)));
typedef unsigned u32x4 __attribute__((ext_vector_type(4)));
typedef unsigned u32x2 __attribute__((ext_vector_type(2)));

#ifndef GEMM_SP2
#define GEMM_SP2 1
#endif
#ifndef GEMM_ALIGN_EPI
#define GEMM_ALIGN_EPI 1
#endif
#ifndef P3_STREAMK
#define P3_STREAMK 1
#endif
#ifndef PROBE_PH
#define PROBE_PH -1
#endif
constexpr int D = 1024, SEQ = 2048, NB = 8, DEC_B = 32, DEC_L = 64, PAST = 1024;
constexpr int MP = NB * SEQ, MS = DEC_B * DEC_L, M = MP + MS;
constexpr int D_IN = 1792, D_FF = 2816;
constexpr int C_Q = 0, C_K = 512, C_V = 640, C_U = 768, C_VM = 1280;
constexpr float ALPHA = 1.189207115002721f;
constexpr float LN_EPS = 1e-5f;
constexpr size_t O_Y = 0, O_KP = (size_t)M * D, O_VP = O_KP + 131072, O_KS = O_VP + 131072, O_VS = O_KS + 262144, O_MS = O_VS + 262144;
constexpr size_t WS_XB = 0;
constexpr size_t WS_H = WS_XB + (size_t)M * D * 2;
constexpr size_t WS_ACT = 0;
constexpr size_t WS_W1 = (size_t)M * D_FF * 2;
constexpr size_t WS_W2 = WS_W1 + (size_t)D_IN * D * 2;
constexpr size_t WS_W3 = WS_W2 + (size_t)D * D * 2;
constexpr size_t WS_W4 = WS_W3 + (size_t)2 * D_FF * D * 2;
constexpr size_t WS_WS = WS_W4 + (size_t)D * D_FF * 2;
constexpr size_t WS_ROPE = WS_WS + (size_t)8 * 128 * 128 * 2;
constexpr size_t WS_CAT = WS_ROPE + (size_t)2048 * 16 * 4;
constexpr size_t WS_HB = WS_CAT + (size_t)M * D * 2;
constexpr size_t WS_BAR = WS_HB + (size_t)M * D * 2;
constexpr int NSETS = (PROBE_PH == 3 || PROBE_PH == 6 || PROBE_PH == 10) ? 6 : 2, NBAR = PROBE_PH == 10 ? 2 : 1;
constexpr size_t WS_CNT = WS_BAR + (size_t)NBAR * 16384;
constexpr size_t WS_FLG = WS_CNT + (size_t)NSETS * 72 * 256;
constexpr size_t WS_ZERO_BYTES = (size_t)NBAR * 16384 + (size_t)NSETS * 72 * 256 + (size_t)NSETS * 224 * 256;
constexpr size_t WS_XB1 = WS_FLG + (size_t)NSETS * 224 * 256;
constexpr size_t WS_XB2 = WS_XB1 + (size_t)M * 4 * 8;
constexpr size_t WS_SLAB = WS_XB2 + (size_t)M * 4 * 8;
constexpr size_t WS_END = WS_SLAB + (size_t)224 * 131072;
constexpr int LDS_BYTES = 147456;
constexpr int NTHREADS = 512;

struct Params {
    const float *x_prompt, *x_sample, *cache_k, *cache_v, *w_in, *ln_v_g, *ln_v_b, *sinks, *w_sp, *b_sp, *g_attn, *g_cmlp, *w_out, *ln1_g, *ln1_b, *w_gu, *w_down, *ln2_g, *ln2_b;
    float* out;
    unsigned char* ws;
    int ph_lo, ph_hi, coop, pad;
};

__device__ __forceinline__ unsigned cvt_pk_bf16(float lo, float hi) { unsigned r; asm volatile("v_cvt_pk_bf16_f32 %0, %1, %2" : "=v"(r) : "v"(lo), "v"(hi)); return r; }
__device__ __forceinline__ float bf2f(unsigned short b) { return __uint_as_float(((unsigned)b) << 16); }
__device__ __forceinline__ float bflo(unsigned w) { return __uint_as_float(w << 16); }
__device__ __forceinline__ float bfhi(unsigned w) { return __uint_as_float(w & 0xffff0000u); }
__device__ __forceinline__ float fast_sigmoid(float x) { return __builtin_amdgcn_rcpf(1.0f + __builtin_amdgcn_exp2f(-1.4426950408889634f * x)); }
__device__ __forceinline__ float gelu_tanh(float x) { const float u = 1.5957691216057308f * (x + 0.044715f * x * x * x); return x * fast_sigmoid(u); }
__device__ __forceinline__ float silu(float x) { return x * fast_sigmoid(x); }
__device__ __forceinline__ f32x2 silu_mul_pk(f32x2 g, f32x2 u) {
    const f32x2 m = g * (-1.4426950408889634f);
    f32x2 e; e.x = __builtin_amdgcn_exp2f(m.x); e.y = __builtin_amdgcn_exp2f(m.y);
    const f32x2 d = e + 1.0f;
    f32x2 r; r.x = __builtin_amdgcn_rcpf(d.x); r.y = __builtin_amdgcn_rcpf(d.y);
    return (g * r) * u;
}
__device__ __forceinline__ f32x2 gelu_tanh_pk(f32x2 x) {
    const f32x2 f = (x * x) * (-0.10294324f) + (-2.3022082f);
    const f32x2 w = x * f;
    f32x2 e; e.x = __builtin_amdgcn_exp2f(w.x); e.y = __builtin_amdgcn_exp2f(w.y);
    const f32x2 d = e + 1.0f;
    f32x2 r; r.x = __builtin_amdgcn_rcpf(d.x); r.y = __builtin_amdgcn_rcpf(d.y);
    return x * r;
}


#define XB_TMO      128
#define XB_XCNT(j)  (256  + 64 * (j))
#define XB_XSUB(j)  (1280 + 64 * (j))
#define XB_XGEN(j)  (2304 + 64 * (j))
#define XB_TOP      3328
#define XB_TOPGEN   3392
#define XCD_BAR_WORDS 3456
#define XB_SPIN_CAP (1u << 18)
__device__ __forceinline__ unsigned xb_ld(unsigned* p)              { return __hip_atomic_load(p, __ATOMIC_RELAXED, __HIP_MEMORY_SCOPE_AGENT); }
__device__ __forceinline__ unsigned xb_add(unsigned* p, unsigned v) { return __hip_atomic_fetch_add(p, v, __ATOMIC_RELAXED, __HIP_MEMORY_SCOPE_AGENT); }
__device__ __forceinline__ unsigned xb_xcc_id() { return (unsigned)__builtin_amdgcn_s_getreg((3 << 11) | 20) & 0xFu; }
#define XB_SPIN(cond, bar) do { unsigned _sp = 0; while (cond) { __builtin_amdgcn_s_sleep(1); \
    if ((++_sp & 255u) == 0u) { if (xb_ld(&(bar)[XB_TMO])) break; if (_sp > XB_SPIN_CAP) { atomicAdd(&(bar)[XB_TMO], 1u); break; } } } } while (0)
struct XcdBarrier { unsigned* bar; unsigned x; volatile LAS unsigned* st; };
__device__ __forceinline__ XcdBarrier xcd_barrier_post(unsigned* bar, volatile LAS unsigned* st) {
    XcdBarrier b; b.bar = bar; b.x = xb_xcc_id(); b.st = st;
    if (threadIdx.x == 0) (void)xb_add(&bar[XB_XCNT(b.x)], 1u);
    return b;
}
__device__ __forceinline__ void xcd_barrier_complete(unsigned* bar, unsigned x, unsigned& nloc, unsigned& nx) {
    const unsigned G = gridDim.x * gridDim.y * gridDim.z;
    unsigned sum, cnt, mine, sp = 0u;
    for (;;) {
        sum = 0u; cnt = 0u; mine = 0u;
#pragma unroll
        for (unsigned j = 0; j < 16; ++j) { const unsigned c = xb_ld(&bar[XB_XCNT(j)]); sum += c; cnt += (c > 0u) ? 1u : 0u; mine = (j == x) ? c : mine; }
        if (sum == G) break;
        __builtin_amdgcn_s_sleep(1);
        if ((++sp & 255u) == 0u) { if (xb_ld(&bar[XB_TMO])) break; if (sp > XB_SPIN_CAP) { atomicAdd(&bar[XB_TMO], 1u); break; } }
    }
    nloc = mine > 0u ? mine : 1u; nx = cnt > 0u ? cnt : 1u;
}
__device__ __forceinline__ void xcd_barrier(const XcdBarrier& b) {
    asm volatile("s_waitcnt vmcnt(0)" ::: "memory");
    __syncthreads();
    if (threadIdx.x == 0) {
        unsigned* bar = b.bar;
        __builtin_amdgcn_s_waitcnt(0);
        unsigned nloc = b.st[0], nx = b.st[1];
        if (nloc == 0u) { xcd_barrier_complete(bar, b.x, nloc, nx); b.st[0] = nloc; b.st[1] = nx; }
        const unsigned old = xb_add(&bar[XB_XSUB(b.x)], 1u);
        const unsigned gen = old / nloc;
        if (old + 1u == (gen + 1u) * nloc) {
            __builtin_amdgcn_fence(__ATOMIC_RELEASE, "agent");
            asm volatile("s_waitcnt vmcnt(0)" ::: "memory");
            const unsigned og = xb_add(&bar[XB_TOP], 1u);
            const unsigned tg = og / nx;
            if (og + 1u == (tg + 1u) * nx) xb_add(&bar[XB_TOPGEN], 1u);
            else XB_SPIN(xb_ld(&bar[XB_TOPGEN]) == tg, bar);
            __builtin_amdgcn_fence(__ATOMIC_ACQUIRE, "agent");
            xb_add(&bar[XB_XGEN(b.x)], 1u);
            asm volatile("s_waitcnt vmcnt(0)" ::: "memory");
        } else {
            __builtin_amdgcn_fence(__ATOMIC_ACQUIRE, "agent");
            XB_SPIN(xb_ld(&bar[XB_TOPGEN]) == gen, bar);
            asm volatile("s_waitcnt vmcnt(0)" ::: "memory");
        }
    }
    __syncthreads();
}

namespace pg8 {
constexpr int BM = 256, BK = 64, HALF = 128, HTB = HALF * BK * 2, STAGE_BYTES = 8 * HTB, NXCD = 8, WGM = 8;
__host__ __device__ __forceinline__ int lds_byte(int r, int c) { const int st = (r >> 4) * 2 + (c >> 5), rr = r & 15, cc = c & 31, ob = rr * 64 + cc * 2; return st * 1024 + (ob ^ (((ob >> 9) & 1) << 5)); }
__host__ __device__ __forceinline__ void stage_rc(int b, int& R, int& C) { const int st = b / 1024, sb = b % 1024, swz = sb ^ (((sb >> 9) & 1) << 5); R = (st >> 1) * 16 + swz / 64; C = (st & 1) * 32 + (swz % 64) / 2; }
__host__ __device__ __forceinline__ int perm32(int rho) { const int n = rho >> 4, i = rho & 15; return 8 * (i >> 2) + 4 * n + (i & 3); }
struct Unit { int pm, pn, k0, nt, kind, slot; };
struct Gemm { const bf16_t* A; const bf16_t* Bt; int M, N, K; };
struct StaticOrder {
    int nM, nN, nwg, G, c, ntile;
    __host__ __device__ void init(int M_, int N_, int K_, int G_, int c_) { nM = M_ / BM; nN = N_ / BM; nwg = nM * nN; G = G_; c = c_; ntile = K_ / BK; }
    __host__ __device__ bool next(int i, Unit& u) const {
        const long L = (long)i * G + c; if (L >= nwg) return false;
        int wgid = (int)L; { const int q = nwg / NXCD, r = nwg % NXCD, xcd = wgid % NXCD, off = wgid / NXCD; wgid = (xcd < r ? xcd * (q + 1) : r * (q + 1) + (xcd - r) * q) + off; }
        const int nig = WGM * nN, gid = wgid / nig, fm = gid * WGM, gsz = (nM - fm) < WGM ? (nM - fm) : WGM;
        u.pm = fm + ((wgid % nig) % gsz); u.pn = (wgid % nig) / gsz; u.k0 = 0; u.nt = ntile; u.kind = 0; u.slot = 0; return true;
    }
};

struct TeamOrder {
    int x, j, pn, npair, streamk;
    __host__ __device__ void init(int K_, int c_, int streamk_) { x = c_ & 7; const int l = c_ >> 3; j = l >> 2; pn = l & 3; npair = K_ / (2 * BK); streamk = streamk_; }
    __host__ __device__ bool next(int i, Unit& u) const {
        if (!streamk) { const int q = i * 8 + j; if (q >= 9) return false; u.pm = 9 * x + q; u.pn = pn; u.k0 = 0; u.nt = 2 * npair; u.kind = 0; u.slot = 0; return true; }
        const int total = 9 * npair, R1 = ((j + 1) * total) / 8; int p = (j * total) / 8;
        for (int ii = 0; ; ++ii) {
            if (p >= R1) return false;
            const int panel = p / npair, off = p - panel * npair, tend = (panel + 1) * npair, end = R1 < tend ? R1 : tend;
            if (ii == i) { u.pm = 9 * x + panel; u.pn = pn; u.k0 = off * 2; u.nt = (end - p) * 2; u.kind = off > 0 ? 1 : (end < tend ? 2 : 0);
                u.slot = x * 28 + (u.kind == 1 ? j - 1 : j) * 4 + pn; return true; }
            p = end;
        }
    }
};
template <class Epi, class Sched>
__device__ __forceinline__ void gemm_phase(LAS unsigned char* lds, const Gemm g, const Sched& S, const Epi& E) {
    const int tid = threadIdx.x, wid = __builtin_amdgcn_readfirstlane(tid >> 6), lane = tid & 63, wr = wid >> 2, wc = wid & 3, fr = lane & 15, fq = lane >> 4;
    const int K = g.K;
    unsigned voffA[2], voffB[2];
#pragma unroll
    for (int i = 0; i < 2; ++i) { int R, C; stage_rc(tid * 16 + i * 8192, R, C); const int Rb = (R & ~31) + perm32(R & 31);
        voffA[i] = (unsigned)(R * K + C) * 2u; voffB[i] = (unsigned)(Rb * K + C) * 2u; }
    const size_t kstep = (size_t)(BK * 2);
    const size_t hstep = (size_t)HALF * K * 2;
    const size_t tstep = 2 * hstep;
    const unsigned ldsw = (unsigned)wid * 1024u;
    const int aoff = lds_byte(wr * 64 + fr, fq * 8), boff = lds_byte(wc * 32 + fr, fq * 8);
#define PG8_SA(b, h) (((b) * 2 + (h)) * HTB)
#define PG8_SB(b, h) ((4 + (b) * 2 + (h)) * HTB)
#define PG8_STAGE(bufoff, gbase, voff) do { _Pragma("unroll") for (int _i = 0; _i < 2; ++_i) \
        __builtin_amdgcn_global_load_lds((const unsigned*)((const char*)(gbase) + (voff)[_i]), (LAS unsigned*)(lds + (bufoff) + ldsw + _i * 8192), 16, 0, 0); } while (0)
#define PG8_LDA(dst, b, h) do { _Pragma("unroll") for (int m = 0; m < 4; ++m) _Pragma("unroll") for (int k = 0; k < 2; ++k) dst[m][k] = *(const LAS bf16x8*)(lds + PG8_SA(b, h) + aoff + m * 2048 + k * 1024); } while (0)
#define PG8_LDB(dst, b, h) do { _Pragma("unroll") for (int n = 0; n < 2; ++n) _Pragma("unroll") for (int k = 0; k < 2; ++k) dst[n][k] = *(const LAS bf16x8*)(lds + PG8_SB(b, h) + boff + n * 2048 + k * 1024); } while (0)
#define PG8_MMA(ai, bj, At, Bt) do { __builtin_amdgcn_s_setprio(1); _Pragma("unroll") for (int m = 0; m < 4; ++m) _Pragma("unroll") for (int n = 0; n < 2; ++n) _Pragma("unroll") for (int k = 0; k < 2; ++k) \
        acc[ai][bj][m][n] = __builtin_amdgcn_mfma_f32_16x16x32_bf16(Bt[n][k], At[m][k], acc[ai][bj][m][n], 0, 0, 0); __builtin_amdgcn_s_setprio(0); } while (0)
#define PG8_WAIT_V(n) asm volatile("s_waitcnt vmcnt(" #n ")" ::: "memory")
#define PG8_WAIT_L(n) asm volatile("s_waitcnt lgkmcnt(" #n ")" ::: "memory")
#define PG8_BAR __builtin_amdgcn_s_barrier()
#define PG8_SCHED __builtin_amdgcn_sched_barrier(0)
    Unit cur, nxt; int ui = 0;
    if (!S.next(0, cur)) return;
    f32x4 acc[2][2][4][2];
    if constexpr (Epi::FUSED) E.init(acc, cur, wid, lane);
    else {
#pragma unroll
    for (int a = 0; a < 2; ++a)
#pragma unroll
        for (int b = 0; b < 2; ++b)
#pragma unroll
            for (int m = 0; m < 4; ++m)
#pragma unroll
                for (int n = 0; n < 2; ++n) acc[a][b][m][n] = (f32x4){0.f, 0.f, 0.f, 0.f};
    }
    bf16x8 At[4][2], B0[2][2], B1[2][2];
    const char* cA = (const char*)g.A + (size_t)cur.pm * tstep + (size_t)cur.k0 * kstep; const char* cB = (const char*)g.Bt + (size_t)cur.pn * tstep + (size_t)cur.k0 * kstep;
#if GEMM_SP2
    PG8_STAGE(PG8_SB(0, 0), cB, voffB); PG8_STAGE(PG8_SB(0, 1), cB + hstep, voffB); PG8_STAGE(PG8_SA(0, 0), cA, voffA); PG8_STAGE(PG8_SA(0, 1), cA + hstep, voffA);
    if (wr == 1) PG8_BAR;
    PG8_WAIT_V(2); PG8_BAR;
    PG8_STAGE(PG8_SB(1, 0), cB + kstep, voffB); PG8_STAGE(PG8_SA(1, 0), cA + kstep, voffA); PG8_STAGE(PG8_SB(1, 1), cB + hstep + kstep, voffB);
    PG8_WAIT_V(6); PG8_BAR;
#else
    PG8_STAGE(PG8_SB(0, 0), cB, voffB); PG8_STAGE(PG8_SA(0, 0), cA, voffA); PG8_STAGE(PG8_SB(0, 1), cB + hstep, voffB); PG8_STAGE(PG8_SA(0, 1), cA + hstep, voffA);
    if (wr == 1) PG8_BAR;
    PG8_WAIT_V(4); PG8_BAR;
    PG8_STAGE(PG8_SB(1, 0), cB + kstep, voffB); PG8_STAGE(PG8_SA(1, 0), cA + kstep, voffA); PG8_STAGE(PG8_SB(1, 1), cB + hstep + kstep, voffB);
    PG8_WAIT_V(6); PG8_BAR;
#endif
    for (;;) {
        const bool has_next = S.next(ui + 1, nxt);
        const char* nA = has_next ? (const char*)g.A + (size_t)nxt.pm * tstep + (size_t)nxt.k0 * kstep : cA; const char* nB = has_next ? (const char*)g.Bt + (size_t)nxt.pn * tstep + (size_t)nxt.k0 * kstep : cB;
        const int nt = cur.nt;
        for (int t = 0; t < nt; t += 2) {
            const bool last = (t == nt - 2);
            const char* a1 = cA + (size_t)(t + 1) * kstep;
            const char* a2 = last ? nA : cA + (size_t)(t + 2) * kstep; const char* b2 = last ? nB : cB + (size_t)(t + 2) * kstep;
            const char* a3 = a2 + kstep; const char* b3 = b2 + kstep;
#if GEMM_SP2
            PG8_LDB(B0, 0, 0); PG8_LDB(B1, 0, 1); PG8_SCHED; PG8_LDA(At, 0, 0); PG8_STAGE(PG8_SA(1, 1), a1 + hstep, voffA);
            PG8_WAIT_V(8); PG8_WAIT_L(0); PG8_BAR; PG8_MMA(0, 0, At, B0); PG8_MMA(0, 1, At, B1); PG8_BAR; PG8_SCHED;
            PG8_LDA(At, 0, 1); PG8_STAGE(PG8_SB(0, 0), b2, voffB); PG8_STAGE(PG8_SB(0, 1), b2 + hstep, voffB); PG8_STAGE(PG8_SA(0, 0), a2, voffA);
            PG8_WAIT_V(8); PG8_WAIT_L(0); PG8_BAR; PG8_MMA(1, 0, At, B0); PG8_MMA(1, 1, At, B1); PG8_BAR; PG8_SCHED;
            PG8_LDB(B0, 1, 0); PG8_LDB(B1, 1, 1); PG8_SCHED; PG8_LDA(At, 1, 0); PG8_STAGE(PG8_SA(0, 1), a2 + hstep, voffA);
            PG8_WAIT_V(8); PG8_WAIT_L(0); PG8_BAR; PG8_MMA(0, 0, At, B0); PG8_MMA(0, 1, At, B1); PG8_BAR; PG8_SCHED;
            PG8_LDA(At, 1, 1); PG8_STAGE(PG8_SB(1, 0), b3, voffB); PG8_STAGE(PG8_SB(1, 1), b3 + hstep, voffB); PG8_STAGE(PG8_SA(1, 0), a3, voffA);
            PG8_WAIT_V(8); PG8_WAIT_L(0); PG8_BAR; PG8_MMA(1, 0, At, B0); PG8_MMA(1, 1, At, B1); PG8_BAR; PG8_SCHED;
#else
            PG8_LDB(B0, 0, 0); PG8_SCHED; PG8_LDA(At, 0, 0); PG8_STAGE(PG8_SA(1, 1), a1 + hstep, voffA);
            PG8_WAIT_L(8); PG8_BAR; PG8_WAIT_L(0); PG8_MMA(0, 0, At, B0); PG8_BAR; PG8_SCHED;
            PG8_LDB(B1, 0, 1); PG8_STAGE(PG8_SB(0, 0), b2, voffB);
            PG8_BAR; PG8_WAIT_L(0); PG8_MMA(0, 1, At, B1); PG8_BAR;
            PG8_LDA(At, 0, 1); PG8_STAGE(PG8_SA(0, 0), a2, voffA);
            PG8_BAR; PG8_WAIT_L(0); PG8_MMA(1, 0, At, B0); PG8_BAR; PG8_SCHED;
            PG8_STAGE(PG8_SB(0, 1), b2 + hstep, voffB);
            PG8_WAIT_V(6); PG8_BAR; PG8_MMA(1, 1, At, B1); PG8_BAR;
            PG8_LDB(B0, 1, 0); PG8_SCHED; PG8_LDA(At, 1, 0); PG8_STAGE(PG8_SA(0, 1), a2 + hstep, voffA);
            PG8_WAIT_L(8); PG8_BAR; PG8_WAIT_L(0); PG8_MMA(0, 0, At, B0); PG8_BAR; PG8_SCHED;
            PG8_LDB(B1, 1, 1); PG8_STAGE(PG8_SB(1, 0), b3, voffB);
            PG8_BAR; PG8_WAIT_L(0); PG8_MMA(0, 1, At, B1); PG8_BAR;
            PG8_LDA(At, 1, 1); PG8_STAGE(PG8_SA(1, 0), a3, voffA);
            PG8_BAR; PG8_WAIT_L(0); PG8_MMA(1, 0, At, B0); PG8_BAR; PG8_SCHED;
            PG8_STAGE(PG8_SB(1, 1), b3 + hstep, voffB);
            PG8_WAIT_V(6); PG8_BAR; PG8_MMA(1, 1, At, B1); PG8_BAR;
#endif
        }
        if constexpr (Epi::FUSED) {
            if (wr == 0) PG8_BAR;
            E.fused(acc, cur, wr, wc, fr, fq, lds + STAGE_BYTES, wid, lane);
            if (wr == 1) PG8_BAR;
        } else {
#if GEMM_ALIGN_EPI
            if (wr == 0) PG8_BAR;
            E(acc, cur, wr, wc, fr, fq);
            if (wr == 1) PG8_BAR;
#else
            E(acc, cur, wr, wc, fr, fq);
#endif
        }
        if (!has_next) break;
        if constexpr (Epi::FUSED) E.init(acc, nxt, wid, lane);
        else {
#pragma unroll
        for (int a = 0; a < 2; ++a)
#pragma unroll
            for (int b = 0; b < 2; ++b)
#pragma unroll
                for (int m = 0; m < 4; ++m)
#pragma unroll
                    for (int n = 0; n < 2; ++n) acc[a][b][m][n] = (f32x4){0.f, 0.f, 0.f, 0.f};
        }
        cur = nxt; cA = nA; cB = nB; ++ui;
    }
    PG8_WAIT_V(0);
    if (wr == 0) PG8_BAR;
    PG8_BAR;
#undef PG8_SA
#undef PG8_SB
#undef PG8_STAGE
#undef PG8_LDA
#undef PG8_LDB
#undef PG8_MMA
#undef PG8_WAIT_V
#undef PG8_WAIT_L
#undef PG8_BAR
#undef PG8_SCHED
}
}
using pg8::Unit;
typedef f32x4 Acc[2][2][4][2];


struct EpiProj {
    static constexpr bool FUSED = false;
    bf16_t* H; const float* rope; float* out;
    __device__ __forceinline__ void operator()(const Acc& acc, const Unit& u, int wr, int wc, int fr, int fq) const {
        const int pn = u.pn;
#pragma unroll
        for (int ai = 0; ai < 2; ++ai)
#pragma unroll
            for (int m = 0; m < 4; ++m) {
                const int row = u.pm * 256 + ai * 128 + wr * 64 + m * 16 + fr;
                const int pos = row < MP ? (row & (SEQ - 1)) : PAST + ((row - MP) & (DEC_L - 1));
                bf16_t* rowp = H + (size_t)row * D_IN + pn * 256 + wc * 32 + 8 * fq;
#pragma unroll
                for (int bj = 0; bj < 2; ++bj) {
                    f32x4 v0 = acc[ai][bj][m][0], v1 = acc[ai][bj][m][1];
                    if (pn >= 3) {
#pragma unroll
                        for (int j = 0; j < 4; j += 2) { const f32x2 a = gelu_tanh_pk((f32x2){v0[j], v0[j + 1]}), b = gelu_tanh_pk((f32x2){v1[j], v1[j + 1]}); v0[j] = a.x; v0[j + 1] = a.y; v1[j] = b.x; v1[j + 1] = b.y; }
                    } else {
                        const bool is_v = (pn == 2 && bj == 1);
                        if (!is_v) {
                            f32x4 p0, p1;
#pragma unroll
                            for (int j = 0; j < 4; ++j) { p0[j] = __shfl_xor(v0[j], 16); p1[j] = __shfl_xor(v1[j], 16); }
                            if ((wc & 1) == 0 && fq < 2) {
                                const f32x4 c0 = *(const f32x4*)(rope + pos * 16), c1 = *(const f32x4*)(rope + pos * 16 + 4), s0 = *(const f32x4*)(rope + pos * 16 + 8), s1 = *(const f32x4*)(rope + pos * 16 + 12);
                                if (fq == 0) { v0 = v0 * c0 - p0 * s0; v1 = v1 * c1 - p1 * s1; }
                                else         { v0 = v0 * c0 + p0 * s0; v1 = v1 * c1 + p1 * s1; }
                            }
                        }
                        if (pn == 2) {
                            const int c = wc * 32 + 8 * fq;
                            float* o = nullptr;
                            if (row >= MP) o = out + (bj ? O_VS : O_KS) + (size_t)(row - MP) * 128 + c;
                            else if ((row & (SEQ - 1)) >= SEQ - 128) o = out + (bj ? O_VP : O_KP) + ((size_t)(row >> 11) * 128 + ((row & (SEQ - 1)) - (SEQ - 128))) * 128 + c;
                            if (o) { *(f32x4*)o = v0; *(f32x4*)(o + 4) = v1; }
                        } else { v0 = v0 * 0.18033688011112042f; v1 = v1 * 0.18033688011112042f; }
                    }
                    u32x4 w; w.x = cvt_pk_bf16(v0[0], v0[1]); w.y = cvt_pk_bf16(v0[2], v0[3]); w.z = cvt_pk_bf16(v1[0], v1[1]); w.w = cvt_pk_bf16(v1[2], v1[3]);
                    *(u32x4*)(rowp + bj * 128) = w;
                }
            }
    }
};
template <int WHICH> struct EpiLn {
    static constexpr bool FUSED = true;
    int set;
    __device__ __forceinline__ void init(Acc& acc, const Unit& u, int wid_, int lane_) const {
        int lane = lane_, wid = wid_; asm volatile("" : "+v"(lane)); asm volatile("" : "+s"(wid));
        const int fr = lane & 15, fq = lane >> 4, wr = wid >> 2, wc = wid & 3, tid = wid * 64 + lane;
        typedef const Params __attribute__((address_space(4)))* KP;
        KP pp = (KP)__builtin_amdgcn_kernarg_segment_ptr(); asm volatile("" : "+s"(pp));
        unsigned char* ws = pp->ws;
        if (u.kind == 2) {
            unsigned* flg = (unsigned*)(ws + WS_FLG) + set * 224 * 64;
            unsigned sp = 0;
            while ((unsigned)__builtin_amdgcn_readfirstlane(__hip_atomic_load(flg + 64 * u.slot, __ATOMIC_RELAXED, __HIP_MEMORY_SCOPE_AGENT)) < 8u) { __builtin_amdgcn_s_sleep(2); if (++sp > (1u << 22)) break; }
            asm volatile("" ::: "memory");
            const unsigned long long* sl = (const unsigned long long*)(ws + WS_SLAB) + (size_t)u.slot * 16384 + (size_t)tid;
#pragma unroll
            for (int ai = 0; ai < 2; ++ai)
#pragma unroll
                for (int bj = 0; bj < 2; ++bj)
#pragma unroll
                    for (int m = 0; m < 4; ++m)
#pragma unroll
                        for (int n = 0; n < 2; ++n) {
                            const unsigned long long a = __hip_atomic_load(sl, __ATOMIC_RELAXED, __HIP_MEMORY_SCOPE_AGENT);
                            sl += 512; asm volatile("" : "+v"(sl));
                            const unsigned lo = (unsigned)a, hi = (unsigned)(a >> 32);
                            acc[ai][bj][m][n] = (f32x4){bflo(lo), bfhi(lo), bflo(hi), bfhi(hi)}; }
            return;
        }
        const int rbase = u.pm * 256, col0 = u.pn * 256 + wc * 32 + 8 * fq;
#pragma unroll
        for (int ai = 0; ai < 2; ++ai)
#pragma unroll
            for (int m = 0; m < 4; ++m) { const int rl = ai * 128 + wr * 64 + m * 16 + fr;
#pragma unroll
                for (int bj = 0; bj < 2; ++bj) {
                    { const u32x4 h = *(const u32x4*)((const bf16_t*)(ws + (WHICH == 1 ? WS_XB : WS_HB)) + (size_t)(rbase + rl) * D + col0 + bj * 128);
                        acc[ai][bj][m][0] = (f32x4){bflo(h.x), bfhi(h.x), bflo(h.y), bfhi(h.y)} * ALPHA; acc[ai][bj][m][1] = (f32x4){bflo(h.z), bfhi(h.z), bflo(h.w), bfhi(h.w)} * ALPHA; } } }
    }
    __device__ __forceinline__ void fused(const Acc& acc, const Unit& u, int wr_, int wc_, int fr_, int fq_, LAS unsigned char* lx, int wid_, int lane_) const {
        int lane = lane_, wid = wid_; asm volatile("" : "+v"(lane)); asm volatile("" : "+s"(wid));
        const int fr = lane & 15, fq = lane >> 4, wr = wid >> 2, wc = wid & 3, tid = wid * 64 + lane;
        typedef const Params __attribute__((address_space(4)))* KP;
        KP pp = (KP)__builtin_amdgcn_kernarg_segment_ptr(); asm volatile("" : "+s"(pp));
        unsigned char* ws = pp->ws;
        if (u.kind == 1) {
            unsigned* flg = (unsigned*)(ws + WS_FLG) + set * 224 * 64;
            unsigned long long* sl = (unsigned long long*)(ws + WS_SLAB) + (size_t)u.slot * 16384 + (size_t)tid;
#pragma unroll
            for (int ai = 0; ai < 2; ++ai)
#pragma unroll
                for (int bj = 0; bj < 2; ++bj)
#pragma unroll
                    for (int m = 0; m < 4; ++m)
#pragma unroll
                        for (int n = 0; n < 2; ++n) { const f32x4 v = acc[ai][bj][m][n];
                            __hip_atomic_store(sl, ((unsigned long long)cvt_pk_bf16(v[2], v[3]) << 32) | cvt_pk_bf16(v[0], v[1]), __ATOMIC_RELAXED, __HIP_MEMORY_SCOPE_AGENT);
                            sl += 512; asm volatile("" : "+v"(sl)); }
            asm volatile("s_waitcnt vmcnt(0)" ::: "memory");
            if (lane == 0) __hip_atomic_fetch_add(flg + 64 * u.slot, 1u, __ATOMIC_RELAXED, __HIP_MEMORY_SCOPE_AGENT);
            return;
        }
        bf16_t* Hout = (bf16_t*)(ws + WS_HB); float* Y = pp->out + O_Y;
        const float* gam = WHICH == 1 ? pp->ln1_g : pp->ln2_g; const float* bet = WHICH == 1 ? pp->ln1_b : pp->ln2_b;
        unsigned long long* xbuf = (unsigned long long*)(ws + (WHICH == 1 ? WS_XB1 : WS_XB2)); unsigned* cnt = (unsigned*)(ws + WS_CNT) + set * 72 * 64;
        const int rbase = u.pm * 256, col0 = u.pn * 256 + wc * 32 + 8 * fq;
        LAS f32x2* P = (LAS f32x2*)lx;
        LAS f32x2* S = (LAS f32x2*)(lx + 8192);
#pragma unroll
        for (int ai = 0; ai < 2; ++ai)
#pragma unroll
            for (int m = 0; m < 4; ++m) {
                float s = 0.f;
#pragma unroll
                for (int bj = 0; bj < 2; ++bj)
#pragma unroll
                    for (int n = 0; n < 2; ++n) { const f32x4 x = acc[ai][bj][m][n]; s += (x[0] + x[1]) + (x[2] + x[3]); }
                s += __shfl_xor(s, 16); s += __shfl_xor(s, 32);
                const float mw = s * (1.0f / 64.0f); float q = 0.f;
#pragma unroll
                for (int bj = 0; bj < 2; ++bj)
#pragma unroll
                    for (int n = 0; n < 2; ++n) { const f32x4 d = acc[ai][bj][m][n] - mw; q += (d[0] * d[0] + d[1] * d[1]) + (d[2] * d[2] + d[3] * d[3]); }
                q += __shfl_xor(q, 16); q += __shfl_xor(q, 32);
                if (fq == 0) P[(ai * 128 + wr * 64 + m * 16 + fr) * 4 + wc] = (f32x2){mw, q};
            }
        asm volatile("s_waitcnt lgkmcnt(0)" ::: "memory"); __builtin_amdgcn_s_barrier(); asm volatile("" ::: "memory");
        const int row = wid * 32 + (lane & 31);
        if (lane < 32) {
            const f32x2 a = P[row * 4 + 0], b = P[row * 4 + 1], c = P[row * 4 + 2], d = P[row * 4 + 3];
            const float mt = (a.x + b.x + c.x + d.x) * 0.25f;
            const float da = a.x - mt, db = b.x - mt, dc = c.x - mt, dd = d.x - mt;
            const float m2 = (a.y + b.y) + (c.y + d.y) + 64.0f * ((da * da + db * db) + (dc * dc + dd * dd));
            __hip_atomic_store(xbuf + ((size_t)(rbase + row) * 4 + u.pn), ((unsigned long long)__float_as_uint(m2) << 32) | __float_as_uint(mt), __ATOMIC_RELAXED, __HIP_MEMORY_SCOPE_AGENT);
        }
        asm volatile("s_waitcnt vmcnt(0)" ::: "memory");
        if (lane == 0) __hip_atomic_fetch_add(cnt + 64 * u.pm, 1u, __ATOMIC_RELAXED, __HIP_MEMORY_SCOPE_AGENT);
        if (wid == 0) { unsigned sp = 0;
            while ((unsigned)__builtin_amdgcn_readfirstlane(__hip_atomic_load(cnt + 64 * u.pm, __ATOMIC_RELAXED, __HIP_MEMORY_SCOPE_AGENT)) < 32u) { __builtin_amdgcn_s_sleep(2); if (++sp > (1u << 22)) break; }
            asm volatile("" ::: "memory"); }
        asm volatile("s_waitcnt vmcnt(0) lgkmcnt(0)" ::: "memory"); __builtin_amdgcn_s_barrier(); asm volatile("" ::: "memory");
        if (lane < 32) {
            const unsigned long long* slot = xbuf + (size_t)(rbase + row) * 4; float mt[4], m2[4]; float ms = 0.f;
#pragma unroll
            for (int t = 0; t < 4; ++t) { const unsigned long long w = __hip_atomic_load(slot + t, __ATOMIC_RELAXED, __HIP_MEMORY_SCOPE_AGENT); mt[t] = __uint_as_float((unsigned)w); m2[t] = __uint_as_float((unsigned)(w >> 32)); ms += mt[t]; }
            const float mean = ms * 0.25f; float q = 0.f;
#pragma unroll
            for (int t = 0; t < 4; ++t) { const float dm = mt[t] - mean; q += m2[t] + 256.0f * dm * dm; }
            S[row] = (f32x2){mean, rsqrtf(q * (1.0f / 1024.0f) + LN_EPS)};
        }
        asm volatile("s_waitcnt lgkmcnt(0)" ::: "memory"); __builtin_amdgcn_s_barrier(); asm volatile("" ::: "memory");
        f32x4 g0[2], g1[2], b0[2], b1[2];
#pragma unroll
        for (int bj = 0; bj < 2; ++bj) { g0[bj] = *(const f32x4*)(gam + col0 + bj * 128); g1[bj] = *(const f32x4*)(gam + col0 + bj * 128 + 4); b0[bj] = *(const f32x4*)(bet + col0 + bj * 128); b1[bj] = *(const f32x4*)(bet + col0 + bj * 128 + 4); }
#pragma unroll
        for (int ai = 0; ai < 2; ++ai)
#pragma unroll
            for (int m = 0; m < 4; ++m) { const int rl = ai * 128 + wr * 64 + m * 16 + fr; const f32x2 st = S[rl];
#pragma unroll
                for (int bj = 0; bj < 2; ++bj) { const f32x4 y0 = (acc[ai][bj][m][0] - st.x) * st.y * g0[bj] + b0[bj], y1 = (acc[ai][bj][m][1] - st.x) * st.y * g1[bj] + b1[bj];
                    if (WHICH == 1) { u32x4 w; w.x = cvt_pk_bf16(y0[0], y0[1]); w.y = cvt_pk_bf16(y0[2], y0[3]); w.z = cvt_pk_bf16(y1[0], y1[1]); w.w = cvt_pk_bf16(y1[2], y1[3]);
                        *(u32x4*)(Hout + (size_t)(rbase + rl) * D + col0 + bj * 128) = w; }
                    else { float* yr = Y + (size_t)(rbase + rl) * D + col0 + bj * 128; __builtin_nontemporal_store(y0, (f32x4*)yr); __builtin_nontemporal_store(y1, (f32x4*)(yr + 4)); } } }
        asm volatile("s_waitcnt lgkmcnt(0)" ::: "memory"); __builtin_amdgcn_s_barrier(); asm volatile("" ::: "memory");
    }
};
struct EpiSwiglu {
    static constexpr bool FUSED = false;
    bf16_t* ACT;
    __device__ __forceinline__ void operator()(const Acc& acc, const Unit& u, int wr, int wc, int fr, int fq) const {
        const int col0 = u.pn * 128 + wc * 32 + 8 * fq;
#pragma unroll
        for (int ai = 0; ai < 2; ++ai)
#pragma unroll
            for (int m = 0; m < 4; ++m) { const int row = u.pm * 256 + ai * 128 + wr * 64 + m * 16 + fr;
                f32x4 a0 = acc[ai][0][m][0], a1 = acc[ai][0][m][1]; const f32x4 b0 = acc[ai][1][m][0], b1 = acc[ai][1][m][1];
#pragma unroll
                for (int j = 0; j < 4; j += 2) { const f32x2 p0 = silu_mul_pk((f32x2){a0[j], a0[j + 1]}, (f32x2){b0[j], b0[j + 1]}), p1 = silu_mul_pk((f32x2){a1[j], a1[j + 1]}, (f32x2){b1[j], b1[j + 1]});
                    a0[j] = p0.x; a0[j + 1] = p0.y; a1[j] = p1.x; a1[j + 1] = p1.y; }
                u32x4 w; w.x = cvt_pk_bf16(a0[0], a0[1]); w.y = cvt_pk_bf16(a0[2], a0[3]); w.z = cvt_pk_bf16(a1[0], a1[1]); w.w = cvt_pk_bf16(a1[2], a1[3]);
                *(u32x4*)(ACT + (size_t)row * D_FF + col0) = w; }
    }
};

struct TileDesc { const float* W; bf16_t* Bt; int K, N, tk, tn, mode; };
__device__ __forceinline__ void tile_load(const TileDesc& d, f32x4& v0, f32x4& v1) {
    const int t = threadIdx.x, r = t >> 4, c4 = (t & 15) * 4;
    v0 = *(const f32x4*)(d.W + (size_t)(d.tk * 64 + r) * d.N + d.tn * 64 + c4); v1 = *(const f32x4*)(d.W + (size_t)(d.tk * 64 + r + 32) * d.N + d.tn * 64 + c4);
}
__device__ __forceinline__ void tile_finish(const TileDesc& d, const f32x4& v0, const f32x4& v1, LAS float* tile) {
    const int t = threadIdx.x;
    { const int r = t >> 4, c4 = (t & 15) * 4;
      tile[r * 65 + c4] = v0[0]; tile[r * 65 + c4 + 1] = v0[1]; tile[r * 65 + c4 + 2] = v0[2]; tile[r * 65 + c4 + 3] = v0[3];
      tile[(r + 32) * 65 + c4] = v1[0]; tile[(r + 32) * 65 + c4 + 1] = v1[1]; tile[(r + 32) * 65 + c4 + 2] = v1[2]; tile[(r + 32) * 65 + c4 + 3] = v1[3]; }
    __syncthreads();
    { const int n = t >> 3, k8 = (t & 7) * 8; float v[8];
#pragma unroll
      for (int j = 0; j < 8; ++j) v[j] = tile[(k8 + j) * 65 + n];
      int ng = d.tn * 64 + n;
      if (d.mode == 1) { const int up = ng >= D_FF; const int n2 = up ? ng - D_FF : ng; ng = 256 * (n2 >> 7) + (n2 & 127) + (up ? 128 : 0); }
      u32x4 w; w.x = cvt_pk_bf16(v[0], v[1]); w.y = cvt_pk_bf16(v[2], v[3]); w.z = cvt_pk_bf16(v[4], v[5]); w.w = cvt_pk_bf16(v[6], v[7]);
      *(u32x4*)(d.Bt + (size_t)ng * d.K + d.tk * 64 + k8) = w; }
    __syncthreads();
}
__device__ __forceinline__ TileDesc tile_desc(const Params& p, int part, int i) {
    if (part == 0) { if (i < 256) return TileDesc{p.w_out, (bf16_t*)(p.ws + WS_W2), D, D, i / 16, i % 16, 0};
                     const int j = i - 256; return TileDesc{p.w_gu, (bf16_t*)(p.ws + WS_W3), D, 2 * D_FF, j / 88, j % 88, 1}; }
    if (part == 1) return TileDesc{p.w_down, (bf16_t*)(p.ws + WS_W4), D_FF, D, i / 16, i % 16, 0};
    return TileDesc{p.w_in, (bf16_t*)(p.ws + WS_W1), D, D_IN, i / 28, i % 28, 0};
}
__device__ void late_transposes(const Params& p, LAS unsigned char* lds, int first, int stride, int part, int end) {
    LAS float* tile = (LAS float*)lds;
    const int n = part == 0 ? 256 + 1408 : (part == 1 ? 704 : 448); if (end > n) end = n;
    if (first >= end) return;
    TileDesc d = tile_desc(p, part, first); f32x4 a0, a1; tile_load(d, a0, a1);
    for (int i = first; ; i += stride) {
        const int nx = i + stride; const bool hn = nx < end;
        TileDesc dn = d; f32x4 b0 = a0, b1 = a1;
        if (hn) { dn = tile_desc(p, part, nx); tile_load(dn, b0, b1); }
        tile_finish(d, a0, a1, tile);
        if (!hn) break;
        d = dn; a0 = b0; a1 = b1;
    }
}
__device__ void prologue(const Params& p, LAS unsigned char* lds) {
    const int G = gridDim.x, bid = blockIdx.x, t = threadIdx.x;
    LAS float* tile = (LAS float*)lds;
    bf16_t* W1 = (bf16_t*)(p.ws + WS_W1);
    late_transposes(p, lds, bid, G, 2, 1 << 30);
    bf16_t* XB = (bf16_t*)(p.ws + WS_XB);
    const size_t n8 = (size_t)M * D / 8, np8 = (size_t)MP * D / 8;
    for (size_t i = (size_t)bid * NTHREADS + t; i < n8; i += (size_t)G * NTHREADS) {
        const float* src = i < np8 ? p.x_prompt + i * 8 : p.x_sample + (i - np8) * 8;
        const f32x4 a = *(const f32x4*)src, b = *(const f32x4*)(src + 4);
        u32x4 w; w.x = cvt_pk_bf16(a[0], a[1]); w.y = cvt_pk_bf16(a[2], a[3]); w.z = cvt_pk_bf16(b[0], b[1]); w.w = cvt_pk_bf16(b[2], b[3]);
        *(u32x4*)(XB + i * 8) = w;
    }
    float* rope = (float*)(p.ws + WS_ROPE);
    for (int i = bid * NTHREADS + t; i < 2048 * 8; i += G * NTHREADS) {
        const int pos = i >> 3, k = i & 7;
        const float inv = (float)exp(-(double)k * 0.125 * 13.122363377404328);
        const double ang = (double)((float)pos * inv);
        rope[pos * 16 + k] = (float)cos(ang); rope[pos * 16 + 8 + k] = (float)sin(ang);
    }
    bf16_t* WSB = (bf16_t*)(p.ws + WS_WS);
    for (int i = bid * NTHREADS + t; i < 8 * 128 * 128 / 2; i += G * NTHREADS) {
        const int e = i * 2, ri = (e >> 7) & 127, cj = e & 127; const bool ok = !(ri < 64 && cj >= 64);
        const f32x2 v = *(const f32x2*)(p.w_sp + e);
        *(unsigned*)(WSB + e) = ok ? cvt_pk_bf16(v[0], v[1]) : 0u;
    }
}

constexpr int KS_STRIDE = 72, VT_STRIDE = 200;
constexpr int LDS_KS = 0, LDS_VT = LDS_KS + 2 * 192 * KS_STRIDE * 2, LDS_ASSQ = LDS_VT + 2 * 64 * VT_STRIDE * 2;
__device__ void attn_unit(const Params& p, LAS unsigned char* lds, int unit) {
    int t_ = threadIdx.x; asm volatile("" : "+v"(t_));
    const int t = t_, wid = t >> 6, lane = t & 63, fr = lane & 15, fq = lane >> 4;
    const bool samp = unit >= 256; const int b = samp ? unit - 256 : unit >> 5, c = samp ? 2 : (unit & 31);
    const int r0 = samp ? MP + b * 64 : b * SEQ + c * 64;
    const int kstart = samp ? 0 : (c >= 2 ? 0 : (2 - c) * 64);
    const bf16_t* H = (const bf16_t*)(p.ws + WS_H);
    LAS bf16_t* Ks = (LAS bf16_t*)(lds + LDS_KS); LAS bf16_t* Vt = (LAS bf16_t*)(lds + LDS_VT); LAS float* ssq = (LAS float*)(lds + LDS_ASSQ);
    const int h = wid;
    bf16x8 qf[4][2];
#pragma unroll
    for (int qt = 0; qt < 4; ++qt)
#pragma unroll
        for (int ks = 0; ks < 2; ++ks) qf[qt][ks] = *(const bf16x8*)(H + (size_t)(r0 + qt * 16 + fr) * D_IN + C_Q + h * 64 + ks * 32 + fq * 8);
#pragma unroll
    for (int qi = 0; qi < 6; ++qi) { const int q = t + qi * NTHREADS;
        const int key = q >> 4, cc = q & 15, kvh = cc >> 3, d0 = (cc & 7) * 8;
        u32x4 kw = {0u, 0u, 0u, 0u}, vw = {0u, 0u, 0u, 0u};
        if (key >= kstart) {
            if (samp && key < 128) {
                const float* ck = p.cache_k + ((size_t)(b * 128 + key) * 2 + kvh) * 64 + d0; const float* cv = p.cache_v + ((size_t)(b * 128 + key) * 2 + kvh) * 64 + d0;
                const f32x4 a0 = *(const f32x4*)ck, a1 = *(const f32x4*)(ck + 4), b0 = *(const f32x4*)cv, b1 = *(const f32x4*)(cv + 4);
                kw.x = cvt_pk_bf16(a0[0], a0[1]); kw.y = cvt_pk_bf16(a0[2], a0[3]); kw.z = cvt_pk_bf16(a1[0], a1[1]); kw.w = cvt_pk_bf16(a1[2], a1[3]);
                vw.x = cvt_pk_bf16(b0[0], b0[1]); vw.y = cvt_pk_bf16(b0[2], b0[3]); vw.z = cvt_pk_bf16(b1[0], b1[1]); vw.w = cvt_pk_bf16(b1[2], b1[3]);
            } else {
                const bf16_t* hr = H + (size_t)(r0 - 128 + key) * D_IN;
                kw = *(const u32x4*)(hr + C_K + kvh * 64 + d0); vw = *(const u32x4*)(hr + C_V + kvh * 64 + d0);
            }
        }
        *(LAS u32x4*)(Ks + (kvh * 192 + key) * KS_STRIDE + d0) = kw;
        LAS bf16_t* vt = Vt + (kvh * 64 + d0) * VT_STRIDE + ((((key >> 3) ^ (cc & 7)) << 3) | (key & 7));
        vt[0 * VT_STRIDE] = (bf16_t)(vw.x & 0xffff); vt[1 * VT_STRIDE] = (bf16_t)(vw.x >> 16); vt[2 * VT_STRIDE] = (bf16_t)(vw.y & 0xffff); vt[3 * VT_STRIDE] = (bf16_t)(vw.y >> 16);
        vt[4 * VT_STRIDE] = (bf16_t)(vw.z & 0xffff); vt[5 * VT_STRIDE] = (bf16_t)(vw.z >> 16); vt[6 * VT_STRIDE] = (bf16_t)(vw.w & 0xffff); vt[7 * VT_STRIDE] = (bf16_t)(vw.w >> 16);
    }
    __syncthreads();
    const int kvh = h >> 2;
    const float sink = p.sinks[h] * 1.4426950408889634f;
    f32x4 o[4][4];
#pragma unroll
    for (int qp = 0; qp < 2; ++qp) {
        f32x4 s[2][12];
#pragma unroll
        for (int kt = 0; kt < 12; ++kt) {
            s[0][kt] = (f32x4){0.f, 0.f, 0.f, 0.f}; s[1][kt] = (f32x4){0.f, 0.f, 0.f, 0.f};
#pragma unroll
            for (int ks = 0; ks < 2; ++ks) { const bf16x8 kf = *(const LAS bf16x8*)(Ks + (kvh * 192 + kt * 16 + fr) * KS_STRIDE + ks * 32 + fq * 8);
                s[0][kt] = __builtin_amdgcn_mfma_f32_16x16x32_bf16(kf, qf[2 * qp][ks], s[0][kt], 0, 0, 0);
                s[1][kt] = __builtin_amdgcn_mfma_f32_16x16x32_bf16(kf, qf[2 * qp + 1][ks], s[1][kt], 0, 0, 0); }
        }
        if (kstart > 0) {
#pragma unroll
            for (int kt = 0; kt < 12; ++kt) if (kt * 16 < kstart) { s[0][kt] = (f32x4){-1e30f, -1e30f, -1e30f, -1e30f}; s[1][kt] = s[0][kt]; } }
        float inv[2];
#pragma unroll
        for (int e = 0; e < 2; ++e) {
            float mx = sink;
#pragma unroll
            for (int kt = 0; kt < 12; ++kt) mx = fmaxf(mx, fmaxf(fmaxf(s[e][kt][0], s[e][kt][1]), fmaxf(s[e][kt][2], s[e][kt][3])));
            mx = fmaxf(mx, __shfl_xor(mx, 16)); mx = fmaxf(mx, __shfl_xor(mx, 32));
            float sum = 0.f;
#pragma unroll
            for (int kt = 0; kt < 12; ++kt) {
#pragma unroll
                for (int j = 0; j < 4; ++j) { const float ex = __builtin_amdgcn_exp2f(s[e][kt][j] - mx); s[e][kt][j] = ex; sum += ex; } }
            sum += __shfl_xor(sum, 16); sum += __shfl_xor(sum, 32);
            inv[e] = 1.0f / (sum + __builtin_amdgcn_exp2f(sink - mx));
#pragma unroll
            for (int dt = 0; dt < 4; ++dt) o[2 * qp + e][dt] = (f32x4){0.f, 0.f, 0.f, 0.f};
        }
#pragma unroll
        for (int kp = 0; kp < 6; ++kp) {
            bf16x8 pf[2];
#pragma unroll
            for (int e = 0; e < 2; ++e) { u32x4 pw; pw.x = cvt_pk_bf16(s[e][2 * kp][0], s[e][2 * kp][1]); pw.y = cvt_pk_bf16(s[e][2 * kp][2], s[e][2 * kp][3]);
                pw.z = cvt_pk_bf16(s[e][2 * kp + 1][0], s[e][2 * kp + 1][1]); pw.w = cvt_pk_bf16(s[e][2 * kp + 1][2], s[e][2 * kp + 1][3]); pf[e] = __builtin_bit_cast(bf16x8, pw); }
#pragma unroll
            for (int dt = 0; dt < 4; ++dt) {
                const LAS bf16_t* vrow = Vt + (kvh * 64 + dt * 16 + fr) * VT_STRIDE; const int sw = (dt * 2 + (fr >> 3)) & 7;
                const int k0 = kp * 32 + fq * 4, k1 = k0 + 16;
                const u32x2 va = *(const LAS u32x2*)(vrow + ((((k0 >> 3) ^ sw) << 3) | (k0 & 7))), vb = *(const LAS u32x2*)(vrow + ((((k1 >> 3) ^ sw) << 3) | (k1 & 7)));
                const u32x4 vv = {va.x, va.y, vb.x, vb.y};
                o[2 * qp][dt] = __builtin_amdgcn_mfma_f32_16x16x32_bf16(__builtin_bit_cast(bf16x8, vv), pf[0], o[2 * qp][dt], 0, 0, 0);
                o[2 * qp + 1][dt] = __builtin_amdgcn_mfma_f32_16x16x32_bf16(__builtin_bit_cast(bf16x8, vv), pf[1], o[2 * qp + 1][dt], 0, 0, 0);
            }
        }
#pragma unroll
        for (int e = 0; e < 2; ++e) { const int qt = 2 * qp + e;
            float q2 = 0.f;
#pragma unroll
            for (int dt = 0; dt < 4; ++dt) { o[qt][dt] = o[qt][dt] * inv[e];
#pragma unroll
                for (int j = 0; j < 4; ++j) q2 += o[qt][dt][j] * o[qt][dt][j]; }
            q2 += __shfl_xor(q2, 16); q2 += __shfl_xor(q2, 32);
            if (fq == 0) ssq[h * 64 + qt * 16 + fr] = q2; }
    }
    __syncthreads();
    bf16_t* CAT = (bf16_t*)(p.ws + WS_CAT);
#pragma unroll
    for (int qt = 0; qt < 4; ++qt) {
        float tot = 0.f;
#pragma unroll
        for (int hh = 0; hh < 8; ++hh) tot += ssq[hh * 64 + qt * 16 + fr];
        const float rs = rsqrtf(tot * (1.0f / 512.0f) + LN_EPS);
#pragma unroll
        for (int dt = 0; dt < 4; ++dt) { const int col = h * 64 + dt * 16 + fq * 4; const f32x4 g = *(const f32x4*)(p.g_attn + col); const f32x4 v = o[qt][dt] * rs * g;
            u32x2 w; w.x = cvt_pk_bf16(v[0], v[1]); w.y = cvt_pk_bf16(v[2], v[3]);
            *(u32x2*)(CAT + (size_t)(r0 + qt * 16 + fr) * D + col) = w; }
    }
    __syncthreads();
}

constexpr int VM_STRIDE = 136;
constexpr int LDS_VMT = 0, LDS_GST = LDS_VMT + 8 * 64 * VM_STRIDE * 2, LDS_GSSQ = LDS_GST + 128 * 2 * 4;
__device__ void gate_unit(const Params& p, LAS unsigned char* lds, int unit) {
    int t_ = threadIdx.x; asm volatile("" : "+v"(t_));
    const int t = t_, wid = t >> 6, lane = t & 63, fr = lane & 15, fq = lane >> 4;
    const bool samp = unit >= 256; const int w_ = unit & 127; const int b = samp ? unit - 256 : w_ >> 4, c = samp ? 0 : 2 * (w_ & 15) + (unit < 128 ? 1 : 0), par = c & 1;
    const int r0 = samp ? MP + b * 64 : b * SEQ + c * 64;
    const int Kc = par ? 128 : 64, jr0 = par ? r0 - 64 : r0;
    const bf16_t* H = (const bf16_t*)(p.ws + WS_H);
    LAS bf16_t* VmT = (LAS bf16_t*)(lds + LDS_VMT); LAS float* st = (LAS float*)(lds + LDS_GST); LAS float* ssq = (LAS float*)(lds + LDS_GSSQ);
    const int g = wid, jl = lane >> 3, c8 = (lane & 7) * 8, col = g * 64 + c8;
    LAS f32x2* part = (LAS f32x2*)(lds + LDS_VMT);
    u32x4 raw[16];
#pragma unroll
    for (int it = 0; it < 16; ++it) if (it * 8 < Kc) raw[it] = *(const u32x4*)(H + (size_t)(jr0 + it * 8 + jl) * D_IN + C_VM + col);
#pragma unroll
    for (int it = 0; it < 16; ++it) if (it * 8 < Kc) {
        const u32x4 w = raw[it];
        const float v0 = bflo(w.x), v1 = bfhi(w.x), v2 = bflo(w.y), v3 = bfhi(w.y), v4 = bflo(w.z), v5 = bfhi(w.z), v6 = bflo(w.w), v7 = bfhi(w.w);
        float sm = ((v0 + v1) + (v2 + v3)) + ((v4 + v5) + (v6 + v7));
        float sq = ((v0 * v0 + v1 * v1) + (v2 * v2 + v3 * v3)) + ((v4 * v4 + v5 * v5) + (v6 * v6 + v7 * v7));
        sm += __shfl_xor(sm, 1); sq += __shfl_xor(sq, 1); sm += __shfl_xor(sm, 2); sq += __shfl_xor(sq, 2); sm += __shfl_xor(sm, 4); sq += __shfl_xor(sq, 4);
        if ((lane & 7) == 0) part[(it * 8 + jl) * 8 + g] = (f32x2){sm, sq};
    }
    __syncthreads();
    if (t < Kc) { float sm = 0.f, sq = 0.f;
#pragma unroll
        for (int gg = 0; gg < 8; ++gg) { const f32x2 pv = part[t * 8 + gg]; sm += pv.x; sq += pv.y; }
        const float mean = sm * (1.0f / 512.0f), var = fmaxf(sq * (1.0f / 512.0f) - mean * mean, 0.f);
        st[t * 2] = mean; st[t * 2 + 1] = rsqrtf(var + LN_EPS); }
    __syncthreads();
    { const f32x4 ga0 = *(const f32x4*)(p.ln_v_g + col), ga1 = *(const f32x4*)(p.ln_v_g + col + 4), be0 = *(const f32x4*)(p.ln_v_b + col), be1 = *(const f32x4*)(p.ln_v_b + col + 4);
#pragma unroll
      for (int it = 0; it < 16; ++it) if (it * 8 < Kc) { const int j = it * 8 + jl;
          const u32x4 w = raw[it];
          const float mean = st[j * 2], rstd = st[j * 2 + 1];
          f32x4 v0 = {bflo(w.x), bfhi(w.x), bflo(w.y), bfhi(w.y)}, v1 = {bflo(w.z), bfhi(w.z), bflo(w.w), bfhi(w.w)};
          v0 = (v0 - mean) * rstd * ga0 + be0; v1 = (v1 - mean) * rstd * ga1 + be1;
          if (samp) { float* o = p.out + O_MS + (size_t)(b * 64 + j) * 512 + col; *(f32x4*)o = v0; *(f32x4*)(o + 4) = v1; }
          const unsigned w0 = cvt_pk_bf16(v0[0], v0[1]), w1 = cvt_pk_bf16(v0[2], v0[3]), w2 = cvt_pk_bf16(v1[0], v1[1]), w3 = cvt_pk_bf16(v1[2], v1[3]);
          LAS bf16_t* d = VmT + (g * 64 + c8) * VM_STRIDE + ((it ^ (lane & 7)) * 8 + jl);
          d[0 * VM_STRIDE] = (bf16_t)(w0 & 0xffff); d[1 * VM_STRIDE] = (bf16_t)(w0 >> 16); d[2 * VM_STRIDE] = (bf16_t)(w1 & 0xffff); d[3 * VM_STRIDE] = (bf16_t)(w1 >> 16);
          d[4 * VM_STRIDE] = (bf16_t)(w2 & 0xffff); d[5 * VM_STRIDE] = (bf16_t)(w2 >> 16); d[6 * VM_STRIDE] = (bf16_t)(w3 & 0xffff); d[7 * VM_STRIDE] = (bf16_t)(w3 >> 16); } }
    __syncthreads();
    const bf16_t* WSB = (const bf16_t*)(p.ws + WS_WS) + (size_t)g * 128 * 128 + (size_t)(par * 64) * 128;
    f32x4 acc[4][4];
#pragma unroll
    for (int it = 0; it < 4; ++it)
#pragma unroll
        for (int dt = 0; dt < 4; ++dt) acc[it][dt] = (f32x4){0.f, 0.f, 0.f, 0.f};
    bf16x8 wf[4][4];
#pragma unroll
    for (int ks = 0; ks < 4; ++ks) if (ks * 32 < Kc) {
#pragma unroll
        for (int it = 0; it < 4; ++it) wf[ks][it] = *(const bf16x8*)(WSB + (size_t)(it * 16 + fr) * 128 + ks * 32 + fq * 8); }
#pragma unroll
    for (int ks = 0; ks < 4; ++ks) if (ks * 32 < Kc) {
        bf16x8 vf[4];
#pragma unroll
        for (int dt = 0; dt < 4; ++dt) vf[dt] = *(const LAS bf16x8*)(VmT + (g * 64 + dt * 16 + fr) * VM_STRIDE + (((ks * 4 + fq) ^ ((dt * 2 + (fr >> 3)) & 7)) * 8));
#pragma unroll
        for (int it = 0; it < 4; ++it)
#pragma unroll
            for (int dt = 0; dt < 4; ++dt) acc[it][dt] = __builtin_amdgcn_mfma_f32_16x16x32_bf16(vf[dt], wf[ks][it], acc[it][dt], 0, 0, 0);
    }
    u32x2 uw[4][4];
#pragma unroll
    for (int it = 0; it < 4; ++it)
#pragma unroll
        for (int dt = 0; dt < 4; ++dt) uw[it][dt] = *(const u32x2*)(H + (size_t)(r0 + it * 16 + fr) * D_IN + C_U + g * 64 + dt * 16 + fq * 4);
#pragma unroll
    for (int it = 0; it < 4; ++it) {
        const float bs = p.b_sp[g * 128 + par * 64 + it * 16 + fr]; float q2 = 0.f;
#pragma unroll
        for (int dt = 0; dt < 4; ++dt) { const f32x4 uv = {bflo(uw[it][dt].x), bfhi(uw[it][dt].x), bflo(uw[it][dt].y), bfhi(uw[it][dt].y)};
            acc[it][dt] = (acc[it][dt] + bs) * uv;
#pragma unroll
            for (int j = 0; j < 4; ++j) q2 += acc[it][dt][j] * acc[it][dt][j]; }
        q2 += __shfl_xor(q2, 16); q2 += __shfl_xor(q2, 32);
        if (fq == 0) ssq[g * 64 + it * 16 + fr] = q2;
    }
    __syncthreads();
    bf16_t* CAT = (bf16_t*)(p.ws + WS_CAT);
#pragma unroll
    for (int it = 0; it < 4; ++it) {
        float tot = 0.f;
#pragma unroll
        for (int gg = 0; gg < 8; ++gg) tot += ssq[gg * 64 + it * 16 + fr];
        const float rs = rsqrtf(tot * (1.0f / 512.0f) + LN_EPS);
#pragma unroll
        for (int dt = 0; dt < 4; ++dt) { const int col = g * 64 + dt * 16 + fq * 4; const f32x4 gm = *(const f32x4*)(p.g_cmlp + col); const f32x4 v = acc[it][dt] * rs * gm;
            u32x2 w; w.x = cvt_pk_bf16(v[0], v[1]); w.y = cvt_pk_bf16(v[2], v[3]);
            *(u32x2*)(CAT + (size_t)(r0 + it * 16 + fr) * D + 512 + col) = w; }
    }
    __syncthreads();
}

template <bool TO_BF16>
__device__ void ln_rows(const float* Z, const float* gam, const float* bet, bf16_t* Hb, float* Y) {
    const int lane = threadIdx.x & 63, gw = blockIdx.x * 8 + (threadIdx.x >> 6), nw = gridDim.x * 8;
    f32x4 g[4], be[4];
#pragma unroll
    for (int i = 0; i < 4; ++i) { g[i] = *(const f32x4*)(gam + i * 256 + lane * 4); be[i] = *(const f32x4*)(bet + i * 256 + lane * 4); }
    for (int row = gw; row < M; row += nw) {
        const float* z = Z + (size_t)row * D; f32x4 v[4]; float s = 0.f;
#pragma unroll
        for (int i = 0; i < 4; ++i) { v[i] = *(const f32x4*)(z + i * 256 + lane * 4); s += (v[i][0] + v[i][1]) + (v[i][2] + v[i][3]); }
#pragma unroll
        for (int o = 1; o < 64; o <<= 1) s += __shfl_xor(s, o);
        const float mean = s * (1.0f / 1024.0f); float q = 0.f;
#pragma unroll
        for (int i = 0; i < 4; ++i) { v[i] = v[i] - mean; q += (v[i][0] * v[i][0] + v[i][1] * v[i][1]) + (v[i][2] * v[i][2] + v[i][3] * v[i][3]); }
#pragma unroll
        for (int o = 1; o < 64; o <<= 1) q += __shfl_xor(q, o);
        const float rstd = rsqrtf(q * (1.0f / 1024.0f) + LN_EPS);
#pragma unroll
        for (int i = 0; i < 4; ++i) { const f32x4 y = v[i] * rstd * g[i] + be[i];
            if (TO_BF16) { u32x2 w; w.x = cvt_pk_bf16(y[0], y[1]); w.y = cvt_pk_bf16(y[2], y[3]); *(u32x2*)(Hb + (size_t)row * D + i * 256 + lane * 4) = w; }
            else *(f32x4*)(Y + (size_t)row * D + i * 256 + lane * 4) = y; }
    }
}

__global__ void __launch_bounds__(NTHREADS, 2) fwd_mega(Params p) {
    extern __shared__ __attribute__((aligned(16))) unsigned char smem[];
    LAS unsigned char* lds = (LAS unsigned char*)smem;
    const int G = gridDim.x, bid = blockIdx.x;
    volatile LAS unsigned* xst = (volatile LAS unsigned*)(lds + LDS_BYTES - 16);
    if (threadIdx.x == 0) { xst[0] = 0u; xst[1] = 0u; }
    __syncthreads();
    XcdBarrier xb = xcd_barrier_post((unsigned*)(p.ws + WS_BAR) + (NBAR > 1 ? p.pad * 4096 : 0), xst);
#define IN(ph) (p.ph_lo <= (ph) && (ph) < p.ph_hi)
#define REP(ph) for (int _r = 0; _r < ((ph) == PROBE_PH ? 3 : 1); ++_r)
#define SYNC(ph) do { if (p.coop && IN(ph) && IN((ph) + 1)) xcd_barrier(xb); } while (0)
    if (IN(0)) REP(0) prologue(p, lds);
    SYNC(0);
    if (IN(1)) { pg8::Gemm g{(const bf16_t*)(p.ws + WS_XB), (const bf16_t*)(p.ws + WS_W1), M, D_IN, D}; pg8::StaticOrder S; S.init(M, D_IN, D, G, bid);
        EpiProj E{(bf16_t*)(p.ws + WS_H), (const float*)(p.ws + WS_ROPE), p.out}; pg8::gemm_phase(lds, g, S, E); }
    SYNC(1);
    if (IN(2)) {
        if (G == 256) {
            for (int k = 0; k < 3; ++k) {
                int u = -1;
                if (k == 0) u = bid;
                else if (k == 1) u = bid < 32 ? 256 + bid : (bid < 160 ? 288 + (bid - 32) : 288 + 128 + (bid - 160));
                else if (bid >= 160 && bid < 224) u = 288 + 224 + (bid - 160);
                if (u < 0) break;
                if (u < 288) attn_unit(p, lds, u); else gate_unit(p, lds, u - 288);
            }
            int t0 = 0, tn = 0;
            if (bid < 32) { t0 = bid * 9; tn = 9; } else if (bid < 160) { t0 = 288 + (bid - 32) * 8; tn = 8; } else if (bid >= 224) { t0 = 1312 + (bid - 224) * 11; tn = 11; }
            if (tn) late_transposes(p, lds, t0, 1, 0, t0 + tn);
        } }
    SYNC(2);
    if (IN(3)) { for (int rep = 0; rep < (PROBE_PH == 3 ? 3 : 1); ++rep) { if (rep) xcd_barrier(xb);
        pg8::Gemm g{(const bf16_t*)(p.ws + WS_CAT), (const bf16_t*)(p.ws + WS_W2), M, D, D}; pg8::TeamOrder S; S.init(D, bid, P3_STREAMK);
        EpiLn<1> E{(PROBE_PH == 10 ? p.pad * 2 : 0) + rep}; pg8::gemm_phase(lds, g, S, E); } }
    SYNC(3);
    if (IN(4)) REP(5) { pg8::Gemm g{(const bf16_t*)(p.ws + WS_HB), (const bf16_t*)(p.ws + WS_W3), M, 2 * D_FF, D}; pg8::StaticOrder S; S.init(M, 2 * D_FF, D, G, bid);
        EpiSwiglu E{(bf16_t*)(p.ws + WS_ACT)}; pg8::gemm_phase(lds, g, S, E);
        if (G == 256 && bid >= 48) late_transposes(p, lds, bid - 48, 208, 1, 1 << 30); }
    SYNC(4);
    if (IN(5)) { for (int rep = 0; rep < (PROBE_PH == 6 ? 3 : 1); ++rep) { if (rep) xcd_barrier(xb);
        pg8::Gemm g{(const bf16_t*)(p.ws + WS_ACT), (const bf16_t*)(p.ws + WS_W4), M, D, D_FF}; pg8::TeamOrder S; S.init(D_FF, bid, 1);
        EpiLn<2> E{(PROBE_PH == 10 ? p.pad * 2 + 1 : (PROBE_PH == 3 || PROBE_PH == 6) ? 3 : 1) + rep}; pg8::gemm_phase(lds, g, S, E); } }
#undef IN
#undef SYNC
}

#undef REP
#ifndef N_LAUNCHES
#define N_LAUNCHES 1
#endif
extern "C" void kernel_launch(void* const* d_in, const int* in_sizes, int n_in, void* d_out, int out_size, void* d_ws, size_t ws_size, hipStream_t stream) {
    static int grid = 0;
    if (grid == 0) {
        int dev = 0, cus = 0, per_cu = 0;
        hipGetDevice(&dev); hipDeviceGetAttribute(&cus, hipDeviceAttributeMultiprocessorCount, dev);
        if (hipFuncSetAttribute((const void*)fwd_mega, hipFuncAttributeMaxDynamicSharedMemorySize, LDS_BYTES) != hipSuccess) { fprintf(stderr, "hipFuncSetAttribute failed\n"); grid = -1; return; }
        if (hipOccupancyMaxActiveBlocksPerMultiprocessor(&per_cu, (const void*)fwd_mega, NTHREADS, LDS_BYTES) != hipSuccess || per_cu < 1) { fprintf(stderr, "occupancy query: %d\n", per_cu); per_cu = 1; }
        (void)hipGetLastError();
        grid = cus * (per_cu > 1 ? 1 : per_cu);
        if (grid != 256) { fprintf(stderr, "this kernel needs a grid of exactly 256 workgroups (one per CU), got %d\n", grid); grid = -1; return; }
        if (ws_size < WS_END) { fprintf(stderr, "workspace too small: %zu < %zu\n", ws_size, WS_END); grid = -1; return; }
    }
    if (grid < 0) return;
    if (hipMemsetAsync((char*)d_ws + WS_BAR, 0, WS_ZERO_BYTES, stream) != hipSuccess) { fprintf(stderr, "memset failed\n"); return; }
    Params p{};
    p.x_prompt = (const float*)d_in[0]; p.x_sample = (const float*)d_in[1]; p.cache_k = (const float*)d_in[2]; p.cache_v = (const float*)d_in[3]; p.w_in = (const float*)d_in[4];
    p.ln_v_g = (const float*)d_in[5]; p.ln_v_b = (const float*)d_in[6]; p.sinks = (const float*)d_in[7]; p.w_sp = (const float*)d_in[8]; p.b_sp = (const float*)d_in[9];
    p.g_attn = (const float*)d_in[10]; p.g_cmlp = (const float*)d_in[11]; p.w_out = (const float*)d_in[12]; p.ln1_g = (const float*)d_in[13]; p.ln1_b = (const float*)d_in[14];
    p.w_gu = (const float*)d_in[15]; p.w_down = (const float*)d_in[16]; p.ln2_g = (const float*)d_in[17]; p.ln2_b = (const float*)d_in[18];
    p.out = (float*)d_out; p.ws = (unsigned char*)d_ws;
#if N_LAUNCHES == 1
    p.ph_lo = 0; p.ph_hi = 6; p.coop = 1;
    void* args[] = {&p};
    hipError_t e = hipLaunchCooperativeKernel((const void*)fwd_mega, dim3(grid), dim3(NTHREADS), args, LDS_BYTES, stream);
#if PROBE_PH == 10
    p.pad = 1; e = hipLaunchCooperativeKernel((const void*)fwd_mega, dim3(grid), dim3(NTHREADS), args, LDS_BYTES, stream);
#endif
    if (e != hipSuccess) fprintf(stderr, "cooperative launch failed: %s (grid %d)\n", hipGetErrorString(e), grid);
#else
    for (int ph = 0; ph < 6; ++ph) { p.ph_lo = ph; p.ph_hi = ph + 1; p.coop = 0;
        hipLaunchKernelGGL(fwd_mega, dim3(grid), dim3(NTHREADS), LDS_BYTES, stream, p); }
#endif
}
```

```cpp
#include <hip/hip_runtime.h>
#include <hip/hip_cooperative_groups.h>
#include <cstdio>
#include <cstdint>
namespace cg = cooperative_groups;

#define LAS __attribute__((address_space(3)))
typedef unsigned short bf16_t;
typedef short bf16x8 __attribute__((ext_vector_type(8)));
typedef short bf16x4 __attribute__((ext_vector_type(4)));
typedef float f32x4 __attribute__((ext_vector_type(4)));
typedef float f32x2 __attribute__((ext_vector_type(2)));
typedef unsigned u32x4 __attribute__((ext_vector_type(4)));
typedef unsigned u32x2 __attribute__((ext_vector_type(2)));

#ifndef GEMM_SP2
#define GEMM_SP2 1
#endif
#ifndef GEMM_ALIGN_EPI
#define GEMM_ALIGN_EPI 1
#endif
#ifndef P3_STREAMK
#define P3_STREAMK 1
#endif
#ifndef PROBE_PH
#define PROBE_PH -1
#endif
constexpr int D = 1024, SEQ = 2048, NB = 8, DEC_B = 32, DEC_L = 64, PAST = 1024;
constexpr int MP = NB * SEQ, MS = DEC_B * DEC_L, M = MP + MS;
constexpr int D_IN = 1792, D_FF = 2816;
constexpr int C_Q = 0, C_K = 512, C_V = 640, C_U = 768, C_VM = 1280;
constexpr float ALPHA = 1.189207115002721f;
constexpr float LN_EPS = 1e-5f;
constexpr size_t O_Y = 0, O_KP = (size_t)M * D, O_VP = O_KP + 131072, O_KS = O_VP + 131072, O_VS = O_KS + 262144, O_MS = O_VS + 262144;
constexpr size_t WS_XB = 0;
constexpr size_t WS_H = WS_XB + (size_t)M * D * 2;
constexpr size_t WS_ACT = 0;
constexpr size_t WS_W1 = (size_t)M * D_FF * 2;
constexpr size_t WS_W2 = WS_W1 + (size_t)D_IN * D * 2;
constexpr size_t WS_W3 = WS_W2 + (size_t)D * D * 2;
constexpr size_t WS_W4 = WS_W3 + (size_t)2 * D_FF * D * 2;
constexpr size_t WS_WS = WS_W4 + (size_t)D * D_FF * 2;
constexpr size_t WS_ROPE = WS_WS + (size_t)8 * 128 * 128 * 2;
constexpr size_t WS_CAT = WS_ROPE + (size_t)2048 * 16 * 4;
constexpr size_t WS_HB = WS_CAT + (size_t)M * D * 2;
constexpr size_t WS_BAR = WS_HB + (size_t)M * D * 2;
constexpr int NSETS = (PROBE_PH == 3 || PROBE_PH == 6 || PROBE_PH == 10) ? 6 : 2, NBAR = PROBE_PH == 10 ? 2 : 1;
constexpr size_t WS_CNT = WS_BAR + (size_t)NBAR * 16384;
constexpr size_t WS_FLG = WS_CNT + (size_t)NSETS * 72 * 256;
constexpr size_t WS_ZERO_BYTES = (size_t)NBAR * 16384 + (size_t)NSETS * 72 * 256 + (size_t)NSETS * 224 * 256;
constexpr size_t WS_XB1 = WS_FLG + (size_t)NSETS * 224 * 256;
constexpr size_t WS_XB2 = WS_XB1 + (size_t)M * 4 * 8;
constexpr size_t WS_SLAB = WS_XB2 + (size_t)M * 4 * 8;
constexpr size_t WS_END = WS_SLAB + (size_t)224 * 131072;
constexpr int LDS_BYTES = 147456;
constexpr int NTHREADS = 512;

struct Params {
    const float *x_prompt, *x_sample, *cache_k, *cache_v, *w_in, *ln_v_g, *ln_v_b, *sinks, *w_sp, *b_sp, *g_attn, *g_cmlp, *w_out, *ln1_g, *ln1_b, *w_gu, *w_down, *ln2_g, *ln2_b;
    float* out;
    unsigned char* ws;
    int ph_lo, ph_hi, coop, pad;
};

__device__ __forceinline__ unsigned cvt_pk_bf16(float lo, float hi) { unsigned r; asm volatile("v_cvt_pk_bf16_f32 %0, %1, %2" : "=v"(r) : "v"(lo), "v"(hi)); return r; }
__device__ __forceinline__ float bf2f(unsigned short b) { return __uint_as_float(((unsigned)b) << 16); }
__device__ __forceinline__ float bflo(unsigned w) { return __uint_as_float(w << 16); }
__device__ __forceinline__ float bfhi(unsigned w) { return __uint_as_float(w & 0xffff0000u); }
__device__ __forceinline__ float fast_sigmoid(float x) { return __builtin_amdgcn_rcpf(1.0f + __builtin_amdgcn_exp2f(-1.4426950408889634f * x)); }
__device__ __forceinline__ float gelu_tanh(float x) { const float u = 1.5957691216057308f * (x + 0.044715f * x * x * x); return x * fast_sigmoid(u); }
__device__ __forceinline__ float silu(float x) { return x * fast_sigmoid(x); }
__device__ __forceinline__ f32x2 silu_mul_pk(f32x2 g, f32x2 u) {
    const f32x2 m = g * (-1.4426950408889634f);
    f32x2 e; e.x = __builtin_amdgcn_exp2f(m.x); e.y = __builtin_amdgcn_exp2f(m.y);
    const f32x2 d = e + 1.0f;
    f32x2 r; r.x = __builtin_amdgcn_rcpf(d.x); r.y = __builtin_amdgcn_rcpf(d.y);
    return (g * r) * u;
}
__device__ __forceinline__ f32x2 gelu_tanh_pk(f32x2 x) {
    const f32x2 f = (x * x) * (-0.10294324f) + (-2.3022082f);
    const f32x2 w = x * f;
    f32x2 e; e.x = __builtin_amdgcn_exp2f(w.x); e.y = __builtin_amdgcn_exp2f(w.y);
    const f32x2 d = e + 1.0f;
    f32x2 r; r.x = __builtin_amdgcn_rcpf(d.x); r.y = __builtin_amdgcn_rcpf(d.y);
    return x * r;
}


#define XB_TMO      128
#define XB_XCNT(j)  (256  + 64 * (j))
#define XB_XSUB(j)  (1280 + 64 * (j))
#define XB_XGEN(j)  (2304 + 64 * (j))
#define XB_TOP      3328
#define XB_TOPGEN   3392
#define XCD_BAR_WORDS 3456
#define XB_SPIN_CAP (1u << 18)
__device__ __forceinline__ unsigned xb_ld(unsigned* p)              { return __hip_atomic_load(p, __ATOMIC_RELAXED, __HIP_MEMORY_SCOPE_AGENT); }
__device__ __forceinline__ unsigned xb_add(unsigned* p, unsigned v) { return __hip_atomic_fetch_add(p, v, __ATOMIC_RELAXED, __HIP_MEMORY_SCOPE_AGENT); }
__device__ __forceinline__ unsigned xb_xcc_id() { return (unsigned)__builtin_amdgcn_s_getreg((3 << 11) | 20) & 0xFu; }
#define XB_SPIN(cond, bar) do { unsigned _sp = 0; while (cond) { __builtin_amdgcn_s_sleep(1); \
    if ((++_sp & 255u) == 0u) { if (xb_ld(&(bar)[XB_TMO])) break; if (_sp > XB_SPIN_CAP) { atomicAdd(&(bar)[XB_TMO], 1u); break; } } } } while (0)
struct XcdBarrier { unsigned* bar; unsigned x; volatile LAS unsigned* st; };
__device__ __forceinline__ XcdBarrier xcd_barrier_post(unsigned* bar, volatile LAS unsigned* st) {
    XcdBarrier b; b.bar = bar; b.x = xb_xcc_id(); b.st = st;
    if (threadIdx.x == 0) (void)xb_add(&bar[XB_XCNT(b.x)], 1u);
    return b;
}
__device__ __forceinline__ void xcd_barrier_complete(unsigned* bar, unsigned x, unsigned& nloc, unsigned& nx) {
    const unsigned G = gridDim.x * gridDim.y * gridDim.z;
    unsigned sum, cnt, mine, sp = 0u;
    for (;;) {
        sum = 0u; cnt = 0u; mine = 0u;
#pragma unroll
        for (unsigned j = 0; j < 16; ++j) { const unsigned c = xb_ld(&bar[XB_XCNT(j)]); sum += c; cnt += (c > 0u) ? 1u : 0u; mine = (j == x) ? c : mine; }
        if (sum == G) break;
        __builtin_amdgcn_s_sleep(1);
        if ((++sp & 255u) == 0u) { if (xb_ld(&bar[XB_TMO])) break; if (sp > XB_SPIN_CAP) { atomicAdd(&bar[XB_TMO], 1u); break; } }
    }
    nloc = mine > 0u ? mine : 1u; nx = cnt > 0u ? cnt : 1u;
}
__device__ __forceinline__ void xcd_barrier(const XcdBarrier& b) {
    asm volatile("s_waitcnt vmcnt(0)" ::: "memory");
    __syncthreads();
    if (threadIdx.x == 0) {
        unsigned* bar = b.bar;
        __builtin_amdgcn_s_waitcnt(0);
        unsigned nloc = b.st[0], nx = b.st[1];
        if (nloc == 0u) { xcd_barrier_complete(bar, b.x, nloc, nx); b.st[0] = nloc; b.st[1] = nx; }
        const unsigned old = xb_add(&bar[XB_XSUB(b.x)], 1u);
        const unsigned gen = old / nloc;
        if (old + 1u == (gen + 1u) * nloc) {
            __builtin_amdgcn_fence(__ATOMIC_RELEASE, "agent");
            asm volatile("s_waitcnt vmcnt(0)" ::: "memory");
            const unsigned og = xb_add(&bar[XB_TOP], 1u);
            const unsigned tg = og / nx;
            if (og + 1u == (tg + 1u) * nx) xb_add(&bar[XB_TOPGEN], 1u);
            else XB_SPIN(xb_ld(&bar[XB_TOPGEN]) == tg, bar);
            __builtin_amdgcn_fence(__ATOMIC_ACQUIRE, "agent");
            xb_add(&bar[XB_XGEN(b.x)], 1u);
            asm volatile("s_waitcnt vmcnt(0)" ::: "memory");
        } else {
            __builtin_amdgcn_fence(__ATOMIC_ACQUIRE, "agent");
            XB_SPIN(xb_ld(&bar[XB_TOPGEN]) == gen, bar);
            asm volatile("s_waitcnt vmcnt(0)" ::: "memory");
        }
    }
    __syncthreads();
}

namespace pg8 {
constexpr int BM = 256, BK = 64, HALF = 128, HTB = HALF * BK * 2, STAGE_BYTES = 8 * HTB, NXCD = 8, WGM = 8;
__host__ __device__ __forceinline__ int lds_byte(int r, int c) { const int st = (r >> 4) * 2 + (c >> 5), rr = r & 15, cc = c & 31, ob = rr * 64 + cc * 2; return st * 1024 + (ob ^ (((ob >> 9) & 1) << 5)); }
__host__ __device__ __forceinline__ void stage_rc(int b, int& R, int& C) { const int st = b / 1024, sb = b % 1024, swz = sb ^ (((sb >> 9) & 1) << 5); R = (st >> 1) * 16 + swz / 64; C = (st & 1) * 32 + (swz % 64) / 2; }
__host__ __device__ __forceinline__ int perm32(int rho) { const int n = rho >> 4, i = rho & 15; return 8 * (i >> 2) + 4 * n + (i & 3); }
struct Unit { int pm, pn, k0, nt, kind, slot; };
struct Gemm { const bf16_t* A; const bf16_t* Bt; int M, N, K; };
struct StaticOrder {
    int nM, nN, nwg, G, c, ntile;
    __host__ __device__ void init(int M_, int N_, int K_, int G_, int c_) { nM = M_ / BM; nN = N_ / BM; nwg = nM * nN; G = G_; c = c_; ntile = K_ / BK; }
    __host__ __device__ bool next(int i, Unit& u) const {
        const long L = (long)i * G + c; if (L >= nwg) return false;
        int wgid = (int)L; { const int q = nwg / NXCD, r = nwg % NXCD, xcd = wgid % NXCD, off = wgid / NXCD; wgid = (xcd < r ? xcd * (q + 1) : r * (q + 1) + (xcd - r) * q) + off; }
        const int nig = WGM * nN, gid = wgid / nig, fm = gid * WGM, gsz = (nM - fm) < WGM ? (nM - fm) : WGM;
        u.pm = fm + ((wgid % nig) % gsz); u.pn = (wgid % nig) / gsz; u.k0 = 0; u.nt = ntile; u.kind = 0; u.slot = 0; return true;
    }
};

struct TeamOrder {
    int x, j, pn, npair, streamk;
    __host__ __device__ void init(int K_, int c_, int streamk_) { x = c_ & 7; const int l = c_ >> 3; j = l >> 2; pn = l & 3; npair = K_ / (2 * BK); streamk = streamk_; }
    __host__ __device__ bool next(int i, Unit& u) const {
        if (!streamk) { const int q = i * 8 + j; if (q >= 9) return false; u.pm = 9 * x + q; u.pn = pn; u.k0 = 0; u.nt = 2 * npair; u.kind = 0; u.slot = 0; return true; }
        const int total = 9 * npair, R1 = ((j + 1) * total) / 8; int p = (j * total) / 8;
        for (int ii = 0; ; ++ii) {
            if (p >= R1) return false;
            const int panel = p / npair, off = p - panel * npair, tend = (panel + 1) * npair, end = R1 < tend ? R1 : tend;
            if (ii == i) { u.pm = 9 * x + panel; u.pn = pn; u.k0 = off * 2; u.nt = (end - p) * 2; u.kind = off > 0 ? 1 : (end < tend ? 2 : 0);
                u.slot = x * 28 + (u.kind == 1 ? j - 1 : j) * 4 + pn; return true; }
            p = end;
        }
    }
};
template <class Epi, class Sched>
__device__ __forceinline__ void gemm_phase(LAS unsigned char* lds, const Gemm g, const Sched& S, const Epi& E) {
    const int tid = threadIdx.x, wid = __builtin_amdgcn_readfirstlane(tid >> 6), lane = tid & 63, wr = wid >> 2, wc = wid & 3, fr = lane & 15, fq = lane >> 4;
    const int K = g.K;
    unsigned voffA[2], voffB[2];
#pragma unroll
    for (int i = 0; i < 2; ++i) { int R, C; stage_rc(tid * 16 + i * 8192, R, C); const int Rb = (R & ~31) + perm32(R & 31);
        voffA[i] = (unsigned)(R * K + C) * 2u; voffB[i] = (unsigned)(Rb * K + C) * 2u; }
    const size_t kstep = (size_t)(BK * 2);
    const size_t hstep = (size_t)HALF * K * 2;
    const size_t tstep = 2 * hstep;
    const unsigned ldsw = (unsigned)wid * 1024u;
    const int aoff = lds_byte(wr * 64 + fr, fq * 8), boff = lds_byte(wc * 32 + fr, fq * 8);
#define PG8_SA(b, h) (((b) * 2 + (h)) * HTB)
#define PG8_SB(b, h) ((4 + (b) * 2 + (h)) * HTB)
#define PG8_STAGE(bufoff, gbase, voff) do { _Pragma("unroll") for (int _i = 0; _i < 2; ++_i) \
        __builtin_amdgcn_global_load_lds((const unsigned*)((const char*)(gbase) + (voff)[_i]), (LAS unsigned*)(lds + (bufoff) + ldsw + _i * 8192), 16, 0, 0); } while (0)
#define PG8_LDA(dst, b, h) do { _Pragma("unroll") for (int m = 0; m < 4; ++m) _Pragma("unroll") for (int k = 0; k < 2; ++k) dst[m][k] = *(const LAS bf16x8*)(lds + PG8_SA(b, h) + aoff + m * 2048 + k * 1024); } while (0)
#define PG8_LDB(dst, b, h) do { _Pragma("unroll") for (int n = 0; n < 2; ++n) _Pragma("unroll") for (int k = 0; k < 2; ++k) dst[n][k] = *(const LAS bf16x8*)(lds + PG8_SB(b, h) + boff + n * 2048 + k * 1024); } while (0)
#define PG8_MMA(ai, bj, At, Bt) do { __builtin_amdgcn_s_setprio(1); _Pragma("unroll") for (int m = 0; m < 4; ++m) _Pragma("unroll") for (int n = 0; n < 2; ++n) _Pragma("unroll") for (int k = 0; k < 2; ++k) \
        acc[ai][bj][m][n] = __builtin_amdgcn_mfma_f32_16x16x32_bf16(Bt[n][k], At[m][k], acc[ai][bj][m][n], 0, 0, 0); __builtin_amdgcn_s_setprio(0); } while (0)
#define PG8_WAIT_V(n) asm volatile("s_waitcnt vmcnt(" #n ")" ::: "memory")
#define PG8_WAIT_L(n) asm volatile("s_waitcnt lgkmcnt(" #n ")" ::: "memory")
#define PG8_BAR __builtin_amdgcn_s_barrier()
#define PG8_SCHED __builtin_amdgcn_sched_barrier(0)
    Unit cur, nxt; int ui = 0;
    if (!S.next(0, cur)) return;
    f32x4 acc[2][2][4][2];
    if constexpr (Epi::FUSED) E.init(acc, cur, wid, lane);
    else {
#pragma unroll
    for (int a = 0; a < 2; ++a)
#pragma unroll
        for (int b = 0; b < 2; ++b)
#pragma unroll
            for (int m = 0; m < 4; ++m)
#pragma unroll
                for (int n = 0; n < 2; ++n) acc[a][b][m][n] = (f32x4){0.f, 0.f, 0.f, 0.f};
    }
    bf16x8 At[4][2], B0[2][2], B1[2][2];
    const char* cA = (const char*)g.A + (size_t)cur.pm * tstep + (size_t)cur.k0 * kstep; const char* cB = (const char*)g.Bt + (size_t)cur.pn * tstep + (size_t)cur.k0 * kstep;
#if GEMM_SP2
    PG8_STAGE(PG8_SB(0, 0), cB, voffB); PG8_STAGE(PG8_SB(0, 1), cB + hstep, voffB); PG8_STAGE(PG8_SA(0, 0), cA, voffA); PG8_STAGE(PG8_SA(0, 1), cA + hstep, voffA);
    if (wr == 1) PG8_BAR;
    PG8_WAIT_V(2); PG8_BAR;
    PG8_STAGE(PG8_SB(1, 0), cB + kstep, voffB); PG8_STAGE(PG8_SA(1, 0), cA + kstep, voffA); PG8_STAGE(PG8_SB(1, 1), cB + hstep + kstep, voffB);
    PG8_WAIT_V(6); PG8_BAR;
#else
    PG8_STAGE(PG8_SB(0, 0), cB, voffB); PG8_STAGE(PG8_SA(0, 0), cA, voffA); PG8_STAGE(PG8_SB(0, 1), cB + hstep, voffB); PG8_STAGE(PG8_SA(0, 1), cA + hstep, voffA);
    if (wr == 1) PG8_BAR;
    PG8_WAIT_V(4); PG8_BAR;
    PG8_STAGE(PG8_SB(1, 0), cB + kstep, voffB); PG8_STAGE(PG8_SA(1, 0), cA + kstep, voffA); PG8_STAGE(PG8_SB(1, 1), cB + hstep + kstep, voffB);
    PG8_WAIT_V(6); PG8_BAR;
#endif
    for (;;) {
        const bool has_next = S.next(ui + 1, nxt);
        const char* nA = has_next ? (const char*)g.A + (size_t)nxt.pm * tstep + (size_t)nxt.k0 * kstep : cA; const char* nB = has_next ? (const char*)g.Bt + (size_t)nxt.pn * tstep + (size_t)nxt.k0 * kstep : cB;
        const int nt = cur.nt;
        for (int t = 0; t < nt; t += 2) {
            const bool last = (t == nt - 2);
            const char* a1 = cA + (size_t)(t + 1) * kstep;
            const char* a2 = last ? nA : cA + (size_t)(t + 2) * kstep; const char* b2 = last ? nB : cB + (size_t)(t + 2) * kstep;
            const char* a3 = a2 + kstep; const char* b3 = b2 + kstep;
#if GEMM_SP2
            PG8_LDB(B0, 0, 0); PG8_LDB(B1, 0, 1); PG8_SCHED; PG8_LDA(At, 0, 0); PG8_STAGE(PG8_SA(1, 1), a1 + hstep, voffA);
            PG8_WAIT_V(8); PG8_WAIT_L(0); PG8_BAR; PG8_MMA(0, 0, At, B0); PG8_MMA(0, 1, At, B1); PG8_BAR; PG8_SCHED;
            PG8_LDA(At, 0, 1); PG8_STAGE(PG8_SB(0, 0), b2, voffB); PG8_STAGE(PG8_SB(0, 1), b2 + hstep, voffB); PG8_STAGE(PG8_SA(0, 0), a2, voffA);
            PG8_WAIT_V(8); PG8_WAIT_L(0); PG8_BAR; PG8_MMA(1, 0, At, B0); PG8_MMA(1, 1, At, B1); PG8_BAR; PG8_SCHED;
            PG8_LDB(B0, 1, 0); PG8_LDB(B1, 1, 1); PG8_SCHED; PG8_LDA(At, 1, 0); PG8_STAGE(PG8_SA(0, 1), a2 + hstep, voffA);
            PG8_WAIT_V(8); PG8_WAIT_L(0); PG8_BAR; PG8_MMA(0, 0, At, B0); PG8_MMA(0, 1, At, B1); PG8_BAR; PG8_SCHED;
            PG8_LDA(At, 1, 1); PG8_STAGE(PG8_SB(1, 0), b3, voffB); PG8_STAGE(PG8_SB(1, 1), b3 + hstep, voffB); PG8_STAGE(PG8_SA(1, 0), a3, voffA);
            PG8_WAIT_V(8); PG8_WAIT_L(0); PG8_BAR; PG8_MMA(1, 0, At, B0); PG8_MMA(1, 1, At, B1); PG8_BAR; PG8_SCHED;
#else
            PG8_LDB(B0, 0, 0); PG8_SCHED; PG8_LDA(At, 0, 0); PG8_STAGE(PG8_SA(1, 1), a1 + hstep, voffA);
            PG8_WAIT_L(8); PG8_BAR; PG8_WAIT_L(0); PG8_MMA(0, 0, At, B0); PG8_BAR; PG8_SCHED;
            PG8_LDB(B1, 0, 1); PG8_STAGE(PG8_SB(0, 0), b2, voffB);
            PG8_BAR; PG8_WAIT_L(0); PG8_MMA(0, 1, At, B1); PG8_BAR;
            PG8_LDA(At, 0, 1); PG8_STAGE(PG8_SA(0, 0), a2, voffA);
            PG8_BAR; PG8_WAIT_L(0); PG8_MMA(1, 0, At, B0); PG8_BAR; PG8_SCHED;
            PG8_STAGE(PG8_SB(0, 1), b2 + hstep, voffB);
            PG8_WAIT_V(6); PG8_BAR; PG8_MMA(1, 1, At, B1); PG8_BAR;
            PG8_LDB(B0, 1, 0); PG8_SCHED; PG8_LDA(At, 1, 0); PG8_STAGE(PG8_SA(0, 1), a2 + hstep, voffA);
            PG8_WAIT_L(8); PG8_BAR; PG8_WAIT_L(0); PG8_MMA(0, 0, At, B0); PG8_BAR; PG8_SCHED;
            PG8_LDB(B1, 1, 1); PG8_STAGE(PG8_SB(1, 0), b3, voffB);
            PG8_BAR; PG8_WAIT_L(0); PG8_MMA(0, 1, At, B1); PG8_BAR;
            PG8_LDA(At, 1, 1); PG8_STAGE(PG8_SA(1, 0), a3, voffA);
            PG8_BAR; PG8_WAIT_L(0); PG8_MMA(1, 0, At, B0); PG8_BAR; PG8_SCHED;
            PG8_STAGE(PG8_SB(1, 1), b3 + hstep, voffB);
            PG8_WAIT_V(6); PG8_BAR; PG8_MMA(1, 1, At, B1); PG8_BAR;
#endif
        }
        if constexpr (Epi::FUSED) {
            if (wr == 0) PG8_BAR;
            E.fused(acc, cur, wr, wc, fr, fq, lds + STAGE_BYTES, wid, lane);
            if (wr == 1) PG8_BAR;
        } else {
#if GEMM_ALIGN_EPI
            if (wr == 0) PG8_BAR;
            E(acc, cur, wr, wc, fr, fq);
            if (wr == 1) PG8_BAR;
#else
            E(acc, cur, wr, wc, fr, fq);
#endif
        }
        if (!has_next) break;
        if constexpr (Epi::FUSED) E.init(acc, nxt, wid, lane);
        else {
#pragma unroll
        for (int a = 0; a < 2; ++a)
#pragma unroll
            for (int b = 0; b < 2; ++b)
#pragma unroll
                for (int m = 0; m < 4; ++m)
#pragma unroll
                    for (int n = 0; n < 2; ++n) acc[a][b][m][n] = (f32x4){0.f, 0.f, 0.f, 0.f};
        }
        cur = nxt; cA = nA; cB = nB; ++ui;
    }
    PG8_WAIT_V(0);
    if (wr == 0) PG8_BAR;
    PG8_BAR;
#undef PG8_SA
#undef PG8_SB
#undef PG8_STAGE
#undef PG8_LDA
#undef PG8_LDB
#undef PG8_MMA
#undef PG8_WAIT_V
#undef PG8_WAIT_L
#undef PG8_BAR
#undef PG8_SCHED
}
}
using pg8::Unit;
typedef f32x4 Acc[2][2][4][2];


struct EpiProj {
    static constexpr bool FUSED = false;
    bf16_t* H; const float* rope; float* out;
    __device__ __forceinline__ void operator()(const Acc& acc, const Unit& u, int wr, int wc, int fr, int fq) const {
        const int pn = u.pn;
#pragma unroll
        for (int ai = 0; ai < 2; ++ai)
#pragma unroll
            for (int m = 0; m < 4; ++m) {
                const int row = u.pm * 256 + ai * 128 + wr * 64 + m * 16 + fr;
                const int pos = row < MP ? (row & (SEQ - 1)) : PAST + ((row - MP) & (DEC_L - 1));
                bf16_t* rowp = H + (size_t)row * D_IN + pn * 256 + wc * 32 + 8 * fq;
#pragma unroll
                for (int bj = 0; bj < 2; ++bj) {
                    f32x4 v0 = acc[ai][bj][m][0], v1 = acc[ai][bj][m][1];
                    if (pn >= 3) {
#pragma unroll
                        for (int j = 0; j < 4; j += 2) { const f32x2 a = gelu_tanh_pk((f32x2){v0[j], v0[j + 1]}), b = gelu_tanh_pk((f32x2){v1[j], v1[j + 1]}); v0[j] = a.x; v0[j + 1] = a.y; v1[j] = b.x; v1[j + 1] = b.y; }
                    } else {
                        const bool is_v = (pn == 2 && bj == 1);
                        if (!is_v) {
                            f32x4 p0, p1;
#pragma unroll
                            for (int j = 0; j < 4; ++j) { p0[j] = __shfl_xor(v0[j], 16); p1[j] = __shfl_xor(v1[j], 16); }
                            if ((wc & 1) == 0 && fq < 2) {
                                const f32x4 c0 = *(const f32x4*)(rope + pos * 16), c1 = *(const f32x4*)(rope + pos * 16 + 4), s0 = *(const f32x4*)(rope + pos * 16 + 8), s1 = *(const f32x4*)(rope + pos * 16 + 12);
                                if (fq == 0) { v0 = v0 * c0 - p0 * s0; v1 = v1 * c1 - p1 * s1; }
                                else         { v0 = v0 * c0 + p0 * s0; v1 = v1 * c1 + p1 * s1; }
                            }
                        }
                        if (pn == 2) {
                            const int c = wc * 32 + 8 * fq;
                            float* o = nullptr;
                            if (row >= MP) o = out + (bj ? O_VS : O_KS) + (size_t)(row - MP) * 128 + c;
                            else if ((row & (SEQ - 1)) >= SEQ - 128) o = out + (bj ? O_VP : O_KP) + ((size_t)(row >> 11) * 128 + ((row & (SEQ - 1)) - (SEQ - 128))) * 128 + c;
                            if (o) { *(f32x4*)o = v0; *(f32x4*)(o + 4) = v1; }
                        } else { v0 = v0 * 0.18033688011112042f; v1 = v1 * 0.18033688011112042f; }
                    }
                    u32x4 w; w.x = cvt_pk_bf16(v0[0], v0[1]); w.y = cvt_pk_bf16(v0[2], v0[3]); w.z = cvt_pk_bf16(v1[0], v1[1]); w.w = cvt_pk_bf16(v1[2], v1[3]);
                    *(u32x4*)(rowp + bj * 128) = w;
                }
            }
    }
};
template <int WHICH> struct EpiLn {
    static constexpr bool FUSED = true;
    int set;
    __device__ __forceinline__ void init(Acc& acc, const Unit& u, int wid_, int lane_) const {
        int lane = lane_, wid = wid_; asm volatile("" : "+v"(lane)); asm volatile("" : "+s"(wid));
        const int fr = lane & 15, fq = lane >> 4, wr = wid >> 2, wc = wid & 3, tid = wid * 64 + lane;
        typedef const Params __attribute__((address_space(4)))* KP;
        KP pp = (KP)__builtin_amdgcn_kernarg_segment_ptr(); asm volatile("" : "+s"(pp));
        unsigned char* ws = pp->ws;
        if (u.kind == 2) {
            unsigned* flg = (unsigned*)(ws + WS_FLG) + set * 224 * 64;
            unsigned sp = 0;
            while ((unsigned)__builtin_amdgcn_readfirstlane(__hip_atomic_load(flg + 64 * u.slot, __ATOMIC_RELAXED, __HIP_MEMORY_SCOPE_AGENT)) < 8u) { __builtin_amdgcn_s_sleep(2); if (++sp > (1u << 22)) break; }
            asm volatile("" ::: "memory");
            const unsigned long long* sl = (const unsigned long long*)(ws + WS_SLAB) + (size_t)u.slot * 16384 + (size_t)tid;
#pragma unroll
            for (int ai = 0; ai < 2; ++ai)
#pragma unroll
                for (int bj = 0; bj < 2; ++bj)
#pragma unroll
                    for (int m = 0; m < 4; ++m)
#pragma unroll
                        for (int n = 0; n < 2; ++n) {
                            const unsigned long long a = __hip_atomic_load(sl, __ATOMIC_RELAXED, __HIP_MEMORY_SCOPE_AGENT);
                            sl += 512; asm volatile("" : "+v"(sl));
                            const unsigned lo = (unsigned)a, hi = (unsigned)(a >> 32);
                            acc[ai][bj][m][n] = (f32x4){bflo(lo), bfhi(lo), bflo(hi), bfhi(hi)}; }
            return;
        }
        const int rbase = u.pm * 256, col0 = u.pn * 256 + wc * 32 + 8 * fq;
#pragma unroll
        for (int ai = 0; ai < 2; ++ai)
#pragma unroll
            for (int m = 0; m < 4; ++m) { const int rl = ai * 128 + wr * 64 + m * 16 + fr;
#pragma unroll
                for (int bj = 0; bj < 2; ++bj) {
                    { const u32x4 h = *(const u32x4*)((const bf16_t*)(ws + (WHICH == 1 ? WS_XB : WS_HB)) + (size_t)(rbase + rl) * D + col0 + bj * 128);
                        acc[ai][bj][m][0] = (f32x4){bflo(h.x), bfhi(h.x), bflo(h.y), bfhi(h.y)} * ALPHA; acc[ai][bj][m][1] = (f32x4){bflo(h.z), bfhi(h.z), bflo(h.w), bfhi(h.w)} * ALPHA; } } }
    }
    __device__ __forceinline__ void fused(const Acc& acc, const Unit& u, int wr_, int wc_, int fr_, int fq_, LAS unsigned char* lx, int wid_, int lane_) const {
        int lane = lane_, wid = wid_; asm volatile("" : "+v"(lane)); asm volatile("" : "+s"(wid));
        const int fr = lane & 15, fq = lane >> 4, wr = wid >> 2, wc = wid & 3, tid = wid * 64 + lane;
        typedef const Params __attribute__((address_space(4)))* KP;
        KP pp = (KP)__builtin_amdgcn_kernarg_segment_ptr(); asm volatile("" : "+s"(pp));
        unsigned char* ws = pp->ws;
        if (u.kind == 1) {
            unsigned* flg = (unsigned*)(ws + WS_FLG) + set * 224 * 64;
            unsigned long long* sl = (unsigned long long*)(ws + WS_SLAB) + (size_t)u.slot * 16384 + (size_t)tid;
#pragma unroll
            for (int ai = 0; ai < 2; ++ai)
#pragma unroll
                for (int bj = 0; bj < 2; ++bj)
#pragma unroll
                    for (int m = 0; m < 4; ++m)
#pragma unroll
                        for (int n = 0; n < 2; ++n) { const f32x4 v = acc[ai][bj][m][n];
                            __hip_atomic_store(sl, ((unsigned long long)cvt_pk_bf16(v[2], v[3]) << 32) | cvt_pk_bf16(v[0], v[1]), __ATOMIC_RELAXED, __HIP_MEMORY_SCOPE_AGENT);
                            sl += 512; asm volatile("" : "+v"(sl)); }
            asm volatile("s_waitcnt vmcnt(0)" ::: "memory");
            if (lane == 0) __hip_atomic_fetch_add(flg + 64 * u.slot, 1u, __ATOMIC_RELAXED, __HIP_MEMORY_SCOPE_AGENT);
            return;
        }
        bf16_t* Hout = (bf16_t*)(ws + WS_HB); float* Y = pp->out + O_Y;
        const float* gam = WHICH == 1 ? pp->ln1_g : pp->ln2_g; const float* bet = WHICH == 1 ? pp->ln1_b : pp->ln2_b;
        unsigned long long* xbuf = (unsigned long long*)(ws + (WHICH == 1 ? WS_XB1 : WS_XB2)); unsigned* cnt = (unsigned*)(ws + WS_CNT) + set * 72 * 64;
        const int rbase = u.pm * 256, col0 = u.pn * 256 + wc * 32 + 8 * fq;
        LAS f32x2* P = (LAS f32x2*)lx;
        LAS f32x2* S = (LAS f32x2*)(lx + 8192);
#pragma unroll
        for (int ai = 0; ai < 2; ++ai)
#pragma unroll
            for (int m = 0; m < 4; ++m) {
                float s = 0.f;
#pragma unroll
                for (int bj = 0; bj < 2; ++bj)
#pragma unroll
                    for (int n = 0; n < 2; ++n) { const f32x4 x = acc[ai][bj][m][n]; s += (x[0] + x[1]) + (x[2] + x[3]); }
                s += __shfl_xor(s, 16); s += __shfl_xor(s, 32);
                const float mw = s * (1.0f / 64.0f); float q = 0.f;
#pragma unroll
                for (int bj = 0; bj < 2; ++bj)
#pragma unroll
                    for (int n = 0; n < 2; ++n) { const f32x4 d = acc[ai][bj][m][n] - mw; q += (d[0] * d[0] + d[1] * d[1]) + (d[2] * d[2] + d[3] * d[3]); }
                q += __shfl_xor(q, 16); q += __shfl_xor(q, 32);
                if (fq == 0) P[(ai * 128 + wr * 64 + m * 16 + fr) * 4 + wc] = (f32x2){mw, q};
            }
        asm volatile("s_waitcnt lgkmcnt(0)" ::: "memory"); __builtin_amdgcn_s_barrier(); asm volatile("" ::: "memory");
        const int row = wid * 32 + (lane & 31);
        if (lane < 32) {
            const f32x2 a = P[row * 4 + 0], b = P[row * 4 + 1], c = P[row * 4 + 2], d = P[row * 4 + 3];
            const float mt = (a.x + b.x + c.x + d.x) * 0.25f;
            const float da = a.x - mt, db = b.x - mt, dc = c.x - mt, dd = d.x - mt;
            const float m2 = (a.y + b.y) + (c.y + d.y) + 64.0f * ((da * da + db * db) + (dc * dc + dd * dd));
            __hip_atomic_store(xbuf + ((size_t)(rbase + row) * 4 + u.pn), ((unsigned long long)__float_as_uint(m2) << 32) | __float_as_uint(mt), __ATOMIC_RELAXED, __HIP_MEMORY_SCOPE_AGENT);
        }
        asm volatile("s_waitcnt vmcnt(0)" ::: "memory");
        if (lane == 0) __hip_atomic_fetch_add(cnt + 64 * u.pm, 1u, __ATOMIC_RELAXED, __HIP_MEMORY_SCOPE_AGENT);
        if (wid == 0) { unsigned sp = 0;
            while ((unsigned)__builtin_amdgcn_readfirstlane(__hip_atomic_load(cnt + 64 * u.pm, __ATOMIC_RELAXED, __HIP_MEMORY_SCOPE_AGENT)) < 32u) { __builtin_amdgcn_s_sleep(2); if (++sp > (1u << 22)) break; }
            asm volatile("" ::: "memory"); }
        asm volatile("s_waitcnt vmcnt(0) lgkmcnt(0)" ::: "memory"); __builtin_amdgcn_s_barrier(); asm volatile("" ::: "memory");
        if (lane < 32) {
            const unsigned long long* slot = xbuf + (size_t)(rbase + row) * 4; float mt[4], m2[4]; float ms = 0.f;
#pragma unroll
            for (int t = 0; t < 4; ++t) { const unsigned long long w = __hip_atomic_load(slot + t, __ATOMIC_RELAXED, __HIP_MEMORY_SCOPE_AGENT); mt[t] = __uint_as_float((unsigned)w); m2[t] = __uint_as_float((unsigned)(w >> 32)); ms += mt[t]; }
            const float mean = ms * 0.25f; float q = 0.f;
#pragma unroll
            for (int t = 0; t < 4; ++t) { const float dm = mt[t] - mean; q += m2[t] + 256.0f * dm * dm; }
            S[row] = (f32x2){mean, rsqrtf(q * (1.0f / 1024.0f) + LN_EPS)};
        }
        asm volatile("s_waitcnt lgkmcnt(0)" ::: "memory"); __builtin_amdgcn_s_barrier(); asm volatile("" ::: "memory");
        f32x4 g0[2], g1[2], b0[2], b1[2];
#pragma unroll
        for (int bj = 0; bj < 2; ++bj) { g0[bj] = *(const f32x4*)(gam + col0 + bj * 128); g1[bj] = *(const f32x4*)(gam + col0 + bj * 128 + 4); b0[bj] = *(const f32x4*)(bet + col0 + bj * 128); b1[bj] = *(const f32x4*)(bet + col0 + bj * 128 + 4); }
#pragma unroll
        for (int ai = 0; ai < 2; ++ai)
#pragma unroll
            for (int m = 0; m < 4; ++m) { const int rl = ai * 128 + wr * 64 + m * 16 + fr; const f32x2 st = S[rl];
#pragma unroll
                for (int bj = 0; bj < 2; ++bj) { const f32x4 y0 = (acc[ai][bj][m][0] - st.x) * st.y * g0[bj] + b0[bj], y1 = (acc[ai][bj][m][1] - st.x) * st.y * g1[bj] + b1[bj];
                    if (WHICH == 1) { u32x4 w; w.x = cvt_pk_bf16(y0[0], y0[1]); w.y = cvt_pk_bf16(y0[2], y0[3]); w.z = cvt_pk_bf16(y1[0], y1[1]); w.w = cvt_pk_bf16(y1[2], y1[3]);
                        *(u32x4*)(Hout + (size_t)(rbase + rl) * D + col0 + bj * 128) = w; }
                    else { float* yr = Y + (size_t)(rbase + rl) * D + col0 + bj * 128; __builtin_nontemporal_store(y0, (f32x4*)yr); __builtin_nontemporal_store(y1, (f32x4*)(yr + 4)); } } }
        asm volatile("s_waitcnt lgkmcnt(0)" ::: "memory"); __builtin_amdgcn_s_barrier(); asm volatile("" ::: "memory");
    }
};
struct EpiSwiglu {
    static constexpr bool FUSED = false;
    bf16_t* ACT;
    __device__ __forceinline__ void operator()(const Acc& acc, const Unit& u, int wr, int wc, int fr, int fq) const {
        const int col0 = u.pn * 128 + wc * 32 + 8 * fq;
#pragma unroll
        for (int ai = 0; ai < 2; ++ai)
#pragma unroll
            for (int m = 0; m < 4; ++m) { const int row = u.pm * 256 + ai * 128 + wr * 64 + m * 16 + fr;
                f32x4 a0 = acc[ai][0][m][0], a1 = acc[ai][0][m][1]; const f32x4 b0 = acc[ai][1][m][0], b1 = acc[ai][1][m][1];
#pragma unroll
                for (int j = 0; j < 4; j += 2) { const f32x2 p0 = silu_mul_pk((f32x2){a0[j], a0[j + 1]}, (f32x2){b0[j], b0[j + 1]}), p1 = silu_mul_pk((f32x2){a1[j], a1[j + 1]}, (f32x2){b1[j], b1[j + 1]});
                    a0[j] = p0.x; a0[j + 1] = p0.y; a1[j] = p1.x; a1[j + 1] = p1.y; }
                u32x4 w; w.x = cvt_pk_bf16(a0[0], a0[1]); w.y = cvt_pk_bf16(a0[2], a0[3]); w.z = cvt_pk_bf16(a1[0], a1[1]); w.w = cvt_pk_bf16(a1[2], a1[3]);
                *(u32x4*)(ACT + (size_t)row * D_FF + col0) = w; }
    }
};

struct TileDesc { const float* W; bf16_t* Bt; int K, N, tk, tn, mode; };
__device__ __forceinline__ void tile_load(const TileDesc& d, f32x4& v0, f32x4& v1) {
    const int t = threadIdx.x, r = t >> 4, c4 = (t & 15) * 4;
    v0 = __builtin_nontemporal_load((const f32x4*)(d.W + (size_t)(d.tk * 64 + r) * d.N + d.tn * 64 + c4)); v1 = __builtin_nontemporal_load((const f32x4*)(d.W + (size_t)(d.tk * 64 + r + 32) * d.N + d.tn * 64 + c4));
}
__device__ __forceinline__ void tile_finish(const TileDesc& d, const f32x4& v0, const f32x4& v1, LAS float* tile) {
    const int t = threadIdx.x;
    { const int r = t >> 4, c4 = (t & 15) * 4;
      tile[r * 65 + c4] = v0[0]; tile[r * 65 + c4 + 1] = v0[1]; tile[r * 65 + c4 + 2] = v0[2]; tile[r * 65 + c4 + 3] = v0[3];
      tile[(r + 32) * 65 + c4] = v1[0]; tile[(r + 32) * 65 + c4 + 1] = v1[1]; tile[(r + 32) * 65 + c4 + 2] = v1[2]; tile[(r + 32) * 65 + c4 + 3] = v1[3]; }
    __syncthreads();
    { const int n = t >> 3, k8 = (t & 7) * 8; float v[8];
#pragma unroll
      for (int j = 0; j < 8; ++j) v[j] = tile[(k8 + j) * 65 + n];
      int ng = d.tn * 64 + n;
      if (d.mode == 1) { const int up = ng >= D_FF; const int n2 = up ? ng - D_FF : ng; ng = 256 * (n2 >> 7) + (n2 & 127) + (up ? 128 : 0); }
      u32x4 w; w.x = cvt_pk_bf16(v[0], v[1]); w.y = cvt_pk_bf16(v[2], v[3]); w.z = cvt_pk_bf16(v[4], v[5]); w.w = cvt_pk_bf16(v[6], v[7]);
      *(u32x4*)(d.Bt + (size_t)ng * d.K + d.tk * 64 + k8) = w; }
    __syncthreads();
}
__device__ __forceinline__ TileDesc tile_desc(const Params& p, int part, int i) {
    if (part == 0) { if (i < 256) return TileDesc{p.w_out, (bf16_t*)(p.ws + WS_W2), D, D, i / 16, i % 16, 0};
                     const int j = i - 256; return TileDesc{p.w_gu, (bf16_t*)(p.ws + WS_W3), D, 2 * D_FF, j / 88, j % 88, 1}; }
    if (part == 1) return TileDesc{p.w_down, (bf16_t*)(p.ws + WS_W4), D_FF, D, i / 16, i % 16, 0};
    return TileDesc{p.w_in, (bf16_t*)(p.ws + WS_W1), D, D_IN, i / 28, i % 28, 0};
}
__device__ void late_transposes(const Params& p, LAS unsigned char* lds, int first, int stride, int part, int end) {
    LAS float* tile = (LAS float*)lds;
    const int n = part == 0 ? 256 + 1408 : (part == 1 ? 704 : 448); if (end > n) end = n;
    if (first >= end) return;
    TileDesc d = tile_desc(p, part, first); f32x4 a0, a1; tile_load(d, a0, a1);
    for (int i = first; ; i += stride) {
        const int nx = i + stride; const bool hn = nx < end;
        TileDesc dn = d; f32x4 b0 = a0, b1 = a1;
        if (hn) { dn = tile_desc(p, part, nx); tile_load(dn, b0, b1); }
        tile_finish(d, a0, a1, tile);
        if (!hn) break;
        d = dn; a0 = b0; a1 = b1;
    }
}
__device__ void prologue(const Params& p, LAS unsigned char* lds) {
    const int G = gridDim.x, bid = blockIdx.x, t = threadIdx.x;
    LAS float* tile = (LAS float*)lds;
    bf16_t* W1 = (bf16_t*)(p.ws + WS_W1);
    late_transposes(p, lds, bid, G, 2, 1 << 30);
    bf16_t* XB = (bf16_t*)(p.ws + WS_XB);
    const size_t n8 = (size_t)M * D / 8, np8 = (size_t)MP * D / 8;
    for (size_t i = (size_t)bid * NTHREADS + t; i < n8; i += (size_t)G * NTHREADS) {
        const float* src = i < np8 ? p.x_prompt + i * 8 : p.x_sample + (i - np8) * 8;
        const f32x4 a = __builtin_nontemporal_load((const f32x4*)src), b = __builtin_nontemporal_load((const f32x4*)(src + 4));
        u32x4 w; w.x = cvt_pk_bf16(a[0], a[1]); w.y = cvt_pk_bf16(a[2], a[3]); w.z = cvt_pk_bf16(b[0], b[1]); w.w = cvt_pk_bf16(b[2], b[3]);
        *(u32x4*)(XB + i * 8) = w;
    }
    float* rope = (float*)(p.ws + WS_ROPE);
    for (int i = bid * NTHREADS + t; i < 2048 * 8; i += G * NTHREADS) {
        const int pos = i >> 3, k = i & 7;
        const float inv = (float)exp(-(double)k * 0.125 * 13.122363377404328);
        const double ang = (double)((float)pos * inv);
        rope[pos * 16 + k] = (float)cos(ang); rope[pos * 16 + 8 + k] = (float)sin(ang);
    }
    bf16_t* WSB = (bf16_t*)(p.ws + WS_WS);
    for (int i = bid * NTHREADS + t; i < 8 * 128 * 128 / 2; i += G * NTHREADS) {
        const int e = i * 2, ri = (e >> 7) & 127, cj = e & 127; const bool ok = !(ri < 64 && cj >= 64);
        const f32x2 v = *(const f32x2*)(p.w_sp + e);
        *(unsigned*)(WSB + e) = ok ? cvt_pk_bf16(v[0], v[1]) : 0u;
    }
}

constexpr int KS_STRIDE = 72, VT_STRIDE = 200;
constexpr int LDS_KS = 0, LDS_VT = LDS_KS + 2 * 192 * KS_STRIDE * 2, LDS_ASSQ = LDS_VT + 2 * 64 * VT_STRIDE * 2;
__device__ void attn_unit(const Params& p, LAS unsigned char* lds, int unit) {
    int t_ = threadIdx.x; asm volatile("" : "+v"(t_));
    const int t = t_, wid = t >> 6, lane = t & 63, fr = lane & 15, fq = lane >> 4;
    const bool samp = unit >= 256; const int b = samp ? unit - 256 : unit >> 5, c = samp ? 2 : (unit & 31);
    const int r0 = samp ? MP + b * 64 : b * SEQ + c * 64;
    const int kstart = samp ? 0 : (c >= 2 ? 0 : (2 - c) * 64);
    const bf16_t* H = (const bf16_t*)(p.ws + WS_H);
    LAS bf16_t* Ks = (LAS bf16_t*)(lds + LDS_KS); LAS bf16_t* Vt = (LAS bf16_t*)(lds + LDS_VT); LAS float* ssq = (LAS float*)(lds + LDS_ASSQ);
    const int h = wid;
    bf16x8 qf[4][2];
#pragma unroll
    for (int qt = 0; qt < 4; ++qt)
#pragma unroll
        for (int ks = 0; ks < 2; ++ks) qf[qt][ks] = *(const bf16x8*)(H + (size_t)(r0 + qt * 16 + fr) * D_IN + C_Q + h * 64 + ks * 32 + fq * 8);
#pragma unroll
    for (int qi = 0; qi < 6; ++qi) { const int q = t + qi * NTHREADS;
        const int key = q >> 4, cc = q & 15, kvh = cc >> 3, d0 = (cc & 7) * 8;
        u32x4 kw = {0u, 0u, 0u, 0u}, vw = {0u, 0u, 0u, 0u};
        if (key >= kstart) {
            if (samp && key < 128) {
                const float* ck = p.cache_k + ((size_t)(b * 128 + key) * 2 + kvh) * 64 + d0; const float* cv = p.cache_v + ((size_t)(b * 128 + key) * 2 + kvh) * 64 + d0;
                const f32x4 a0 = *(const f32x4*)ck, a1 = *(const f32x4*)(ck + 4), b0 = *(const f32x4*)cv, b1 = *(const f32x4*)(cv + 4);
                kw.x = cvt_pk_bf16(a0[0], a0[1]); kw.y = cvt_pk_bf16(a0[2], a0[3]); kw.z = cvt_pk_bf16(a1[0], a1[1]); kw.w = cvt_pk_bf16(a1[2], a1[3]);
                vw.x = cvt_pk_bf16(b0[0], b0[1]); vw.y = cvt_pk_bf16(b0[2], b0[3]); vw.z = cvt_pk_bf16(b1[0], b1[1]); vw.w = cvt_pk_bf16(b1[2], b1[3]);
            } else {
                const bf16_t* hr = H + (size_t)(r0 - 128 + key) * D_IN;
                kw = *(const u32x4*)(hr + C_K + kvh * 64 + d0); vw = *(const u32x4*)(hr + C_V + kvh * 64 + d0);
            }
        }
        *(LAS u32x4*)(Ks + (kvh * 192 + key) * KS_STRIDE + d0) = kw;
        LAS bf16_t* vt = Vt + (kvh * 64 + d0) * VT_STRIDE + ((((key >> 3) ^ (cc & 7)) << 3) | (key & 7));
        vt[0 * VT_STRIDE] = (bf16_t)(vw.x & 0xffff); vt[1 * VT_STRIDE] = (bf16_t)(vw.x >> 16); vt[2 * VT_STRIDE] = (bf16_t)(vw.y & 0xffff); vt[3 * VT_STRIDE] = (bf16_t)(vw.y >> 16);
        vt[4 * VT_STRIDE] = (bf16_t)(vw.z & 0xffff); vt[5 * VT_STRIDE] = (bf16_t)(vw.z >> 16); vt[6 * VT_STRIDE] = (bf16_t)(vw.w & 0xffff); vt[7 * VT_STRIDE] = (bf16_t)(vw.w >> 16);
    }
    __syncthreads();
    const int kvh = h >> 2;
    const float sink = p.sinks[h] * 1.4426950408889634f;
    f32x4 o[4][4];
#pragma unroll
    for (int qp = 0; qp < 2; ++qp) {
        f32x4 s[2][12];
#pragma unroll
        for (int kt = 0; kt < 12; ++kt) {
            s[0][kt] = (f32x4){0.f, 0.f, 0.f, 0.f}; s[1][kt] = (f32x4){0.f, 0.f, 0.f, 0.f};
#pragma unroll
            for (int ks = 0; ks < 2; ++ks) { const bf16x8 kf = *(const LAS bf16x8*)(Ks + (kvh * 192 + kt * 16 + fr) * KS_STRIDE + ks * 32 + fq * 8);
                s[0][kt] = __builtin_amdgcn_mfma_f32_16x16x32_bf16(kf, qf[2 * qp][ks], s[0][kt], 0, 0, 0);
                s[1][kt] = __builtin_amdgcn_mfma_f32_16x16x32_bf16(kf, qf[2 * qp + 1][ks], s[1][kt], 0, 0, 0); }
        }
        if (kstart > 0) {
#pragma unroll
            for (int kt = 0; kt < 12; ++kt) if (kt * 16 < kstart) { s[0][kt] = (f32x4){-1e30f, -1e30f, -1e30f, -1e30f}; s[1][kt] = s[0][kt]; } }
        float inv[2];
#pragma unroll
        for (int e = 0; e < 2; ++e) {
            float mx = sink;
#pragma unroll
            for (int kt = 0; kt < 12; ++kt) mx = fmaxf(mx, fmaxf(fmaxf(s[e][kt][0], s[e][kt][1]), fmaxf(s[e][kt][2], s[e][kt][3])));
            mx = fmaxf(mx, __shfl_xor(mx, 16)); mx = fmaxf(mx, __shfl_xor(mx, 32));
            float sum = 0.f;
#pragma unroll
            for (int kt = 0; kt < 12; ++kt) {
#pragma unroll
                for (int j = 0; j < 4; ++j) { const float ex = __builtin_amdgcn_exp2f(s[e][kt][j] - mx); s[e][kt][j] = ex; sum += ex; } }
            sum += __shfl_xor(sum, 16); sum += __shfl_xor(sum, 32);
            inv[e] = 1.0f / (sum + __builtin_amdgcn_exp2f(sink - mx));
#pragma unroll
            for (int dt = 0; dt < 4; ++dt) o[2 * qp + e][dt] = (f32x4){0.f, 0.f, 0.f, 0.f};
        }
#pragma unroll
        for (int kp = 0; kp < 6; ++kp) {
            bf16x8 pf[2];
#pragma unroll
            for (int e = 0; e < 2; ++e) { u32x4 pw; pw.x = cvt_pk_bf16(s[e][2 * kp][0], s[e][2 * kp][1]); pw.y = cvt_pk_bf16(s[e][2 * kp][2], s[e][2 * kp][3]);
                pw.z = cvt_pk_bf16(s[e][2 * kp + 1][0], s[e][2 * kp + 1][1]); pw.w = cvt_pk_bf16(s[e][2 * kp + 1][2], s[e][2 * kp + 1][3]); pf[e] = __builtin_bit_cast(bf16x8, pw); }
#pragma unroll
            for (int dt = 0; dt < 4; ++dt) {
                const LAS bf16_t* vrow = Vt + (kvh * 64 + dt * 16 + fr) * VT_STRIDE; const int sw = (dt * 2 + (fr >> 3)) & 7;
                const int k0 = kp * 32 + fq * 4, k1 = k0 + 16;
                const u32x2 va = *(const LAS u32x2*)(vrow + ((((k0 >> 3) ^ sw) << 3) | (k0 & 7))), vb = *(const LAS u32x2*)(vrow + ((((k1 >> 3) ^ sw) << 3) | (k1 & 7)));
                const u32x4 vv = {va.x, va.y, vb.x, vb.y};
                o[2 * qp][dt] = __builtin_amdgcn_mfma_f32_16x16x32_bf16(__builtin_bit_cast(bf16x8, vv), pf[0], o[2 * qp][dt], 0, 0, 0);
                o[2 * qp + 1][dt] = __builtin_amdgcn_mfma_f32_16x16x32_bf16(__builtin_bit_cast(bf16x8, vv), pf[1], o[2 * qp + 1][dt], 0, 0, 0);
            }
        }
#pragma unroll
        for (int e = 0; e < 2; ++e) { const int qt = 2 * qp + e;
            float q2 = 0.f;
#pragma unroll
            for (int dt = 0; dt < 4; ++dt) { o[qt][dt] = o[qt][dt] * inv[e];
#pragma unroll
                for (int j = 0; j < 4; ++j) q2 += o[qt][dt][j] * o[qt][dt][j]; }
            q2 += __shfl_xor(q2, 16); q2 += __shfl_xor(q2, 32);
            if (fq == 0) ssq[h * 64 + qt * 16 + fr] = q2; }
    }
    __syncthreads();
    bf16_t* CAT = (bf16_t*)(p.ws + WS_CAT);
#pragma unroll
    for (int qt = 0; qt < 4; ++qt) {
        float tot = 0.f;
#pragma unroll
        for (int hh = 0; hh < 8; ++hh) tot += ssq[hh * 64 + qt * 16 + fr];
        const float rs = rsqrtf(tot * (1.0f / 512.0f) + LN_EPS);
#pragma unroll
        for (int dt = 0; dt < 4; ++dt) { const int col = h * 64 + dt * 16 + fq * 4; const f32x4 g = *(const f32x4*)(p.g_attn + col); const f32x4 v = o[qt][dt] * rs * g;
            u32x2 w; w.x = cvt_pk_bf16(v[0], v[1]); w.y = cvt_pk_bf16(v[2], v[3]);
            *(u32x2*)(CAT + (size_t)(r0 + qt * 16 + fr) * D + col) = w; }
    }
    __syncthreads();
}

constexpr int VM_STRIDE = 136;
constexpr int LDS_VMT = 0, LDS_GST = LDS_VMT + 8 * 64 * VM_STRIDE * 2, LDS_GSSQ = LDS_GST + 128 * 2 * 4;
__device__ void gate_unit(const Params& p, LAS unsigned char* lds, int unit) {
    int t_ = threadIdx.x; asm volatile("" : "+v"(t_));
    const int t = t_, wid = t >> 6, lane = t & 63, fr = lane & 15, fq = lane >> 4;
    const bool samp = unit >= 256; const int w_ = unit & 127; const int b = samp ? unit - 256 : w_ >> 4, c = samp ? 0 : 2 * (w_ & 15) + (unit < 128 ? 1 : 0), par = c & 1;
    const int r0 = samp ? MP + b * 64 : b * SEQ + c * 64;
    const int Kc = par ? 128 : 64, jr0 = par ? r0 - 64 : r0;
    const bf16_t* H = (const bf16_t*)(p.ws + WS_H);
    LAS bf16_t* VmT = (LAS bf16_t*)(lds + LDS_VMT); LAS float* st = (LAS float*)(lds + LDS_GST); LAS float* ssq = (LAS float*)(lds + LDS_GSSQ);
    const int g = wid, jl = lane >> 3, c8 = (lane & 7) * 8, col = g * 64 + c8;
    LAS f32x2* part = (LAS f32x2*)(lds + LDS_VMT);
    u32x4 raw[16];
#pragma unroll
    for (int it = 0; it < 16; ++it) if (it * 8 < Kc) raw[it] = *(const u32x4*)(H + (size_t)(jr0 + it * 8 + jl) * D_IN + C_VM + col);
#pragma unroll
    for (int it = 0; it < 16; ++it) if (it * 8 < Kc) {
        const u32x4 w = raw[it];
        const float v0 = bflo(w.x), v1 = bfhi(w.x), v2 = bflo(w.y), v3 = bfhi(w.y), v4 = bflo(w.z), v5 = bfhi(w.z), v6 = bflo(w.w), v7 = bfhi(w.w);
        float sm = ((v0 + v1) + (v2 + v3)) + ((v4 + v5) + (v6 + v7));
        float sq = ((v0 * v0 + v1 * v1) + (v2 * v2 + v3 * v3)) + ((v4 * v4 + v5 * v5) + (v6 * v6 + v7 * v7));
        sm += __shfl_xor(sm, 1); sq += __shfl_xor(sq, 1); sm += __shfl_xor(sm, 2); sq += __shfl_xor(sq, 2); sm += __shfl_xor(sm, 4); sq += __shfl_xor(sq, 4);
        if ((lane & 7) == 0) part[(it * 8 + jl) * 8 + g] = (f32x2){sm, sq};
    }
    __syncthreads();
    if (t < Kc) { float sm = 0.f, sq = 0.f;
#pragma unroll
        for (int gg = 0; gg < 8; ++gg) { const f32x2 pv = part[t * 8 + gg]; sm += pv.x; sq += pv.y; }
        const float mean = sm * (1.0f / 512.0f), var = fmaxf(sq * (1.0f / 512.0f) - mean * mean, 0.f);
        st[t * 2] = mean; st[t * 2 + 1] = rsqrtf(var + LN_EPS); }
    __syncthreads();
    { const f32x4 ga0 = *(const f32x4*)(p.ln_v_g + col), ga1 = *(const f32x4*)(p.ln_v_g + col + 4), be0 = *(const f32x4*)(p.ln_v_b + col), be1 = *(const f32x4*)(p.ln_v_b + col + 4);
#pragma unroll
      for (int it = 0; it < 16; ++it) if (it * 8 < Kc) { const int j = it * 8 + jl;
          const u32x4 w = raw[it];
          const float mean = st[j * 2], rstd = st[j * 2 + 1];
          f32x4 v0 = {bflo(w.x), bfhi(w.x), bflo(w.y), bfhi(w.y)}, v1 = {bflo(w.z), bfhi(w.z), bflo(w.w), bfhi(w.w)};
          v0 = (v0 - mean) * rstd * ga0 + be0; v1 = (v1 - mean) * rstd * ga1 + be1;
          if (samp) { float* o = p.out + O_MS + (size_t)(b * 64 + j) * 512 + col; *(f32x4*)o = v0; *(f32x4*)(o + 4) = v1; }
          const unsigned w0 = cvt_pk_bf16(v0[0], v0[1]), w1 = cvt_pk_bf16(v0[2], v0[3]), w2 = cvt_pk_bf16(v1[0], v1[1]), w3 = cvt_pk_bf16(v1[2], v1[3]);
          LAS bf16_t* d = VmT + (g * 64 + c8) * VM_STRIDE + ((it ^ (lane & 7)) * 8 + jl);
          d[0 * VM_STRIDE] = (bf16_t)(w0 & 0xffff); d[1 * VM_STRIDE] = (bf16_t)(w0 >> 16); d[2 * VM_STRIDE] = (bf16_t)(w1 & 0xffff); d[3 * VM_STRIDE] = (bf16_t)(w1 >> 16);
          d[4 * VM_STRIDE] = (bf16_t)(w2 & 0xffff); d[5 * VM_STRIDE] = (bf16_t)(w2 >> 16); d[6 * VM_STRIDE] = (bf16_t)(w3 & 0xffff); d[7 * VM_STRIDE] = (bf16_t)(w3 >> 16); } }
    __syncthreads();
    const bf16_t* WSB = (const bf16_t*)(p.ws + WS_WS) + (size_t)g * 128 * 128 + (size_t)(par * 64) * 128;
    f32x4 acc[4][4];
#pragma unroll
    for (int it = 0; it < 4; ++it)
#pragma unroll
        for (int dt = 0; dt < 4; ++dt) acc[it][dt] = (f32x4){0.f, 0.f, 0.f, 0.f};
    bf16x8 wf[4][4];
#pragma unroll
    for (int ks = 0; ks < 4; ++ks) if (ks * 32 < Kc) {
#pragma unroll
        for (int it = 0; it < 4; ++it) wf[ks][it] = *(const bf16x8*)(WSB + (size_t)(it * 16 + fr) * 128 + ks * 32 + fq * 8); }
#pragma unroll
    for (int ks = 0; ks < 4; ++ks) if (ks * 32 < Kc) {
        bf16x8 vf[4];
#pragma unroll
        for (int dt = 0; dt < 4; ++dt) vf[dt] = *(const LAS bf16x8*)(VmT + (g * 64 + dt * 16 + fr) * VM_STRIDE + (((ks * 4 + fq) ^ ((dt * 2 + (fr >> 3)) & 7)) * 8));
#pragma unroll
        for (int it = 0; it < 4; ++it)
#pragma unroll
            for (int dt = 0; dt < 4; ++dt) acc[it][dt] = __builtin_amdgcn_mfma_f32_16x16x32_bf16(vf[dt], wf[ks][it], acc[it][dt], 0, 0, 0);
    }
    u32x2 uw[4][4];
#pragma unroll
    for (int it = 0; it < 4; ++it)
#pragma unroll
        for (int dt = 0; dt < 4; ++dt) uw[it][dt] = *(const u32x2*)(H + (size_t)(r0 + it * 16 + fr) * D_IN + C_U + g * 64 + dt * 16 + fq * 4);
#pragma unroll
    for (int it = 0; it < 4; ++it) {
        const float bs = p.b_sp[g * 128 + par * 64 + it * 16 + fr]; float q2 = 0.f;
#pragma unroll
        for (int dt = 0; dt < 4; ++dt) { const f32x4 uv = {bflo(uw[it][dt].x), bfhi(uw[it][dt].x), bflo(uw[it][dt].y), bfhi(uw[it][dt].y)};
            acc[it][dt] = (acc[it][dt] + bs) * uv;
#pragma unroll
            for (int j = 0; j < 4; ++j) q2 += acc[it][dt][j] * acc[it][dt][j]; }
        q2 += __shfl_xor(q2, 16); q2 += __shfl_xor(q2, 32);
        if (fq == 0) ssq[g * 64 + it * 16 + fr] = q2;
    }
    __syncthreads();
    bf16_t* CAT = (bf16_t*)(p.ws + WS_CAT);
#pragma unroll
    for (int it = 0; it < 4; ++it) {
        float tot = 0.f;
#pragma unroll
        for (int gg = 0; gg < 8; ++gg) tot += ssq[gg * 64 + it * 16 + fr];
        const float rs = rsqrtf(tot * (1.0f / 512.0f) + LN_EPS);
#pragma unroll
        for (int dt = 0; dt < 4; ++dt) { const int col = g * 64 + dt * 16 + fq * 4; const f32x4 gm = *(const f32x4*)(p.g_cmlp + col); const f32x4 v = acc[it][dt] * rs * gm;
            u32x2 w; w.x = cvt_pk_bf16(v[0], v[1]); w.y = cvt_pk_bf16(v[2], v[3]);
            *(u32x2*)(CAT + (size_t)(r0 + it * 16 + fr) * D + 512 + col) = w; }
    }
    __syncthreads();
}

template <bool TO_BF16>
__device__ void ln_rows(const float* Z, const float* gam, const float* bet, bf16_t* Hb, float* Y) {
    const int lane = threadIdx.x & 63, gw = blockIdx.x * 8 + (threadIdx.x >> 6), nw = gridDim.x * 8;
    f32x4 g[4], be[4];
#pragma unroll
    for (int i = 0; i < 4; ++i) { g[i] = *(const f32x4*)(gam + i * 256 + lane * 4); be[i] = *(const f32x4*)(bet + i * 256 + lane * 4); }
    for (int row = gw; row < M; row += nw) {
        const float* z = Z + (size_t)row * D; f32x4 v[4]; float s = 0.f;
#pragma unroll
        for (int i = 0; i < 4; ++i) { v[i] = *(const f32x4*)(z + i * 256 + lane * 4); s += (v[i][0] + v[i][1]) + (v[i][2] + v[i][3]); }
#pragma unroll
        for (int o = 1; o < 64; o <<= 1) s += __shfl_xor(s, o);
        const float mean = s * (1.0f / 1024.0f); float q = 0.f;
#pragma unroll
        for (int i = 0; i < 4; ++i) { v[i] = v[i] - mean; q += (v[i][0] * v[i][0] + v[i][1] * v[i][1]) + (v[i][2] * v[i][2] + v[i][3] * v[i][3]); }
#pragma unroll
        for (int o = 1; o < 64; o <<= 1) q += __shfl_xor(q, o);
        const float rstd = rsqrtf(q * (1.0f / 1024.0f) + LN_EPS);
#pragma unroll
        for (int i = 0; i < 4; ++i) { const f32x4 y = v[i] * rstd * g[i] + be[i];
            if (TO_BF16) { u32x2 w; w.x = cvt_pk_bf16(y[0], y[1]); w.y = cvt_pk_bf16(y[2], y[3]); *(u32x2*)(Hb + (size_t)row * D + i * 256 + lane * 4) = w; }
            else *(f32x4*)(Y + (size_t)row * D + i * 256 + lane * 4) = y; }
    }
}

__global__ void __launch_bounds__(NTHREADS, 2) fwd_mega(Params p) {
    extern __shared__ __attribute__((aligned(16))) unsigned char smem[];
    LAS unsigned char* lds = (LAS unsigned char*)smem;
    const int G = gridDim.x, bid = blockIdx.x;
    volatile LAS unsigned* xst = (volatile LAS unsigned*)(lds + LDS_BYTES - 16);
    if (threadIdx.x == 0) { xst[0] = 0u; xst[1] = 0u; }
    __syncthreads();
    XcdBarrier xb = xcd_barrier_post((unsigned*)(p.ws + WS_BAR) + (NBAR > 1 ? p.pad * 4096 : 0), xst);
#define IN(ph) (p.ph_lo <= (ph) && (ph) < p.ph_hi)
#define REP(ph) for (int _r = 0; _r < ((ph) == PROBE_PH ? 3 : 1); ++_r)
#define SYNC(ph) do { if (p.coop && IN(ph) && IN((ph) + 1)) xcd_barrier(xb); } while (0)
    if (IN(0)) REP(0) prologue(p, lds);
    SYNC(0);
    if (IN(1)) { pg8::Gemm g{(const bf16_t*)(p.ws + WS_XB), (const bf16_t*)(p.ws + WS_W1), M, D_IN, D}; pg8::StaticOrder S; S.init(M, D_IN, D, G, bid);
        EpiProj E{(bf16_t*)(p.ws + WS_H), (const float*)(p.ws + WS_ROPE), p.out}; pg8::gemm_phase(lds, g, S, E); }
    SYNC(1);
    if (IN(2)) {
        if (G == 256) {
            for (int k = 0; k < 3; ++k) {
                int u = -1;
                if (k == 0) u = bid;
                else if (k == 1) u = bid < 32 ? 256 + bid : (bid < 160 ? 288 + (bid - 32) : 288 + 128 + (bid - 160));
                else if (bid >= 160 && bid < 224) u = 288 + 224 + (bid - 160);
                if (u < 0) break;
                if (u < 288) attn_unit(p, lds, u); else gate_unit(p, lds, u - 288);
            }
            int t0 = 0, tn = 0;
            if (bid < 32) { t0 = bid * 9; tn = 9; } else if (bid < 160) { t0 = 288 + (bid - 32) * 8; tn = 8; } else if (bid >= 224) { t0 = 1312 + (bid - 224) * 11; tn = 11; }
            if (tn) late_transposes(p, lds, t0, 1, 0, t0 + tn);
        } }
    SYNC(2);
    if (IN(3)) { for (int rep = 0; rep < (PROBE_PH == 3 ? 3 : 1); ++rep) { if (rep) xcd_barrier(xb);
        pg8::Gemm g{(const bf16_t*)(p.ws + WS_CAT), (const bf16_t*)(p.ws + WS_W2), M, D, D}; pg8::TeamOrder S; S.init(D, bid, P3_STREAMK);
        EpiLn<1> E{(PROBE_PH == 10 ? p.pad * 2 : 0) + rep}; pg8::gemm_phase(lds, g, S, E); } }
    SYNC(3);
    if (IN(4)) REP(5) { pg8::Gemm g{(const bf16_t*)(p.ws + WS_HB), (const bf16_t*)(p.ws + WS_W3), M, 2 * D_FF, D}; pg8::StaticOrder S; S.init(M, 2 * D_FF, D, G, bid);
        EpiSwiglu E{(bf16_t*)(p.ws + WS_ACT)}; pg8::gemm_phase(lds, g, S, E);
        if (G == 256 && bid >= 48) late_transposes(p, lds, bid - 48, 208, 1, 1 << 30); }
    SYNC(4);
    if (IN(5)) { for (int rep = 0; rep < (PROBE_PH == 6 ? 3 : 1); ++rep) { if (rep) xcd_barrier(xb);
        pg8::Gemm g{(const bf16_t*)(p.ws + WS_ACT), (const bf16_t*)(p.ws + WS_W4), M, D, D_FF}; pg8::TeamOrder S; S.init(D_FF, bid, 1);
        EpiLn<2> E{(PROBE_PH == 10 ? p.pad * 2 + 1 : (PROBE_PH == 3 || PROBE_PH == 6) ? 3 : 1) + rep}; pg8::gemm_phase(lds, g, S, E); } }
#undef IN
#undef SYNC
}

#undef REP
#ifndef N_LAUNCHES
#define N_LAUNCHES 1
#endif
extern "C" void kernel_launch(void* const* d_in, const int* in_sizes, int n_in, void* d_out, int out_size, void* d_ws, size_t ws_size, hipStream_t stream) {
    static int grid = 0;
    if (grid == 0) {
        int dev = 0, cus = 0, per_cu = 0;
        hipGetDevice(&dev); hipDeviceGetAttribute(&cus, hipDeviceAttributeMultiprocessorCount, dev);
        if (hipFuncSetAttribute((const void*)fwd_mega, hipFuncAttributeMaxDynamicSharedMemorySize, LDS_BYTES) != hipSuccess) { fprintf(stderr, "hipFuncSetAttribute failed\n"); grid = -1; return; }
        if (hipOccupancyMaxActiveBlocksPerMultiprocessor(&per_cu, (const void*)fwd_mega, NTHREADS, LDS_BYTES) != hipSuccess || per_cu < 1) { fprintf(stderr, "occupancy query: %d\n", per_cu); per_cu = 1; }
        (void)hipGetLastError();
        grid = cus * (per_cu > 1 ? 1 : per_cu);
        if (grid != 256) { fprintf(stderr, "this kernel needs a grid of exactly 256 workgroups (one per CU), got %d\n", grid); grid = -1; return; }
        if (ws_size < WS_END) { fprintf(stderr, "workspace too small: %zu < %zu\n", ws_size, WS_END); grid = -1; return; }
    }
    if (grid < 0) return;
    if (hipMemsetAsync((char*)d_ws + WS_BAR, 0, WS_ZERO_BYTES, stream) != hipSuccess) { fprintf(stderr, "memset failed\n"); return; }
    Params p{};
    p.x_prompt = (const float*)d_in[0]; p.x_sample = (const float*)d_in[1]; p.cache_k = (const float*)d_in[2]; p.cache_v = (const float*)d_in[3]; p.w_in = (const float*)d_in[4];
    p.ln_v_g = (const float*)d_in[5]; p.ln_v_b = (const float*)d_in[6]; p.sinks = (const float*)d_in[7]; p.w_sp = (const float*)d_in[8]; p.b_sp = (const float*)d_in[9];
    p.g_attn = (const float*)d_in[10]; p.g_cmlp = (const float*)d_in[11]; p.w_out = (const float*)d_in[12]; p.ln1_g = (const float*)d_in[13]; p.ln1_b = (const float*)d_in[14];
    p.w_gu = (const float*)d_in[15]; p.w_down = (const float*)d_in[16]; p.ln2_g = (const float*)d_in[17]; p.ln2_b = (const float*)d_in[18];
    p.out = (float*)d_out; p.ws = (unsigned char*)d_ws;
#if N_LAUNCHES == 1
    p.ph_lo = 0; p.ph_hi = 6; p.coop = 1;
    void* args[] = {&p};
    hipError_t e = hipLaunchCooperativeKernel((const void*)fwd_mega, dim3(grid), dim3(NTHREADS), args, LDS_BYTES, stream);
#if PROBE_PH == 10
    p.pad = 1; e = hipLaunchCooperativeKernel((const void*)fwd_mega, dim3(grid), dim3(NTHREADS), args, LDS_BYTES, stream);
#endif
    if (e != hipSuccess) fprintf(stderr, "cooperative launch failed: %s (grid %d)\n", hipGetErrorString(e), grid);
#else
    for (int ph = 0; ph < 6; ++ph) { p.ph_lo = ph; p.ph_hi = ph + 1; p.coop = 0;
        hipLaunchKernelGGL(fwd_mega, dim3(grid), dim3(NTHREADS), LDS_BYTES, stream, p); }
#endif
}
```

```cpp
#include <hip/hip_runtime.h>
#include <hip/hip_cooperative_groups.h>
#include <cstdio>
#include <cstdint>
namespace cg = cooperative_groups;

#define LAS __attribute__((address_space(3)))
typedef unsigned short bf16_t;
typedef short bf16x8 __attribute__((ext_vector_type(8)));
typedef short bf16x4 __attribute__((ext_vector_type(4)));
typedef float f32x4 __attribute__((ext_vector_type(4)));
typedef float f32x2 __attribute__((ext_vector_type(2)));
typedef unsigned u32x4 __attribute__((ext_vector_type(4)));
typedef unsigned u32x2 __attribute__((ext_vector_type(2)));

#ifndef GEMM_SP2
#define GEMM_SP2 1
#endif
#ifndef GEMM_ALIGN_EPI
#define GEMM_ALIGN_EPI 1
#endif
#ifndef P3_STREAMK
#define P3_STREAMK 1
#endif
#ifndef PROBE_PH
#define PROBE_PH -1
#endif
constexpr int D = 1024, SEQ = 2048, NB = 8, DEC_B = 32, DEC_L = 64, PAST = 1024;
constexpr int MP = NB * SEQ, MS = DEC_B * DEC_L, M = MP + MS;
constexpr int D_IN = 1792, D_FF = 2816;
constexpr int C_Q = 0, C_K = 512, C_V = 640, C_U = 768, C_VM = 1280;
constexpr float ALPHA = 1.189207115002721f;
constexpr float LN_EPS = 1e-5f;
constexpr size_t O_Y = 0, O_KP = (size_t)M * D, O_VP = O_KP + 131072, O_KS = O_VP + 131072, O_VS = O_KS + 262144, O_MS = O_VS + 262144;
constexpr size_t WS_XB = 0;
constexpr size_t WS_H = WS_XB + (size_t)M * D * 2;
constexpr size_t WS_ACT = 0;
constexpr size_t WS_W1 = (size_t)M * D_FF * 2;
constexpr size_t WS_W2 = WS_W1 + (size_t)D_IN * D * 2;
constexpr size_t WS_W3 = WS_W2 + (size_t)D * D * 2;
constexpr size_t WS_W4 = WS_W3 + (size_t)2 * D_FF * D * 2;
constexpr size_t WS_WS = WS_W4 + (size_t)D * D_FF * 2;
constexpr size_t WS_ROPE = WS_WS + (size_t)8 * 128 * 128 * 2;
constexpr size_t WS_CAT = WS_ROPE + (size_t)2048 * 16 * 4;
constexpr size_t WS_HB = WS_CAT + (size_t)M * D * 2;
constexpr size_t WS_BAR = WS_HB + (size_t)M * D * 2;
constexpr int NSETS = (PROBE_PH == 3 || PROBE_PH == 6 || PROBE_PH == 10) ? 6 : 2, NBAR = PROBE_PH == 10 ? 2 : 1;
constexpr size_t WS_CNT = WS_BAR + (size_t)NBAR * 16384;
constexpr size_t WS_FLG = WS_CNT + (size_t)NSETS * 72 * 256;
constexpr size_t WS_ZERO_BYTES = (size_t)NBAR * 16384 + (size_t)NSETS * 72 * 256 + (size_t)NSETS * 224 * 256;
constexpr size_t WS_XB1 = WS_FLG + (size_t)NSETS * 224 * 256;
constexpr size_t WS_XB2 = WS_XB1 + (size_t)M * 4 * 8;
constexpr size_t WS_SLAB = WS_XB2 + (size_t)M * 4 * 8;
constexpr size_t WS_END = WS_SLAB + (size_t)224 * 131072;
constexpr int LDS_BYTES = 147456;
constexpr int NTHREADS = 512;

struct Params {
    const float *x_prompt, *x_sample, *cache_k, *cache_v, *w_in, *ln_v_g, *ln_v_b, *sinks, *w_sp, *b_sp, *g_attn, *g_cmlp, *w_out, *ln1_g, *ln1_b, *w_gu, *w_down, *ln2_g, *ln2_b;
    float* out;
    unsigned char* ws;
    int ph_lo, ph_hi, coop, pad;
};

__device__ __forceinline__ unsigned cvt_pk_bf16(float lo, float hi) { unsigned r; asm volatile("v_cvt_pk_bf16_f32 %0, %1, %2" : "=v"(r) : "v"(lo), "v"(hi)); return r; }
__device__ __forceinline__ float bf2f(unsigned short b) { return __uint_as_float(((unsigned)b) << 16); }
__device__ __forceinline__ float bflo(unsigned w) { return __uint_as_float(w << 16); }
__device__ __forceinline__ float bfhi(unsigned w) { return __uint_as_float(w & 0xffff0000u); }
__device__ __forceinline__ float fast_sigmoid(float x) { return __builtin_amdgcn_rcpf(1.0f + __builtin_amdgcn_exp2f(-1.4426950408889634f * x)); }
__device__ __forceinline__ float gelu_tanh(float x) { const float u = 1.5957691216057308f * (x + 0.044715f * x * x * x); return x * fast_sigmoid(u); }
__device__ __forceinline__ float silu(float x) { return x * fast_sigmoid(x); }
__device__ __forceinline__ f32x2 silu_mul_pk(f32x2 g, f32x2 u) {
    const f32x2 m = g * (-1.4426950408889634f);
    f32x2 e; e.x = __builtin_amdgcn_exp2f(m.x); e.y = __builtin_amdgcn_exp2f(m.y);
    const f32x2 d = e + 1.0f;
    f32x2 r; r.x = __builtin_amdgcn_rcpf(d.x); r.y = __builtin_amdgcn_rcpf(d.y);
    return (g * r) * u;
}
__device__ __forceinline__ f32x2 gelu_tanh_pk(f32x2 x) {
    const f32x2 f = (x * x) * (-0.10294324f) + (-2.3022082f);
    const f32x2 w = x * f;
    f32x2 e; e.x = __builtin_amdgcn_exp2f(w.x); e.y = __builtin_amdgcn_exp2f(w.y);
    const f32x2 d = e + 1.0f;
    f32x2 r; r.x = __builtin_amdgcn_rcpf(d.x); r.y = __builtin_amdgcn_rcpf(d.y);
    return x * r;
}


#define XB_TMO      128
#define XB_XCNT(j)  (256  + 64 * (j))
#define XB_XSUB(j)  (1280 + 64 * (j))
#define XB_XGEN(j)  (2304 + 64 * (j))
#define XB_TOP      3328
#define XB_TOPGEN   3392
#define XCD_BAR_WORDS 3456
#define XB_SPIN_CAP (1u << 18)
__device__ __forceinline__ unsigned xb_ld(unsigned* p)              { return __hip_atomic_load(p, __ATOMIC_RELAXED, __HIP_MEMORY_SCOPE_AGENT); }
__device__ __forceinline__ unsigned xb_add(unsigned* p, unsigned v) { return __hip_atomic_fetch_add(p, v, __ATOMIC_RELAXED, __HIP_MEMORY_SCOPE_AGENT); }
__device__ __forceinline__ unsigned xb_xcc_id() { return (unsigned)__builtin_amdgcn_s_getreg((3 << 11) | 20) & 0xFu; }
#define XB_SPIN(cond, bar) do { unsigned _sp = 0; while (cond) { __builtin_amdgcn_s_sleep(1); \
    if ((++_sp & 255u) == 0u) { if (xb_ld(&(bar)[XB_TMO])) break; if (_sp > XB_SPIN_CAP) { atomicAdd(&(bar)[XB_TMO], 1u); break; } } } } while (0)
struct XcdBarrier { unsigned* bar; unsigned x; volatile LAS unsigned* st; };
__device__ __forceinline__ XcdBarrier xcd_barrier_post(unsigned* bar, volatile LAS unsigned* st) {
    XcdBarrier b; b.bar = bar; b.x = xb_xcc_id(); b.st = st;
    if (threadIdx.x == 0) (void)xb_add(&bar[XB_XCNT(b.x)], 1u);
    return b;
}
__device__ __forceinline__ void xcd_barrier_complete(unsigned* bar, unsigned x, unsigned& nloc, unsigned& nx) {
    const unsigned G = gridDim.x * gridDim.y * gridDim.z;
    unsigned sum, cnt, mine, sp = 0u;
    for (;;) {
        sum = 0u; cnt = 0u; mine = 0u;
#pragma unroll
        for (unsigned j = 0; j < 16; ++j) { const unsigned c = xb_ld(&bar[XB_XCNT(j)]); sum += c; cnt += (c > 0u) ? 1u : 0u; mine = (j == x) ? c : mine; }
        if (sum == G) break;
        __builtin_amdgcn_s_sleep(1);
        if ((++sp & 255u) == 0u) { if (xb_ld(&bar[XB_TMO])) break; if (sp > XB_SPIN_CAP) { atomicAdd(&bar[XB_TMO], 1u); break; } }
    }
    nloc = mine > 0u ? mine : 1u; nx = cnt > 0u ? cnt : 1u;
}
__device__ __forceinline__ void xcd_barrier(const XcdBarrier& b) {
    asm volatile("s_waitcnt vmcnt(0)" ::: "memory");
    __syncthreads();
    if (threadIdx.x == 0) {
        unsigned* bar = b.bar;
        __builtin_amdgcn_s_waitcnt(0);
        unsigned nloc = b.st[0], nx = b.st[1];
        if (nloc == 0u) { xcd_barrier_complete(bar, b.x, nloc, nx); b.st[0] = nloc; b.st[1] = nx; }
        const unsigned old = xb_add(&bar[XB_XSUB(b.x)], 1u);
        const unsigned gen = old / nloc;
        if (old + 1u == (gen + 1u) * nloc) {
            __builtin_amdgcn_fence(__ATOMIC_RELEASE, "agent");
            asm volatile("s_waitcnt vmcnt(0)" ::: "memory");
            const unsigned og = xb_add(&bar[XB_TOP], 1u);
            const unsigned tg = og / nx;
            if (og + 1u == (tg + 1u) * nx) xb_add(&bar[XB_TOPGEN], 1u);
            else XB_SPIN(xb_ld(&bar[XB_TOPGEN]) == tg, bar);
            __builtin_amdgcn_fence(__ATOMIC_ACQUIRE, "agent");
            xb_add(&bar[XB_XGEN(b.x)], 1u);
            asm volatile("s_waitcnt vmcnt(0)" ::: "memory");
        } else {
            __builtin_amdgcn_fence(__ATOMIC_ACQUIRE, "agent");
            XB_SPIN(xb_ld(&bar[XB_TOPGEN]) == gen, bar);
            asm volatile("s_waitcnt vmcnt(0)" ::: "memory");
        }
    }
    __syncthreads();
}

namespace pg8 {
constexpr int BM = 256, BK = 64, HALF = 128, HTB = HALF * BK * 2, STAGE_BYTES = 8 * HTB, NXCD = 8, WGM = 8;
__host__ __device__ __forceinline__ int lds_byte(int r, int c) { const int st = (r >> 4) * 2 + (c >> 5), rr = r & 15, cc = c & 31, ob = rr * 64 + cc * 2; return st * 1024 + (ob ^ (((ob >> 9) & 1) << 5)); }
__host__ __device__ __forceinline__ void stage_rc(int b, int& R, int& C) { const int st = b / 1024, sb = b % 1024, swz = sb ^ (((sb >> 9) & 1) << 5); R = (st >> 1) * 16 + swz / 64; C = (st & 1) * 32 + (swz % 64) / 2; }
__host__ __device__ __forceinline__ int perm32(int rho) { const int n = rho >> 4, i = rho & 15; return 8 * (i >> 2) + 4 * n + (i & 3); }
struct Unit { int pm, pn, k0, nt, kind, slot; };
struct Gemm { const bf16_t* A; const bf16_t* Bt; int M, N, K; };
struct StaticOrder {
    int nM, nN, nwg, G, c, ntile;
    __host__ __device__ void init(int M_, int N_, int K_, int G_, int c_) { nM = M_ / BM; nN = N_ / BM; nwg = nM * nN; G = G_; c = c_; ntile = K_ / BK; }
    __host__ __device__ bool next(int i, Unit& u) const {
        const long L = (long)i * G + c; if (L >= nwg) return false;
        int wgid = (int)L; { const int q = nwg / NXCD, r = nwg % NXCD, xcd = wgid % NXCD, off = wgid / NXCD; wgid = (xcd < r ? xcd * (q + 1) : r * (q + 1) + (xcd - r) * q) + off; }
        const int nig = WGM * nN, gid = wgid / nig, fm = gid * WGM, gsz = (nM - fm) < WGM ? (nM - fm) : WGM;
        u.pm = fm + ((wgid % nig) % gsz); u.pn = (wgid % nig) / gsz; u.k0 = 0; u.nt = ntile; u.kind = 0; u.slot = 0; return true;
    }
};

struct TeamOrder {
    int x, j, pn, npair, streamk;
    __host__ __device__ void init(int K_, int c_, int streamk_) { x = c_ & 7; const int l = c_ >> 3; j = l >> 2; pn = l & 3; npair = K_ / (2 * BK); streamk = streamk_; }
    __host__ __device__ bool next(int i, Unit& u) const {
        if (!streamk) { const int q = i * 8 + j; if (q >= 9) return false; u.pm = 9 * x + q; u.pn = pn; u.k0 = 0; u.nt = 2 * npair; u.kind = 0; u.slot = 0; return true; }
        const int total = 9 * npair, R1 = ((j + 1) * total) / 8; int p = (j * total) / 8;
        for (int ii = 0; ; ++ii) {
            if (p >= R1) return false;
            const int panel = p / npair, off = p - panel * npair, tend = (panel + 1) * npair, end = R1 < tend ? R1 : tend;
            if (ii == i) { u.pm = 9 * x + panel; u.pn = pn; u.k0 = off * 2; u.nt = (end - p) * 2; u.kind = off > 0 ? 1 : (end < tend ? 2 : 0);
                u.slot = x * 28 + (u.kind == 1 ? j - 1 : j) * 4 + pn; return true; }
            p = end;
        }
    }
};
template <class Epi, class Sched>
__device__ __forceinline__ void gemm_phase(LAS unsigned char* lds, const Gemm g, const Sched& S, const Epi& E) {
    const int tid = threadIdx.x, wid = __builtin_amdgcn_readfirstlane(tid >> 6), lane = tid & 63, wr = wid >> 2, wc = wid & 3, fr = lane & 15, fq = lane >> 4;
    const int K = g.K;
    unsigned voffA[2], voffB[2];
#pragma unroll
    for (int i = 0; i < 2; ++i) { int R, C; stage_rc(tid * 16 + i * 8192, R, C); const int Rb = (R & ~31) + perm32(R & 31);
        voffA[i] = (unsigned)(R * K + C) * 2u; voffB[i] = (unsigned)(Rb * K + C) * 2u; }
    const size_t kstep = (size_t)(BK * 2);
    const size_t hstep = (size_t)HALF * K * 2;
    const size_t tstep = 2 * hstep;
    const unsigned ldsw = (unsigned)wid * 1024u;
    const int aoff = lds_byte(wr * 64 + fr, fq * 8), boff = lds_byte(wc * 32 + fr, fq * 8);
#define PG8_SA(b, h) (((b) * 2 + (h)) * HTB)
#define PG8_SB(b, h) ((4 + (b) * 2 + (h)) * HTB)
#define PG8_STAGE(bufoff, gbase, voff) do { _Pragma("unroll") for (int _i = 0; _i < 2; ++_i) \
        __builtin_amdgcn_global_load_lds((const unsigned*)((const char*)(gbase) + (voff)[_i]), (LAS unsigned*)(lds + (bufoff) + ldsw + _i * 8192), 16, 0, 0); } while (0)
#define PG8_LDA(dst, b, h) do { _Pragma("unroll") for (int m = 0; m < 4; ++m) _Pragma("unroll") for (int k = 0; k < 2; ++k) dst[m][k] = *(const LAS bf16x8*)(lds + PG8_SA(b, h) + aoff + m * 2048 + k * 1024); } while (0)
#define PG8_LDB(dst, b, h) do { _Pragma("unroll") for (int n = 0; n < 2; ++n) _Pragma("unroll") for (int k = 0; k < 2; ++k) dst[n][k] = *(const LAS bf16x8*)(lds + PG8_SB(b, h) + boff + n * 2048 + k * 1024); } while (0)
#define PG8_MMA(ai, bj, At, Bt) do { __builtin_amdgcn_s_setprio(1); _Pragma("unroll") for (int m = 0; m < 4; ++m) _Pragma("unroll") for (int n = 0; n < 2; ++n) _Pragma("unroll") for (int k = 0; k < 2; ++k) \
        acc[ai][bj][m][n] = __builtin_amdgcn_mfma_f32_16x16x32_bf16(Bt[n][k], At[m][k], acc[ai][bj][m][n], 0, 0, 0); __builtin_amdgcn_s_setprio(0); } while (0)
#define PG8_WAIT_V(n) asm volatile("s_waitcnt vmcnt(" #n ")" ::: "memory")
#define PG8_WAIT_L(n) asm volatile("s_waitcnt lgkmcnt(" #n ")" ::: "memory")
#define PG8_BAR __builtin_amdgcn_s_barrier()
#define PG8_SCHED __builtin_amdgcn_sched_barrier(0)
    Unit cur, nxt; int ui = 0;
    if (!S.next(0, cur)) return;
    f32x4 acc[2][2][4][2];
    if constexpr (Epi::FUSED) E.init(acc, cur, wid, lane);
    else {
#pragma unroll
    for (int a = 0; a < 2; ++a)
#pragma unroll
        for (int b = 0; b < 2; ++b)
#pragma unroll
            for (int m = 0; m < 4; ++m)
#pragma unroll
                for (int n = 0; n < 2; ++n) acc[a][b][m][n] = (f32x4){0.f, 0.f, 0.f, 0.f};
    }
    bf16x8 At[4][2], B0[2][2], B1[2][2];
    const char* cA = (const char*)g.A + (size_t)cur.pm * tstep + (size_t)cur.k0 * kstep; const char* cB = (const char*)g.Bt + (size_t)cur.pn * tstep + (size_t)cur.k0 * kstep;
#if GEMM_SP2
    PG8_STAGE(PG8_SB(0, 0), cB, voffB); PG8_STAGE(PG8_SB(0, 1), cB + hstep, voffB); PG8_STAGE(PG8_SA(0, 0), cA, voffA); PG8_STAGE(PG8_SA(0, 1), cA + hstep, voffA);
    if (wr == 1) PG8_BAR;
    PG8_WAIT_V(2); PG8_BAR;
    PG8_STAGE(PG8_SB(1, 0), cB + kstep, voffB); PG8_STAGE(PG8_SA(1, 0), cA + kstep, voffA); PG8_STAGE(PG8_SB(1, 1), cB + hstep + kstep, voffB);
    PG8_WAIT_V(6); PG8_BAR;
#else
    PG8_STAGE(PG8_SB(0, 0), cB, voffB); PG8_STAGE(PG8_SA(0, 0), cA, voffA); PG8_STAGE(PG8_SB(0, 1), cB + hstep, voffB); PG8_STAGE(PG8_SA(0, 1), cA + hstep, voffA);
    if (wr == 1) PG8_BAR;
    PG8_WAIT_V(4); PG8_BAR;
    PG8_STAGE(PG8_SB(1, 0), cB + kstep, voffB); PG8_STAGE(PG8_SA(1, 0), cA + kstep, voffA); PG8_STAGE(PG8_SB(1, 1), cB + hstep + kstep, voffB);
    PG8_WAIT_V(6); PG8_BAR;
#endif
    for (;;) {
        const bool has_next = S.next(ui + 1, nxt);
        const char* nA = has_next ? (const char*)g.A + (size_t)nxt.pm * tstep + (size_t)nxt.k0 * kstep : cA; const char* nB = has_next ? (const char*)g.Bt + (size_t)nxt.pn * tstep + (size_t)nxt.k0 * kstep : cB;
        const int nt = cur.nt;
        for (int t = 0; t < nt; t += 2) {
            const bool last = (t == nt - 2);
            const char* a1 = cA + (size_t)(t + 1) * kstep;
            const char* a2 = last ? nA : cA + (size_t)(t + 2) * kstep; const char* b2 = last ? nB : cB + (size_t)(t + 2) * kstep;
            const char* a3 = a2 + kstep; const char* b3 = b2 + kstep;
#if GEMM_SP2
            PG8_LDB(B0, 0, 0); PG8_LDB(B1, 0, 1); PG8_SCHED; PG8_LDA(At, 0, 0); PG8_STAGE(PG8_SA(1, 1), a1 + hstep, voffA);
            PG8_WAIT_V(8); PG8_WAIT_L(0); PG8_BAR; PG8_MMA(0, 0, At, B0); PG8_MMA(0, 1, At, B1); PG8_BAR; PG8_SCHED;
            PG8_LDA(At, 0, 1); PG8_STAGE(PG8_SB(0, 0), b2, voffB); PG8_STAGE(PG8_SB(0, 1), b2 + hstep, voffB); PG8_STAGE(PG8_SA(0, 0), a2, voffA);
            PG8_WAIT_V(8); PG8_WAIT_L(0); PG8_BAR; PG8_MMA(1, 0, At, B0); PG8_MMA(1, 1, At, B1); PG8_BAR; PG8_SCHED;
            PG8_LDB(B0, 1, 0); PG8_LDB(B1, 1, 1); PG8_SCHED; PG8_LDA(At, 1, 0); PG8_STAGE(PG8_SA(0, 1), a2 + hstep, voffA);
            PG8_WAIT_V(8); PG8_WAIT_L(0); PG8_BAR; PG8_MMA(0, 0, At, B0); PG8_MMA(0, 1, At, B1); PG8_BAR; PG8_SCHED;
            PG8_LDA(At, 1, 1); PG8_STAGE(PG8_SB(1, 0), b3, voffB); PG8_STAGE(PG8_SB(1, 1), b3 + hstep, voffB); PG8_STAGE(PG8_SA(1, 0), a3, voffA);
            PG8_WAIT_V(8); PG8_WAIT_L(0); PG8_BAR; PG8_MMA(1, 0, At, B0); PG8_MMA(1, 1, At, B1); PG8_BAR; PG8_SCHED;
#else
            PG8_LDB(B0, 0, 0); PG8_SCHED; PG8_LDA(At, 0, 0); PG8_STAGE(PG8_SA(1, 1), a1 + hstep, voffA);
            PG8_WAIT_L(8); PG8_BAR; PG8_WAIT_L(0); PG8_MMA(0, 0, At, B0); PG8_BAR; PG8_SCHED;
            PG8_LDB(B1, 0, 1); PG8_STAGE(PG8_SB(0, 0), b2, voffB);
            PG8_BAR; PG8_WAIT_L(0); PG8_MMA(0, 1, At, B1); PG8_BAR;
            PG8_LDA(At, 0, 1); PG8_STAGE(PG8_SA(0, 0), a2, voffA);
            PG8_BAR; PG8_WAIT_L(0); PG8_MMA(1, 0, At, B0); PG8_BAR; PG8_SCHED;
            PG8_STAGE(PG8_SB(0, 1), b2 + hstep, voffB);
            PG8_WAIT_V(6); PG8_BAR; PG8_MMA(1, 1, At, B1); PG8_BAR;
            PG8_LDB(B0, 1, 0); PG8_SCHED; PG8_LDA(At, 1, 0); PG8_STAGE(PG8_SA(0, 1), a2 + hstep, voffA);
            PG8_WAIT_L(8); PG8_BAR; PG8_WAIT_L(0); PG8_MMA(0, 0, At, B0); PG8_BAR; PG8_SCHED;
            PG8_LDB(B1, 1, 1); PG8_STAGE(PG8_SB(1, 0), b3, voffB);
            PG8_BAR; PG8_WAIT_L(0); PG8_MMA(0, 1, At, B1); PG8_BAR;
            PG8_LDA(At, 1, 1); PG8_STAGE(PG8_SA(1, 0), a3, voffA);
            PG8_BAR; PG8_WAIT_L(0); PG8_MMA(1, 0, At, B0); PG8_BAR; PG8_SCHED;
            PG8_STAGE(PG8_SB(1, 1), b3 + hstep, voffB);
            PG8_WAIT_V(6); PG8_BAR; PG8_MMA(1, 1, At, B1); PG8_BAR;
#endif
        }
        if constexpr (Epi::FUSED) {
            if (wr == 0) PG8_BAR;
            E.fused(acc, cur, wr, wc, fr, fq, lds + STAGE_BYTES, wid, lane);
            if (wr == 1) PG8_BAR;
        } else {
#if GEMM_ALIGN_EPI
            if (wr == 0) PG8_BAR;
            E(acc, cur, wr, wc, fr, fq);
            if (wr == 1) PG8_BAR;
#else
            E(acc, cur, wr, wc, fr, fq);
#endif
        }
        if (!has_next) break;
        if constexpr (Epi::FUSED) E.init(acc, nxt, wid, lane);
        else {
#pragma unroll
        for (int a = 0; a < 2; ++a)
#pragma unroll
            for (int b = 0; b < 2; ++b)
#pragma unroll
                for (int m = 0; m < 4; ++m)
#pragma unroll
                    for (int n = 0; n < 2; ++n) acc[a][b][m][n] = (f32x4){0.f, 0.f, 0.f, 0.f};
        }
        cur = nxt; cA = nA; cB = nB; ++ui;
    }
    PG8_WAIT_V(0);
    if (wr == 0) PG8_BAR;
    PG8_BAR;
#undef PG8_SA
#undef PG8_SB
#undef PG8_STAGE
#undef PG8_LDA
#undef PG8_LDB
#undef PG8_MMA
#undef PG8_WAIT_V
#undef PG8_WAIT_L
#undef PG8_BAR
#undef PG8_SCHED
}
}
using pg8::Unit;
typedef f32x4 Acc[2][2][4][2];


struct EpiProj {
    static constexpr bool FUSED = false;
    bf16_t* H; const float* rope; float* out;
    __device__ __forceinline__ void operator()(const Acc& acc, const Unit& u, int wr, int wc, int fr, int fq) const {
        const int pn = u.pn;
#pragma unroll
        for (int ai = 0; ai < 2; ++ai)
#pragma unroll
            for (int m = 0; m < 4; ++m) {
                const int row = u.pm * 256 + ai * 128 + wr * 64 + m * 16 + fr;
                const int pos = row < MP ? (row & (SEQ - 1)) : PAST + ((row - MP) & (DEC_L - 1));
                bf16_t* rowp = H + (size_t)row * D_IN + pn * 256 + wc * 32 + 8 * fq;
#pragma unroll
                for (int bj = 0; bj < 2; ++bj) {
                    f32x4 v0 = acc[ai][bj][m][0], v1 = acc[ai][bj][m][1];
                    if (pn >= 3) {
#pragma unroll
                        for (int j = 0; j < 4; j += 2) { const f32x2 a = gelu_tanh_pk((f32x2){v0[j], v0[j + 1]}), b = gelu_tanh_pk((f32x2){v1[j], v1[j + 1]}); v0[j] = a.x; v0[j + 1] = a.y; v1[j] = b.x; v1[j + 1] = b.y; }
                    } else {
                        const bool is_v = (pn == 2 && bj == 1);
                        if (!is_v) {
                            f32x4 p0, p1;
#pragma unroll
                            for (int j = 0; j < 4; ++j) { p0[j] = __shfl_xor(v0[j], 16); p1[j] = __shfl_xor(v1[j], 16); }
                            if ((wc & 1) == 0 && fq < 2) {
                                const f32x4 c0 = *(const f32x4*)(rope + pos * 16), c1 = *(const f32x4*)(rope + pos * 16 + 4), s0 = *(const f32x4*)(rope + pos * 16 + 8), s1 = *(const f32x4*)(rope + pos * 16 + 12);
                                if (fq == 0) { v0 = v0 * c0 - p0 * s0; v1 = v1 * c1 - p1 * s1; }
                                else         { v0 = v0 * c0 + p0 * s0; v1 = v1 * c1 + p1 * s1; }
                            }
                        }
                        if (pn == 2) {
                            const int c = wc * 32 + 8 * fq;
                            float* o = nullptr;
                            if (row >= MP) o = out + (bj ? O_VS : O_KS) + (size_t)(row - MP) * 128 + c;
                            else if ((row & (SEQ - 1)) >= SEQ - 128) o = out + (bj ? O_VP : O_KP) + ((size_t)(row >> 11) * 128 + ((row & (SEQ - 1)) - (SEQ - 128))) * 128 + c;
                            if (o) { *(f32x4*)o = v0; *(f32x4*)(o + 4) = v1; }
                        } else { v0 = v0 * 0.18033688011112042f; v1 = v1 * 0.18033688011112042f; }
                    }
                    u32x4 w; w.x = cvt_pk_bf16(v0[0], v0[1]); w.y = cvt_pk_bf16(v0[2], v0[3]); w.z = cvt_pk_bf16(v1[0], v1[1]); w.w = cvt_pk_bf16(v1[2], v1[3]);
                    *(u32x4*)(rowp + bj * 128) = w;
                }
            }
    }
};
template <int WHICH> struct EpiLn {
    static constexpr bool FUSED = true;
    int set;
    __device__ __forceinline__ void init(Acc& acc, const Unit& u, int wid_, int lane_) const {
        int lane = lane_, wid = wid_; asm volatile("" : "+v"(lane)); asm volatile("" : "+s"(wid));
        const int fr = lane & 15, fq = lane >> 4, wr = wid >> 2, wc = wid & 3, tid = wid * 64 + lane;
        typedef const Params __attribute__((address_space(4)))* KP;
        KP pp = (KP)__builtin_amdgcn_kernarg_segment_ptr(); asm volatile("" : "+s"(pp));
        unsigned char* ws = pp->ws;
        if (u.kind == 2) {
            unsigned* flg = (unsigned*)(ws + WS_FLG) + set * 224 * 64;
            unsigned sp = 0;
            while ((unsigned)__builtin_amdgcn_readfirstlane(__hip_atomic_load(flg + 64 * u.slot, __ATOMIC_RELAXED, __HIP_MEMORY_SCOPE_AGENT)) < 8u) { __builtin_amdgcn_s_sleep(2); if (++sp > (1u << 22)) break; }
            asm volatile("" ::: "memory");
            const unsigned long long* sl = (const unsigned long long*)(ws + WS_SLAB) + (size_t)u.slot * 16384 + (size_t)tid;
#pragma unroll
            for (int ai = 0; ai < 2; ++ai)
#pragma unroll
                for (int bj = 0; bj < 2; ++bj)
#pragma unroll
                    for (int m = 0; m < 4; ++m)
#pragma unroll
                        for (int n = 0; n < 2; ++n) {
                            const unsigned long long a = __hip_atomic_load(sl, __ATOMIC_RELAXED, __HIP_MEMORY_SCOPE_AGENT);
                            sl += 512; asm volatile("" : "+v"(sl));
                            const unsigned lo = (unsigned)a, hi = (unsigned)(a >> 32);
                            acc[ai][bj][m][n] = (f32x4){bflo(lo), bfhi(lo), bflo(hi), bfhi(hi)}; }
            return;
        }
        const int rbase = u.pm * 256, col0 = u.pn * 256 + wc * 32 + 8 * fq;
#pragma unroll
        for (int ai = 0; ai < 2; ++ai)
#pragma unroll
            for (int m = 0; m < 4; ++m) { const int rl = ai * 128 + wr * 64 + m * 16 + fr;
#pragma unroll
                for (int bj = 0; bj < 2; ++bj) {
                    { const u32x4 h = *(const u32x4*)((const bf16_t*)(ws + (WHICH == 1 ? WS_XB : WS_HB)) + (size_t)(rbase + rl) * D + col0 + bj * 128);
                        acc[ai][bj][m][0] = (f32x4){bflo(h.x), bfhi(h.x), bflo(h.y), bfhi(h.y)} * ALPHA; acc[ai][bj][m][1] = (f32x4){bflo(h.z), bfhi(h.z), bflo(h.w), bfhi(h.w)} * ALPHA; } } }
    }
    __device__ __forceinline__ void fused(const Acc& acc, const Unit& u, int wr_, int wc_, int fr_, int fq_, LAS unsigned char* lx, int wid_, int lane_) const {
        int lane = lane_, wid = wid_; asm volatile("" : "+v"(lane)); asm volatile("" : "+s"(wid));
        const int fr = lane & 15, fq = lane >> 4, wr = wid >> 2, wc = wid & 3, tid = wid * 64 + lane;
        typedef const Params __attribute__((address_space(4)))* KP;
        KP pp = (KP)__builtin_amdgcn_kernarg_segment_ptr(); asm volatile("" : "+s"(pp));
        unsigned char* ws = pp->ws;
        if (u.kind == 1) {
            unsigned* flg = (unsigned*)(ws + WS_FLG) + set * 224 * 64;
            unsigned long long* sl = (unsigned long long*)(ws + WS_SLAB) + (size_t)u.slot * 16384 + (size_t)tid;
#pragma unroll
            for (int ai = 0; ai < 2; ++ai)
#pragma unroll
                for (int bj = 0; bj < 2; ++bj)
#pragma unroll
                    for (int m = 0; m < 4; ++m)
#pragma unroll
                        for (int n = 0; n < 2; ++n) { const f32x4 v = acc[ai][bj][m][n];
                            __hip_atomic_store(sl, ((unsigned long long)cvt_pk_bf16(v[2], v[3]) << 32) | cvt_pk_bf16(v[0], v[1]), __ATOMIC_RELAXED, __HIP_MEMORY_SCOPE_AGENT);
                            sl += 512; asm volatile("" : "+v"(sl)); }
            asm volatile("s_waitcnt vmcnt(0)" ::: "memory");
            if (lane == 0) __hip_atomic_fetch_add(flg + 64 * u.slot, 1u, __ATOMIC_RELAXED, __HIP_MEMORY_SCOPE_AGENT);
            return;
        }
        bf16_t* Hout = (bf16_t*)(ws + WS_HB); float* Y = pp->out + O_Y;
        const float* gam = WHICH == 1 ? pp->ln1_g : pp->ln2_g; const float* bet = WHICH == 1 ? pp->ln1_b : pp->ln2_b;
        unsigned long long* xbuf = (unsigned long long*)(ws + (WHICH == 1 ? WS_XB1 : WS_XB2)); unsigned* cnt = (unsigned*)(ws + WS_CNT) + set * 72 * 64;
        const int rbase = u.pm * 256, col0 = u.pn * 256 + wc * 32 + 8 * fq;
        LAS f32x2* P = (LAS f32x2*)lx;
        LAS f32x2* S = (LAS f32x2*)(lx + 8192);
#pragma unroll
        for (int ai = 0; ai < 2; ++ai)
#pragma unroll
            for (int m = 0; m < 4; ++m) {
                float s = 0.f;
#pragma unroll
                for (int bj = 0; bj < 2; ++bj)
#pragma unroll
                    for (int n = 0; n < 2; ++n) { const f32x4 x = acc[ai][bj][m][n]; s += (x[0] + x[1]) + (x[2] + x[3]); }
                s += __shfl_xor(s, 16); s += __shfl_xor(s, 32);
                const float mw = s * (1.0f / 64.0f); float q = 0.f;
#pragma unroll
                for (int bj = 0; bj < 2; ++bj)
#pragma unroll
                    for (int n = 0; n < 2; ++n) { const f32x4 d = acc[ai][bj][m][n] - mw; q += (d[0] * d[0] + d[1] * d[1]) + (d[2] * d[2] + d[3] * d[3]); }
                q += __shfl_xor(q, 16); q += __shfl_xor(q, 32);
                if (fq == 0) P[(ai * 128 + wr * 64 + m * 16 + fr) * 4 + wc] = (f32x2){mw, q};
            }
        asm volatile("s_waitcnt lgkmcnt(0)" ::: "memory"); __builtin_amdgcn_s_barrier(); asm volatile("" ::: "memory");
        const int row = wid * 32 + (lane & 31);
        if (lane < 32) {
            const f32x2 a = P[row * 4 + 0], b = P[row * 4 + 1], c = P[row * 4 + 2], d = P[row * 4 + 3];
            const float mt = (a.x + b.x + c.x + d.x) * 0.25f;
            const float da = a.x - mt, db = b.x - mt, dc = c.x - mt, dd = d.x - mt;
            const float m2 = (a.y + b.y) + (c.y + d.y) + 64.0f * ((da * da + db * db) + (dc * dc + dd * dd));
            __hip_atomic_store(xbuf + ((size_t)(rbase + row) * 4 + u.pn), ((unsigned long long)__float_as_uint(m2) << 32) | __float_as_uint(mt), __ATOMIC_RELAXED, __HIP_MEMORY_SCOPE_AGENT);
        }
        asm volatile("s_waitcnt vmcnt(0)" ::: "memory");
        if (lane == 0) __hip_atomic_fetch_add(cnt + 64 * u.pm, 1u, __ATOMIC_RELAXED, __HIP_MEMORY_SCOPE_AGENT);
        if (wid == 0) { unsigned sp = 0;
            while ((unsigned)__builtin_amdgcn_readfirstlane(__hip_atomic_load(cnt + 64 * u.pm, __ATOMIC_RELAXED, __HIP_MEMORY_SCOPE_AGENT)) < 32u) { __builtin_amdgcn_s_sleep(2); if (++sp > (1u << 22)) break; }
            asm volatile("" ::: "memory"); }
        asm volatile("s_waitcnt vmcnt(0) lgkmcnt(0)" ::: "memory"); __builtin_amdgcn_s_barrier(); asm volatile("" ::: "memory");
        if (lane < 32) {
            const unsigned long long* slot = xbuf + (size_t)(rbase + row) * 4; float mt[4], m2[4]; float ms = 0.f;
#pragma unroll
            for (int t = 0; t < 4; ++t) { const unsigned long long w = __hip_atomic_load(slot + t, __ATOMIC_RELAXED, __HIP_MEMORY_SCOPE_AGENT); mt[t] = __uint_as_float((unsigned)w); m2[t] = __uint_as_float((unsigned)(w >> 32)); ms += mt[t]; }
            const float mean = ms * 0.25f; float q = 0.f;
#pragma unroll
            for (int t = 0; t < 4; ++t) { const float dm = mt[t] - mean; q += m2[t] + 256.0f * dm * dm; }
            S[row] = (f32x2){mean, rsqrtf(q * (1.0f / 1024.0f) + LN_EPS)};
        }
        asm volatile("s_waitcnt lgkmcnt(0)" ::: "memory"); __builtin_amdgcn_s_barrier(); asm volatile("" ::: "memory");
        f32x4 g0[2], g1[2], b0[2], b1[2];
#pragma unroll
        for (int bj = 0; bj < 2; ++bj) { g0[bj] = *(const f32x4*)(gam + col0 + bj * 128); g1[bj] = *(const f32x4*)(gam + col0 + bj * 128 + 4); b0[bj] = *(const f32x4*)(bet + col0 + bj * 128); b1[bj] = *(const f32x4*)(bet + col0 + bj * 128 + 4); }
#pragma unroll
        for (int ai = 0; ai < 2; ++ai)
#pragma unroll
            for (int m = 0; m < 4; ++m) { const int rl = ai * 128 + wr * 64 + m * 16 + fr; const f32x2 st = S[rl];
#pragma unroll
                for (int bj = 0; bj < 2; ++bj) { const f32x4 y0 = (acc[ai][bj][m][0] - st.x) * st.y * g0[bj] + b0[bj], y1 = (acc[ai][bj][m][1] - st.x) * st.y * g1[bj] + b1[bj];
                    if (WHICH == 1) { u32x4 w; w.x = cvt_pk_bf16(y0[0], y0[1]); w.y = cvt_pk_bf16(y0[2], y0[3]); w.z = cvt_pk_bf16(y1[0], y1[1]); w.w = cvt_pk_bf16(y1[2], y1[3]);
                        *(u32x4*)(Hout + (size_t)(rbase + rl) * D + col0 + bj * 128) = w; }
                    else { float* yr = Y + (size_t)(rbase + rl) * D + col0 + bj * 128; __builtin_nontemporal_store(y0, (f32x4*)yr); __builtin_nontemporal_store(y1, (f32x4*)(yr + 4)); } } }
        asm volatile("s_waitcnt lgkmcnt(0)" ::: "memory"); __builtin_amdgcn_s_barrier(); asm volatile("" ::: "memory");
    }
};
struct EpiSwiglu {
    static constexpr bool FUSED = false;
    bf16_t* ACT;
    __device__ __forceinline__ void operator()(const Acc& acc, const Unit& u, int wr, int wc, int fr, int fq) const {
        const int col0 = u.pn * 128 + wc * 32 + 8 * fq;
#pragma unroll
        for (int ai = 0; ai < 2; ++ai)
#pragma unroll
            for (int m = 0; m < 4; ++m) { const int row = u.pm * 256 + ai * 128 + wr * 64 + m * 16 + fr;
                f32x4 a0 = acc[ai][0][m][0], a1 = acc[ai][0][m][1]; const f32x4 b0 = acc[ai][1][m][0], b1 = acc[ai][1][m][1];
#pragma unroll
                for (int j = 0; j < 4; j += 2) { const f32x2 p0 = silu_mul_pk((f32x2){a0[j], a0[j + 1]}, (f32x2){b0[j], b0[j + 1]}), p1 = silu_mul_pk((f32x2){a1[j], a1[j + 1]}, (f32x2){b1[j], b1[j + 1]});
                    a0[j] = p0.x; a0[j + 1] = p0.y; a1[j] = p1.x; a1[j + 1] = p1.y; }
                u32x4 w; w.x = cvt_pk_bf16(a0[0], a0[1]); w.y = cvt_pk_bf16(a0[2], a0[3]); w.z = cvt_pk_bf16(a1[0], a1[1]); w.w = cvt_pk_bf16(a1[2], a1[3]);
                *(u32x4*)(ACT + (size_t)row * D_FF + col0) = w; }
    }
};

struct TileDesc { const float* W; bf16_t* Bt; int K, N, tk, tn, mode; };
__device__ __forceinline__ void tile_load(const TileDesc& d, f32x4& v0, f32x4& v1) {
    const int t = threadIdx.x, r = t >> 4, c4 = (t & 15) * 4;
    v0 = __builtin_nontemporal_load((const f32x4*)(d.W + (size_t)(d.tk * 64 + r) * d.N + d.tn * 64 + c4)); v1 = __builtin_nontemporal_load((const f32x4*)(d.W + (size_t)(d.tk * 64 + r + 32) * d.N + d.tn * 64 + c4));
}
__device__ __forceinline__ void tile_finish(const TileDesc& d, const f32x4& v0, const f32x4& v1, LAS float* tile) {
    const int t = threadIdx.x;
    { const int r = t >> 4, c4 = (t & 15) * 4;
      tile[r * 65 + c4] = v0[0]; tile[r * 65 + c4 + 1] = v0[1]; tile[r * 65 + c4 + 2] = v0[2]; tile[r * 65 + c4 + 3] = v0[3];
      tile[(r + 32) * 65 + c4] = v1[0]; tile[(r + 32) * 65 + c4 + 1] = v1[1]; tile[(r + 32) * 65 + c4 + 2] = v1[2]; tile[(r + 32) * 65 + c4 + 3] = v1[3]; }
    __syncthreads();
    { const int n = t >> 3, k8 = (t & 7) * 8; float v[8];
#pragma unroll
      for (int j = 0; j < 8; ++j) v[j] = tile[(k8 + j) * 65 + n];
      int ng = d.tn * 64 + n;
      if (d.mode == 1) { const int up = ng >= D_FF; const int n2 = up ? ng - D_FF : ng; ng = 256 * (n2 >> 7) + (n2 & 127) + (up ? 128 : 0); }
      u32x4 w; w.x = cvt_pk_bf16(v[0], v[1]); w.y = cvt_pk_bf16(v[2], v[3]); w.z = cvt_pk_bf16(v[4], v[5]); w.w = cvt_pk_bf16(v[6], v[7]);
      *(u32x4*)(d.Bt + (size_t)ng * d.K + d.tk * 64 + k8) = w; }
    __syncthreads();
}
__device__ __forceinline__ TileDesc tile_desc(const Params& p, int part, int i) {
    if (part == 0) { if (i < 256) return TileDesc{p.w_out, (bf16_t*)(p.ws + WS_W2), D, D, i / 16, i % 16, 0};
                     const int j = i - 256; return TileDesc{p.w_gu, (bf16_t*)(p.ws + WS_W3), D, 2 * D_FF, j / 88, j % 88, 1}; }
    if (part == 1) return TileDesc{p.w_down, (bf16_t*)(p.ws + WS_W4), D_FF, D, i / 16, i % 16, 0};
    return TileDesc{p.w_in, (bf16_t*)(p.ws + WS_W1), D, D_IN, i / 28, i % 28, 0};
}
__device__ void late_transposes(const Params& p, LAS unsigned char* lds, int first, int stride, int part, int end) {
    LAS float* tile = (LAS float*)lds;
    const int n = part == 0 ? 256 + 1408 : (part == 1 ? 704 : 448); if (end > n) end = n;
    if (first >= end) return;
    TileDesc d = tile_desc(p, part, first); f32x4 a0, a1; tile_load(d, a0, a1);
    for (int i = first; ; i += stride) {
        const int nx = i + stride; const bool hn = nx < end;
        TileDesc dn = d; f32x4 b0 = a0, b1 = a1;
        if (hn) { dn = tile_desc(p, part, nx); tile_load(dn, b0, b1); }
        tile_finish(d, a0, a1, tile);
        if (!hn) break;
        d = dn; a0 = b0; a1 = b1;
    }
}
__device__ void prologue(const Params& p, LAS unsigned char* lds) {
    const int G = gridDim.x, bid = blockIdx.x, t = threadIdx.x;
    LAS float* tile = (LAS float*)lds;
    bf16_t* W1 = (bf16_t*)(p.ws + WS_W1);
    late_transposes(p, lds, bid, G, 2, 1 << 30);
    bf16_t* XB = (bf16_t*)(p.ws + WS_XB);
    const size_t n8 = (size_t)M * D / 8, np8 = (size_t)MP * D / 8;
    for (size_t i = (size_t)bid * NTHREADS + t; i < n8; i += (size_t)G * NTHREADS) {
        const float* src = i < np8 ? p.x_prompt + i * 8 : p.x_sample + (i - np8) * 8;
        const f32x4 a = __builtin_nontemporal_load((const f32x4*)src), b = __builtin_nontemporal_load((const f32x4*)(src + 4));
        u32x4 w; w.x = cvt_pk_bf16(a[0], a[1]); w.y = cvt_pk_bf16(a[2], a[3]); w.z = cvt_pk_bf16(b[0], b[1]); w.w = cvt_pk_bf16(b[2], b[3]);
        *(u32x4*)(XB + i * 8) = w;
    }
    float* rope = (float*)(p.ws + WS_ROPE);
    for (int i = bid * NTHREADS + t; i < 2048 * 8; i += G * NTHREADS) {
        const int pos = i >> 3, k = i & 7;
        const float inv = (float)exp(-(double)k * 0.125 * 13.122363377404328);
        const double ang = (double)((float)pos * inv);
        rope[pos * 16 + k] = (float)cos(ang); rope[pos * 16 + 8 + k] = (float)sin(ang);
    }
    bf16_t* WSB = (bf16_t*)(p.ws + WS_WS);
    for (int i = bid * NTHREADS + t; i < 8 * 128 * 128 / 2; i += G * NTHREADS) {
        const int e = i * 2, ri = (e >> 7) & 127, cj = e & 127; const bool ok = !(ri < 64 && cj >= 64);
        const f32x2 v = *(const f32x2*)(p.w_sp + e);
        *(unsigned*)(WSB + e) = ok ? cvt_pk_bf16(v[0], v[1]) : 0u;
    }
}

constexpr int KS_STRIDE = 72, VT_STRIDE = 200;
constexpr int LDS_KS = 0, LDS_VT = LDS_KS + 2 * 192 * KS_STRIDE * 2, LDS_ASSQ = LDS_VT + 2 * 64 * VT_STRIDE * 2;
__device__ void attn_unit(const Params& p, LAS unsigned char* lds, int unit) {
    int t_ = threadIdx.x; asm volatile("" : "+v"(t_));
    const int t = t_, wid = t >> 6, lane = t & 63, fr = lane & 15, fq = lane >> 4;
    const bool samp = unit >= 256; const int b = samp ? unit - 256 : unit >> 5, c = samp ? 2 : (unit & 31);
    const int r0 = samp ? MP + b * 64 : b * SEQ + c * 64;
    const int kstart = samp ? 0 : (c >= 2 ? 0 : (2 - c) * 64);
    const bf16_t* H = (const bf16_t*)(p.ws + WS_H);
    LAS bf16_t* Ks = (LAS bf16_t*)(lds + LDS_KS); LAS bf16_t* Vt = (LAS bf16_t*)(lds + LDS_VT); LAS float* ssq = (LAS float*)(lds + LDS_ASSQ);
    const int h = wid;
    bf16x8 qf[4][2];
#pragma unroll
    for (int qt = 0; qt < 4; ++qt)
#pragma unroll
        for (int ks = 0; ks < 2; ++ks) qf[qt][ks] = *(const bf16x8*)(H + (size_t)(r0 + qt * 16 + fr) * D_IN + C_Q + h * 64 + ks * 32 + fq * 8);
#pragma unroll
    for (int qi = 0; qi < 6; ++qi) { const int q = t + qi * NTHREADS;
        const int key = q >> 4, cc = q & 15, kvh = cc >> 3, d0 = (cc & 7) * 8;
        u32x4 kw = {0u, 0u, 0u, 0u}, vw = {0u, 0u, 0u, 0u};
        if (key >= kstart) {
            if (samp && key < 128) {
                const float* ck = p.cache_k + ((size_t)(b * 128 + key) * 2 + kvh) * 64 + d0; const float* cv = p.cache_v + ((size_t)(b * 128 + key) * 2 + kvh) * 64 + d0;
                const f32x4 a0 = __builtin_nontemporal_load((const f32x4*)ck), a1 = __builtin_nontemporal_load((const f32x4*)(ck + 4)), b0 = __builtin_nontemporal_load((const f32x4*)cv), b1 = __builtin_nontemporal_load((const f32x4*)(cv + 4));
                kw.x = cvt_pk_bf16(a0[0], a0[1]); kw.y = cvt_pk_bf16(a0[2], a0[3]); kw.z = cvt_pk_bf16(a1[0], a1[1]); kw.w = cvt_pk_bf16(a1[2], a1[3]);
                vw.x = cvt_pk_bf16(b0[0], b0[1]); vw.y = cvt_pk_bf16(b0[2], b0[3]); vw.z = cvt_pk_bf16(b1[0], b1[1]); vw.w = cvt_pk_bf16(b1[2], b1[3]);
            } else {
                const bf16_t* hr = H + (size_t)(r0 - 128 + key) * D_IN;
                kw = *(const u32x4*)(hr + C_K + kvh * 64 + d0); vw = *(const u32x4*)(hr + C_V + kvh * 64 + d0);
            }
        }
        *(LAS u32x4*)(Ks + (kvh * 192 + key) * KS_STRIDE + d0) = kw;
        LAS bf16_t* vt = Vt + (kvh * 64 + d0) * VT_STRIDE + ((((key >> 3) ^ (cc & 7)) << 3) | (key & 7));
        vt[0 * VT_STRIDE] = (bf16_t)(vw.x & 0xffff); vt[1 * VT_STRIDE] = (bf16_t)(vw.x >> 16); vt[2 * VT_STRIDE] = (bf16_t)(vw.y & 0xffff); vt[3 * VT_STRIDE] = (bf16_t)(vw.y >> 16);
        vt[4 * VT_STRIDE] = (bf16_t)(vw.z & 0xffff); vt[5 * VT_STRIDE] = (bf16_t)(vw.z >> 16); vt[6 * VT_STRIDE] = (bf16_t)(vw.w & 0xffff); vt[7 * VT_STRIDE] = (bf16_t)(vw.w >> 16);
    }
    __syncthreads();
    const int kvh = h >> 2;
    const float sink = p.sinks[h] * 1.4426950408889634f;
    f32x4 o[4][4];
#pragma unroll
    for (int qp = 0; qp < 2; ++qp) {
        f32x4 s[2][12];
#pragma unroll
        for (int kt = 0; kt < 12; ++kt) {
            s[0][kt] = (f32x4){0.f, 0.f, 0.f, 0.f}; s[1][kt] = (f32x4){0.f, 0.f, 0.f, 0.f};
#pragma unroll
            for (int ks = 0; ks < 2; ++ks) { const bf16x8 kf = *(const LAS bf16x8*)(Ks + (kvh * 192 + kt * 16 + fr) * KS_STRIDE + ks * 32 + fq * 8);
                s[0][kt] = __builtin_amdgcn_mfma_f32_16x16x32_bf16(kf, qf[2 * qp][ks], s[0][kt], 0, 0, 0);
                s[1][kt] = __builtin_amdgcn_mfma_f32_16x16x32_bf16(kf, qf[2 * qp + 1][ks], s[1][kt], 0, 0, 0); }
        }
        if (kstart > 0) {
#pragma unroll
            for (int kt = 0; kt < 12; ++kt) if (kt * 16 < kstart) { s[0][kt] = (f32x4){-1e30f, -1e30f, -1e30f, -1e30f}; s[1][kt] = s[0][kt]; } }
        float inv[2];
#pragma unroll
        for (int e = 0; e < 2; ++e) {
            float mx = sink;
#pragma unroll
            for (int kt = 0; kt < 12; ++kt) mx = fmaxf(mx, fmaxf(fmaxf(s[e][kt][0], s[e][kt][1]), fmaxf(s[e][kt][2], s[e][kt][3])));
            mx = fmaxf(mx, __shfl_xor(mx, 16)); mx = fmaxf(mx, __shfl_xor(mx, 32));
            float sum = 0.f;
#pragma unroll
            for (int kt = 0; kt < 12; ++kt) {
#pragma unroll
                for (int j = 0; j < 4; ++j) { const float ex = __builtin_amdgcn_exp2f(s[e][kt][j] - mx); s[e][kt][j] = ex; sum += ex; } }
            sum += __shfl_xor(sum, 16); sum += __shfl_xor(sum, 32);
            inv[e] = 1.0f / (sum + __builtin_amdgcn_exp2f(sink - mx));
#pragma unroll
            for (int dt = 0; dt < 4; ++dt) o[2 * qp + e][dt] = (f32x4){0.f, 0.f, 0.f, 0.f};
        }
#pragma unroll
        for (int kp = 0; kp < 6; ++kp) {
            bf16x8 pf[2];
#pragma unroll
            for (int e = 0; e < 2; ++e) { u32x4 pw; pw.x = cvt_pk_bf16(s[e][2 * kp][0], s[e][2 * kp][1]); pw.y = cvt_pk_bf16(s[e][2 * kp][2], s[e][2 * kp][3]);
                pw.z = cvt_pk_bf16(s[e][2 * kp + 1][0], s[e][2 * kp + 1][1]); pw.w = cvt_pk_bf16(s[e][2 * kp + 1][2], s[e][2 * kp + 1][3]); pf[e] = __builtin_bit_cast(bf16x8, pw); }
#pragma unroll
            for (int dt = 0; dt < 4; ++dt) {
                const LAS bf16_t* vrow = Vt + (kvh * 64 + dt * 16 + fr) * VT_STRIDE; const int sw = (dt * 2 + (fr >> 3)) & 7;
                const int k0 = kp * 32 + fq * 4, k1 = k0 + 16;
                const u32x2 va = *(const LAS u32x2*)(vrow + ((((k0 >> 3) ^ sw) << 3) | (k0 & 7))), vb = *(const LAS u32x2*)(vrow + ((((k1 >> 3) ^ sw) << 3) | (k1 & 7)));
                const u32x4 vv = {va.x, va.y, vb.x, vb.y};
                o[2 * qp][dt] = __builtin_amdgcn_mfma_f32_16x16x32_bf16(__builtin_bit_cast(bf16x8, vv), pf[0], o[2 * qp][dt], 0, 0, 0);
                o[2 * qp + 1][dt] = __builtin_amdgcn_mfma_f32_16x16x32_bf16(__builtin_bit_cast(bf16x8, vv), pf[1], o[2 * qp + 1][dt], 0, 0, 0);
            }
        }
#pragma unroll
        for (int e = 0; e < 2; ++e) { const int qt = 2 * qp + e;
            float q2 = 0.f;
#pragma unroll
            for (int dt = 0; dt < 4; ++dt) { o[qt][dt] = o[qt][dt] * inv[e];
#pragma unroll
                for (int j = 0; j < 4; ++j) q2 += o[qt][dt][j] * o[qt][dt][j]; }
            q2 += __shfl_xor(q2, 16); q2 += __shfl_xor(q2, 32);
            if (fq == 0) ssq[h * 64 + qt * 16 + fr] = q2; }
    }
    __syncthreads();
    bf16_t* CAT = (bf16_t*)(p.ws + WS_CAT);
#pragma unroll
    for (int qt = 0; qt < 4; ++qt) {
        float tot = 0.f;
#pragma unroll
        for (int hh = 0; hh < 8; ++hh) tot += ssq[hh * 64 + qt * 16 + fr];
        const float rs = rsqrtf(tot * (1.0f / 512.0f) + LN_EPS);
#pragma unroll
        for (int dt = 0; dt < 4; ++dt) { const int col = h * 64 + dt * 16 + fq * 4; const f32x4 g = *(const f32x4*)(p.g_attn + col); const f32x4 v = o[qt][dt] * rs * g;
            u32x2 w; w.x = cvt_pk_bf16(v[0], v[1]); w.y = cvt_pk_bf16(v[2], v[3]);
            *(u32x2*)(CAT + (size_t)(r0 + qt * 16 + fr) * D + col) = w; }
    }
    __syncthreads();
}

constexpr int VM_STRIDE = 136;
constexpr int LDS_VMT = 0, LDS_GST = LDS_VMT + 8 * 64 * VM_STRIDE * 2, LDS_GSSQ = LDS_GST + 128 * 2 * 4;
__device__ void gate_unit(const Params& p, LAS unsigned char* lds, int unit) {
    int t_ = threadIdx.x; asm volatile("" : "+v"(t_));
    const int t = t_, wid = t >> 6, lane = t & 63, fr = lane & 15, fq = lane >> 4;
    const bool samp = unit >= 256; const int w_ = unit & 127; const int b = samp ? unit - 256 : w_ >> 4, c = samp ? 0 : 2 * (w_ & 15) + (unit < 128 ? 1 : 0), par = c & 1;
    const int r0 = samp ? MP + b * 64 : b * SEQ + c * 64;
    const int Kc = par ? 128 : 64, jr0 = par ? r0 - 64 : r0;
    const bf16_t* H = (const bf16_t*)(p.ws + WS_H);
    LAS bf16_t* VmT = (LAS bf16_t*)(lds + LDS_VMT); LAS float* st = (LAS float*)(lds + LDS_GST); LAS float* ssq = (LAS float*)(lds + LDS_GSSQ);
    const int g = wid, jl = lane >> 3, c8 = (lane & 7) * 8, col = g * 64 + c8;
    LAS f32x2* part = (LAS f32x2*)(lds + LDS_VMT);
    u32x4 raw[16];
#pragma unroll
    for (int it = 0; it < 16; ++it) if (it * 8 < Kc) raw[it] = *(const u32x4*)(H + (size_t)(jr0 + it * 8 + jl) * D_IN + C_VM + col);
#pragma unroll
    for (int it = 0; it < 16; ++it) if (it * 8 < Kc) {
        const u32x4 w = raw[it];
        const float v0 = bflo(w.x), v1 = bfhi(w.x), v2 = bflo(w.y), v3 = bfhi(w.y), v4 = bflo(w.z), v5 = bfhi(w.z), v6 = bflo(w.w), v7 = bfhi(w.w);
        float sm = ((v0 + v1) + (v2 + v3)) + ((v4 + v5) + (v6 + v7));
        float sq = ((v0 * v0 + v1 * v1) + (v2 * v2 + v3 * v3)) + ((v4 * v4 + v5 * v5) + (v6 * v6 + v7 * v7));
        sm += __shfl_xor(sm, 1); sq += __shfl_xor(sq, 1); sm += __shfl_xor(sm, 2); sq += __shfl_xor(sq, 2); sm += __shfl_xor(sm, 4); sq += __shfl_xor(sq, 4);
        if ((lane & 7) == 0) part[(it * 8 + jl) * 8 + g] = (f32x2){sm, sq};
    }
    __syncthreads();
    if (t < Kc) { float sm = 0.f, sq = 0.f;
#pragma unroll
        for (int gg = 0; gg < 8; ++gg) { const f32x2 pv = part[t * 8 + gg]; sm += pv.x; sq += pv.y; }
        const float mean = sm * (1.0f / 512.0f), var = fmaxf(sq * (1.0f / 512.0f) - mean * mean, 0.f);
        st[t * 2] = mean; st[t * 2 + 1] = rsqrtf(var + LN_EPS); }
    __syncthreads();
    { const f32x4 ga0 = *(const f32x4*)(p.ln_v_g + col), ga1 = *(const f32x4*)(p.ln_v_g + col + 4), be0 = *(const f32x4*)(p.ln_v_b + col), be1 = *(const f32x4*)(p.ln_v_b + col + 4);
#pragma unroll
      for (int it = 0; it < 16; ++it) if (it * 8 < Kc) { const int j = it * 8 + jl;
          const u32x4 w = raw[it];
          const float mean = st[j * 2], rstd = st[j * 2 + 1];
          f32x4 v0 = {bflo(w.x), bfhi(w.x), bflo(w.y), bfhi(w.y)}, v1 = {bflo(w.z), bfhi(w.z), bflo(w.w), bfhi(w.w)};
          v0 = (v0 - mean) * rstd * ga0 + be0; v1 = (v1 - mean) * rstd * ga1 + be1;
          if (samp) { float* o = p.out + O_MS + (size_t)(b * 64 + j) * 512 + col; *(f32x4*)o = v0; *(f32x4*)(o + 4) = v1; }
          const unsigned w0 = cvt_pk_bf16(v0[0], v0[1]), w1 = cvt_pk_bf16(v0[2], v0[3]), w2 = cvt_pk_bf16(v1[0], v1[1]), w3 = cvt_pk_bf16(v1[2], v1[3]);
          LAS bf16_t* d = VmT + (g * 64 + c8) * VM_STRIDE + ((it ^ (lane & 7)) * 8 + jl);
          d[0 * VM_STRIDE] = (bf16_t)(w0 & 0xffff); d[1 * VM_STRIDE] = (bf16_t)(w0 >> 16); d[2 * VM_STRIDE] = (bf16_t)(w1 & 0xffff); d[3 * VM_STRIDE] = (bf16_t)(w1 >> 16);
          d[4 * VM_STRIDE] = (bf16_t)(w2 & 0xffff); d[5 * VM_STRIDE] = (bf16_t)(w2 >> 16); d[6 * VM_STRIDE] = (bf16_t)(w3 & 0xffff); d[7 * VM_STRIDE] = (bf16_t)(w3 >> 16); } }
    __syncthreads();
    const bf16_t* WSB = (const bf16_t*)(p.ws + WS_WS) + (size_t)g * 128 * 128 + (size_t)(par * 64) * 128;
    f32x4 acc[4][4];
#pragma unroll
    for (int it = 0; it < 4; ++it)
#pragma unroll
        for (int dt = 0; dt < 4; ++dt) acc[it][dt] = (f32x4){0.f, 0.f, 0.f, 0.f};
    bf16x8 wf[4][4];
#pragma unroll
    for (int ks = 0; ks < 4; ++ks) if (ks * 32 < Kc) {
#pragma unroll
        for (int it = 0; it < 4; ++it) wf[ks][it] = *(const bf16x8*)(WSB + (size_t)(it * 16 + fr) * 128 + ks * 32 + fq * 8); }
#pragma unroll
    for (int ks = 0; ks < 4; ++ks) if (ks * 32 < Kc) {
        bf16x8 vf[4];
#pragma unroll
        for (int dt = 0; dt < 4; ++dt) vf[dt] = *(const LAS bf16x8*)(VmT + (g * 64 + dt * 16 + fr) * VM_STRIDE + (((ks * 4 + fq) ^ ((dt * 2 + (fr >> 3)) & 7)) * 8));
#pragma unroll
        for (int it = 0; it < 4; ++it)
#pragma unroll
            for (int dt = 0; dt < 4; ++dt) acc[it][dt] = __builtin_amdgcn_mfma_f32_16x16x32_bf16(vf[dt], wf[ks][it], acc[it][dt], 0, 0, 0);
    }
    u32x2 uw[4][4];
#pragma unroll
    for (int it = 0; it < 4; ++it)
#pragma unroll
        for (int dt = 0; dt < 4; ++dt) uw[it][dt] = *(const u32x2*)(H + (size_t)(r0 + it * 16 + fr) * D_IN + C_U + g * 64 + dt * 16 + fq * 4);
#pragma unroll
    for (int it = 0; it < 4; ++it) {
        const float bs = p.b_sp[g * 128 + par * 64 + it * 16 + fr]; float q2 = 0.f;
#pragma unroll
        for (int dt = 0; dt < 4; ++dt) { const f32x4 uv = {bflo(uw[it][dt].x), bfhi(uw[it][dt].x), bflo(uw[it][dt].y), bfhi(uw[it][dt].y)};
            acc[it][dt] = (acc[it][dt] + bs) * uv;
#pragma unroll
            for (int j = 0; j < 4; ++j) q2 += acc[it][dt][j] * acc[it][dt][j]; }
        q2 += __shfl_xor(q2, 16); q2 += __shfl_xor(q2, 32);
        if (fq == 0) ssq[g * 64 + it * 16 + fr] = q2;
    }
    __syncthreads();
    bf16_t* CAT = (bf16_t*)(p.ws + WS_CAT);
#pragma unroll
    for (int it = 0; it < 4; ++it) {
        float tot = 0.f;
#pragma unroll
        for (int gg = 0; gg < 8; ++gg) tot += ssq[gg * 64 + it * 16 + fr];
        const float rs = rsqrtf(tot * (1.0f / 512.0f) + LN_EPS);
#pragma unroll
        for (int dt = 0; dt < 4; ++dt) { const int col = g * 64 + dt * 16 + fq * 4; const f32x4 gm = *(const f32x4*)(p.g_cmlp + col); const f32x4 v = acc[it][dt] * rs * gm;
            u32x2 w; w.x = cvt_pk_bf16(v[0], v[1]); w.y = cvt_pk_bf16(v[2], v[3]);
            *(u32x2*)(CAT + (size_t)(r0 + it * 16 + fr) * D + 512 + col) = w; }
    }
    __syncthreads();
}

template <bool TO_BF16>
__device__ void ln_rows(const float* Z, const float* gam, const float* bet, bf16_t* Hb, float* Y) {
    const int lane = threadIdx.x & 63, gw = blockIdx.x * 8 + (threadIdx.x >> 6), nw = gridDim.x * 8;
    f32x4 g[4], be[4];
#pragma unroll
    for (int i = 0; i < 4; ++i) { g[i] = *(const f32x4*)(gam + i * 256 + lane * 4); be[i] = *(const f32x4*)(bet + i * 256 + lane * 4); }
    for (int row = gw; row < M; row += nw) {
        const float* z = Z + (size_t)row * D; f32x4 v[4]; float s = 0.f;
#pragma unroll
        for (int i = 0; i < 4; ++i) { v[i] = *(const f32x4*)(z + i * 256 + lane * 4); s += (v[i][0] + v[i][1]) + (v[i][2] + v[i][3]); }
#pragma unroll
        for (int o = 1; o < 64; o <<= 1) s += __shfl_xor(s, o);
        const float mean = s * (1.0f / 1024.0f); float q = 0.f;
#pragma unroll
        for (int i = 0; i < 4; ++i) { v[i] = v[i] - mean; q += (v[i][0] * v[i][0] + v[i][1] * v[i][1]) + (v[i][2] * v[i][2] + v[i][3] * v[i][3]); }
#pragma unroll
        for (int o = 1; o < 64; o <<= 1) q += __shfl_xor(q, o);
        const float rstd = rsqrtf(q * (1.0f / 1024.0f) + LN_EPS);
#pragma unroll
        for (int i = 0; i < 4; ++i) { const f32x4 y = v[i] * rstd * g[i] + be[i];
            if (TO_BF16) { u32x2 w; w.x = cvt_pk_bf16(y[0], y[1]); w.y = cvt_pk_bf16(y[2], y[3]); *(u32x2*)(Hb + (size_t)row * D + i * 256 + lane * 4) = w; }
            else *(f32x4*)(Y + (size_t)row * D + i * 256 + lane * 4) = y; }
    }
}

__global__ void __launch_bounds__(NTHREADS, 2) fwd_mega(Params p) {
    extern __shared__ __attribute__((aligned(16))) unsigned char smem[];
    LAS unsigned char* lds = (LAS unsigned char*)smem;
    const int G = gridDim.x, bid = blockIdx.x;
    volatile LAS unsigned* xst = (volatile LAS unsigned*)(lds + LDS_BYTES - 16);
    if (threadIdx.x == 0) { xst[0] = 0u; xst[1] = 0u; }
    __syncthreads();
    XcdBarrier xb = xcd_barrier_post((unsigned*)(p.ws + WS_BAR) + (NBAR > 1 ? p.pad * 4096 : 0), xst);
#define IN(ph) (p.ph_lo <= (ph) && (ph) < p.ph_hi)
#define REP(ph) for (int _r = 0; _r < ((ph) == PROBE_PH ? 3 : 1); ++_r)
#define SYNC(ph) do { if (p.coop && IN(ph) && IN((ph) + 1)) xcd_barrier(xb); } while (0)
    if (IN(0)) REP(0) prologue(p, lds);
    SYNC(0);
    if (IN(1)) { pg8::Gemm g{(const bf16_t*)(p.ws + WS_XB), (const bf16_t*)(p.ws + WS_W1), M, D_IN, D}; pg8::StaticOrder S; S.init(M, D_IN, D, G, bid);
        EpiProj E{(bf16_t*)(p.ws + WS_H), (const float*)(p.ws + WS_ROPE), p.out}; pg8::gemm_phase(lds, g, S, E); }
    SYNC(1);
    if (IN(2)) {
        if (G == 256) {
            for (int k = 0; k < 3; ++k) {
                int u = -1;
                if (k == 0) u = bid;
                else if (k == 1) u = bid < 32 ? 256 + bid : (bid < 160 ? 288 + (bid - 32) : 288 + 128 + (bid - 160));
                else if (bid >= 160 && bid < 224) u = 288 + 224 + (bid - 160);
                if (u < 0) break;
                if (u < 288) attn_unit(p, lds, u); else gate_unit(p, lds, u - 288);
            }
            int t0 = 0, tn = 0;
            if (bid < 32) { t0 = bid * 9; tn = 9; } else if (bid < 160) { t0 = 288 + (bid - 32) * 8; tn = 8; } else if (bid >= 224) { t0 = 1312 + (bid - 224) * 11; tn = 11; }
            if (tn) late_transposes(p, lds, t0, 1, 0, t0 + tn);
        } }
    SYNC(2);
    if (IN(3)) { for (int rep = 0; rep < (PROBE_PH == 3 ? 3 : 1); ++rep) { if (rep) xcd_barrier(xb);
        pg8::Gemm g{(const bf16_t*)(p.ws + WS_CAT), (const bf16_t*)(p.ws + WS_W2), M, D, D}; pg8::TeamOrder S; S.init(D, bid, P3_STREAMK);
        EpiLn<1> E{(PROBE_PH == 10 ? p.pad * 2 : 0) + rep}; pg8::gemm_phase(lds, g, S, E); } }
    SYNC(3);
    if (IN(4)) REP(5) { pg8::Gemm g{(const bf16_t*)(p.ws + WS_HB), (const bf16_t*)(p.ws + WS_W3), M, 2 * D_FF, D}; pg8::StaticOrder S; S.init(M, 2 * D_FF, D, G, bid);
        EpiSwiglu E{(bf16_t*)(p.ws + WS_ACT)}; pg8::gemm_phase(lds, g, S, E);
        if (G == 256 && bid >= 48) late_transposes(p, lds, bid - 48, 208, 1, 1 << 30); }
    SYNC(4);
    if (IN(5)) { for (int rep = 0; rep < (PROBE_PH == 6 ? 3 : 1); ++rep) { if (rep) xcd_barrier(xb);
        pg8::Gemm g{(const bf16_t*)(p.ws + WS_ACT), (const bf16_t*)(p.ws + WS_W4), M, D, D_FF}; pg8::TeamOrder S; S.init(D_FF, bid, 1);
        EpiLn<2> E{(PROBE_PH == 10 ? p.pad * 2 + 1 : (PROBE_PH == 3 || PROBE_PH == 6) ? 3 : 1) + rep}; pg8::gemm_phase(lds, g, S, E); } }
#undef IN
#undef SYNC
}

#undef REP
#ifndef N_LAUNCHES
#define N_LAUNCHES 1
#endif
extern "C" void kernel_launch(void* const* d_in, const int* in_sizes, int n_in, void* d_out, int out_size, void* d_ws, size_t ws_size, hipStream_t stream) {
    static int grid = 0;
    if (grid == 0) {
        int dev = 0, cus = 0, per_cu = 0;
        hipGetDevice(&dev); hipDeviceGetAttribute(&cus, hipDeviceAttributeMultiprocessorCount, dev);
        if (hipFuncSetAttribute((const void*)fwd_mega, hipFuncAttributeMaxDynamicSharedMemorySize, LDS_BYTES) != hipSuccess) { fprintf(stderr, "hipFuncSetAttribute failed\n"); grid = -1; return; }
        if (hipOccupancyMaxActiveBlocksPerMultiprocessor(&per_cu, (const void*)fwd_mega, NTHREADS, LDS_BYTES) != hipSuccess || per_cu < 1) { fprintf(stderr, "occupancy query: %d\n", per_cu); per_cu = 1; }
        (void)hipGetLastError();
        grid = cus * (per_cu > 1 ? 1 : per_cu);
        if (grid != 256) { fprintf(stderr, "this kernel needs a grid of exactly 256 workgroups (one per CU), got %d\n", grid); grid = -1; return; }
        if (ws_size < WS_END) { fprintf(stderr, "workspace too small: %zu < %zu\n", ws_size, WS_END); grid = -1; return; }
    }
    if (grid < 0) return;
    if (hipMemsetAsync((char*)d_ws + WS_BAR, 0, WS_ZERO_BYTES, stream) != hipSuccess) { fprintf(stderr, "memset failed\n"); return; }
    Params p{};
    p.x_prompt = (const float*)d_in[0]; p.x_sample = (const float*)d_in[1]; p.cache_k = (const float*)d_in[2]; p.cache_v = (const float*)d_in[3]; p.w_in = (const float*)d_in[4];
    p.ln_v_g = (const float*)d_in[5]; p.ln_v_b = (const float*)d_in[6]; p.sinks = (const float*)d_in[7]; p.w_sp = (const float*)d_in[8]; p.b_sp = (const float*)d_in[9];
    p.g_attn = (const float*)d_in[10]; p.g_cmlp = (const float*)d_in[11]; p.w_out = (const float*)d_in[12]; p.ln1_g = (const float*)d_in[13]; p.ln1_b = (const float*)d_in[14];
    p.w_gu = (const float*)d_in[15]; p.w_down = (const float*)d_in[16]; p.ln2_g = (const float*)d_in[17]; p.ln2_b = (const float*)d_in[18];
    p.out = (float*)d_out; p.ws = (unsigned char*)d_ws;
#if N_LAUNCHES == 1
    p.ph_lo = 0; p.ph_hi = 6; p.coop = 1;
    void* args[] = {&p};
    hipError_t e = hipLaunchCooperativeKernel((const void*)fwd_mega, dim3(grid), dim3(NTHREADS), args, LDS_BYTES, stream);
#if PROBE_PH == 10
    p.pad = 1; e = hipLaunchCooperativeKernel((const void*)fwd_mega, dim3(grid), dim3(NTHREADS), args, LDS_BYTES, stream);
#endif
    if (e != hipSuccess) fprintf(stderr, "cooperative launch failed: %s (grid %d)\n", hipGetErrorString(e), grid);
#else
    for (int ph = 0; ph < 6; ++ph) { p.ph_lo = ph; p.ph_hi = ph + 1; p.coop = 0;
        hipLaunchKernelGGL(fwd_mega, dim3(grid), dim3(NTHREADS), LDS_BYTES, stream, p); }
#endif
}
```
